# Optimizing an MI355X kernel written in HIP

```python
import jax, jax.numpy as jnp
from jax import lax
import numpy as np

D_MODEL = 1024
BATCH = 1
SEQ = 16384
DEPTH = 2
DEC_BATCH = 32
DEC_SEQ = 8
PAST_LEN = 16384
PAGE_SIZE = 128

D_CONV = 3 * D_MODEL // 8
CONV_WIDTH = 31
CONV_STATE = CONV_WIDTH - 1
HEAD_DIM = 64
DIL_GROUPS = ((128, 1), (512, 4), (2048, 16))
HEADS_PER_GROUP = 4
N_HEADS = HEADS_PER_GROUP * len(DIL_GROUPS)
D_ATTN = N_HEADS * HEAD_DIM
Q_BLOCK = 128
N_BUCKETS = 32
MAX_DISTANCE = 2048
D_SGU = 3 * D_MODEL // 8
SGU_GROUPS = 4
CHUNK = 128
D_POOL = 3 * D_MODEL // 8
POOL_WINDOWS = (2, 4, 8, 16)
POOL_STATE = max(POOL_WINDOWS) - 1
D_FF = ((8 * D_MODEL // 3 + 255) // 256) * 256
D_PLE = 256
N_BRANCH = 4
SPLITS = (2 * D_CONV,
          2 * D_CONV + D_ATTN,
          2 * D_CONV + 2 * D_ATTN,
          2 * D_CONV + 3 * D_ATTN,
          2 * D_CONV + 3 * D_ATTN + 2 * D_SGU,
          2 * D_CONV + 3 * D_ATTN + 2 * D_SGU + D_POOL)
D_IN = SPLITS[-1] + N_BRANCH * D_MODEL
EPS = 1e-6
NEG_INF = -1e30

kernel_name = "hybrid_gated_conv_dilattn_sgu_pool_decoder_step"


def _rmsnorm(x, g):
    xf = x.astype(jnp.float32)
    y = xf * lax.rsqrt(jnp.mean(xf * xf, axis=-1, keepdims=True) + EPS)
    return (y * g.astype(jnp.float32)).astype(x.dtype)


def _layernorm(x, g, b):
    xf = x.astype(jnp.float32)
    mu = jnp.mean(xf, axis=-1, keepdims=True)
    xc = xf - mu
    y = xc * lax.rsqrt(jnp.mean(xc * xc, axis=-1, keepdims=True) + 1e-5)
    return (y * g.astype(jnp.float32) + b.astype(jnp.float32)).astype(x.dtype)


def _t5_bucket(dist):
    max_exact = N_BUCKETS // 2
    d = np.asarray(dist)
    large = max_exact + (np.log(np.maximum(d, 1) / max_exact)
                         / np.log(MAX_DISTANCE / max_exact)
                         * (N_BUCKETS - max_exact)).astype(np.int64)
    large = np.minimum(large, N_BUCKETS - 1)
    return np.where(d < max_exact, d, large).astype(np.int32)


def _dilated_attention(q, k, v, qidx, offsets, bias):
    B, T, H, hd = q.shape
    qb = Q_BLOCK if T % Q_BLOCK == 0 else T
    nb = T // qb
    offs = jnp.asarray(offsets, jnp.int32)
    bias_t = bias.T.astype(jnp.float32)
    scale = HEAD_DIM ** -0.5

    def block(args):
        qblk, qi = args
        idx = qi[:, None] - offs[None, :]
        valid = idx >= 0
        idx = jnp.maximum(idx, 0)
        kg = jnp.take(k, idx, axis=1)
        vg = jnp.take(v, idx, axis=1)
        s = jnp.einsum("bqhd,bqkhd->bqhk", qblk, kg).astype(jnp.float32) * scale + bias_t
        s = jnp.where(valid[None, :, None, :], s, NEG_INF)
        m = jnp.max(s, axis=-1, keepdims=True)
        p = jnp.exp(s - m)
        den = jnp.sum(p, axis=-1, keepdims=True)
        o = jnp.einsum("bqhk,bqkhd->bqhd", p, vg.astype(jnp.float32)) / den
        return o, (m + jnp.log(den))[..., 0]

    qs = q.reshape(B, nb, qb, H, hd).swapaxes(0, 1)
    qis = qidx.reshape(nb, qb)
    o, lse = lax.map(block, (qs, qis))
    return o.swapaxes(0, 1).reshape(B, T, H, hd), lse.swapaxes(0, 1).reshape(B, T, H)


def _layer(x, pe, prev_conv, prev_pool, prev_kv, pos0, lp, rel_bias):
    B, T, _ = x.shape
    dt = x.dtype
    h = _rmsnorm(x, lp["norm_mix"])
    z = h @ lp["w_in"]
    za, zq, zk, zv, zc, zd, zg = jnp.split(z, SPLITS, axis=-1)

    a, b = jnp.split(za, 2, axis=-1)
    glu = a * jax.nn.sigmoid(b)
    ext = jnp.concatenate([prev_conv.astype(dt), glu], axis=1)
    cv = lax.conv_general_dilated(ext, lp["conv_w"][:, None, :].astype(dt), (1,), "VALID",
                                  dimension_numbers=("NWC", "WIO", "NWC"),
                                  feature_group_count=D_CONV) + lp["conv_b"]
    cv = jax.nn.silu(_layernorm(cv, lp["conv_ln_g"], lp["conv_ln_b"]))
    br_a = cv @ lp["w_a_out"]
    new_conv = ext[:, ext.shape[1] - CONV_STATE:]

    q = _rmsnorm(zq.reshape(B, T, N_HEADS, HEAD_DIM), lp["q_norm"])
    k = _rmsnorm(zk.reshape(B, T, N_HEADS, HEAD_DIM), lp["k_norm"])
    v = zv.reshape(B, T, N_HEADS, HEAD_DIM)
    outs, lses, new_kv = [], [], []
    for gi, (win, dil) in enumerate(DIL_GROUPS):
        hs = slice(gi * HEADS_PER_GROUP, (gi + 1) * HEADS_PER_GROUP)
        kv_new = jnp.stack([k[:, :, hs], v[:, :, hs]], axis=2)
        L = prev_kv[gi].shape[1]
        kv_ext = jnp.concatenate([prev_kv[gi].astype(dt), kv_new], axis=1)
        offsets = dil * np.arange(win // dil + 1)
        bias = rel_bias[_t5_bucket(offsets)][:, hs]
        qidx = L + jnp.arange(T, dtype=jnp.int32)
        o, lse = _dilated_attention(q[:, :, hs], kv_ext[:, :, 0], kv_ext[:, :, 1], qidx, offsets, bias)
        outs.append(o)
        lses.append(lse)
        keep = L if L > 0 else min(win, T)
        new_kv.append(kv_ext[:, kv_ext.shape[1] - keep:])
    alpha = jax.nn.softmax(jnp.stack(lses, axis=0), axis=0)
    o = jnp.sum(alpha[..., None] * jnp.stack(outs, axis=0), axis=0)
    br_b = o.reshape(B, T, HEADS_PER_GROUP * HEAD_DIM).astype(dt) @ lp["w_b_out"]

    u, vv = jnp.split(zc, 2, axis=-1)
    vv = _layernorm(vv, lp["sgu_ln_g"], lp["sgu_ln_b"])
    cl = min(T, CHUNK)
    nc = T // cl
    tril = np.tril(np.ones((cl, cl), dtype=bool))
    ws = jnp.where(tril[None], lp["sgu_w"][:, :cl, :cl], 0)
    vr = vv.reshape(B, nc, cl, SGU_GROUPS, D_SGU // SGU_GROUPS)
    sv = jnp.einsum("gij,bcjgd->bcigd", ws, vr) + lp["sgu_b"][:, :cl].T[None, None, :, :, None]
    br_c = (u * sv.reshape(B, T, D_SGU)) @ lp["w_c_out"]

    P = POOL_STATE
    ext_d = jnp.concatenate([prev_pool.astype(dt), zd], axis=1)
    xf = ext_d.astype(jnp.float32)
    S = jnp.concatenate([jnp.zeros((B, 1, D_POOL), jnp.float32), jnp.cumsum(xf, axis=1)], axis=1)
    pos = pos0 + jnp.arange(T)
    cur = xf[:, P:]
    gw = D_POOL // len(POOL_WINDOWS)
    parts = []
    for j, w in enumerate(POOL_WINDOWS):
        cs = slice(j * gw, (j + 1) * gw)
        win_sum = S[:, P + 1:P + 1 + T, cs] - S[:, P + 1 - w:P + 1 - w + T, cs]
        cnt = jnp.minimum(w, pos + 1).astype(jnp.float32)
        parts.append(win_sum / cnt[None, :, None] - cur[:, :, cs])
    pooled = jnp.stack(parts, axis=2).astype(dt)
    mixed = jnp.einsum("btgc,gcd->btgd", pooled, lp["pool_w"]).reshape(B, T, D_POOL) * lp["pool_scale"]
    br_d = mixed @ lp["w_d_out"]
    new_pool = ext_d[:, ext_d.shape[1] - P:]

    gates = jax.nn.sigmoid(zg.reshape(B, T, N_BRANCH, D_MODEL))
    merged = (gates[:, :, 0] * br_a + gates[:, :, 1] * br_b
              + gates[:, :, 2] * br_c + gates[:, :, 3] * br_d)
    x = x + merged @ lp["w_o"]
    h2 = _rmsnorm(x, lp["norm_ffn"])
    x = x + (jax.nn.silu(h2 @ lp["w_gate"]) * (h2 @ lp["w_up"])) @ lp["w_down"]
    x = x + (pe @ lp["w_ple"]) * jax.nn.sigmoid(_rmsnorm(x, lp["ple_norm"]) @ lp["w_ple_gate"])
    return x, new_kv, new_conv, new_pool, vv


def setup_inputs(seed: int = 0) -> dict:
    key = jax.random.key(seed)
    ks = iter(jax.random.split(key, 64))

    def nrm(shape, scale=1.0):
        return scale * jax.random.normal(next(ks), shape, jnp.float32)

    def gain(shape):
        return 1.0 + 0.05 * nrm(shape)

    lens = [min(w, PAST_LEN) for w, _ in DIL_GROUPS]
    return {
        "x_prompt": nrm((BATCH, SEQ, D_MODEL)),
        "x_sample": nrm((DEC_BATCH, DEC_SEQ, D_MODEL)),
        "cache_kv_w128": nrm((DEPTH, DEC_BATCH, lens[0], 2, HEADS_PER_GROUP, HEAD_DIM)),
        "cache_kv_w512": nrm((DEPTH, DEC_BATCH, lens[1], 2, HEADS_PER_GROUP, HEAD_DIM)),
        "cache_kv_w2048": nrm((DEPTH, DEC_BATCH, lens[2], 2, HEADS_PER_GROUP, HEAD_DIM)),
        "state_conv": nrm((DEPTH, DEC_BATCH, CONV_STATE, D_CONV), 0.5),
        "state_pool": nrm((DEPTH, DEC_BATCH, POOL_STATE, D_POOL)),
        "p_prompt": nrm((DEPTH, BATCH, SEQ, D_PLE)),
        "p_sample": nrm((DEPTH, DEC_BATCH, DEC_SEQ, D_PLE)),
        "rel_bias": nrm((N_BUCKETS, N_HEADS), 0.2),
        "norm_mix": gain((DEPTH, D_MODEL)),
        "w_in": nrm((DEPTH, D_MODEL, D_IN), D_MODEL ** -0.5),
        "conv_w": nrm((DEPTH, CONV_WIDTH, D_CONV), CONV_WIDTH ** -0.5),
        "conv_b": nrm((DEPTH, D_CONV), 0.02),
        "conv_ln_g": gain((DEPTH, D_CONV)),
        "conv_ln_b": nrm((DEPTH, D_CONV), 0.02),
        "w_a_out": nrm((DEPTH, D_CONV, D_MODEL), D_CONV ** -0.5),
        "q_norm": gain((DEPTH, HEAD_DIM)),
        "k_norm": gain((DEPTH, HEAD_DIM)),
        "w_b_out": nrm((DEPTH, HEADS_PER_GROUP * HEAD_DIM, D_MODEL), (HEADS_PER_GROUP * HEAD_DIM) ** -0.5),
        "sgu_ln_g": gain((DEPTH, D_SGU)),
        "sgu_ln_b": nrm((DEPTH, D_SGU), 0.02),
        "sgu_w": nrm((DEPTH, SGU_GROUPS, CHUNK, CHUNK), CHUNK ** -0.5),
        "sgu_b": 1.0 + 0.1 * nrm((DEPTH, SGU_GROUPS, CHUNK)),
        "w_c_out": nrm((DEPTH, D_SGU, D_MODEL), D_SGU ** -0.5),
        "pool_w": nrm((DEPTH, len(POOL_WINDOWS), D_POOL // len(POOL_WINDOWS), D_POOL // len(POOL_WINDOWS)),
                      (D_POOL // len(POOL_WINDOWS)) ** -0.5),
        "pool_scale": 1.0 + 0.1 * nrm((DEPTH, D_POOL)),
        "w_d_out": nrm((DEPTH, D_POOL, D_MODEL), D_POOL ** -0.5),
        "w_o": nrm((DEPTH, D_MODEL, D_MODEL), D_MODEL ** -0.5),
        "norm_ffn": gain((DEPTH, D_MODEL)),
        "w_gate": nrm((DEPTH, D_MODEL, D_FF), D_MODEL ** -0.5),
        "w_up": nrm((DEPTH, D_MODEL, D_FF), D_MODEL ** -0.5),
        "w_down": nrm((DEPTH, D_FF, D_MODEL), D_FF ** -0.5),
        "ple_norm": gain((DEPTH, D_MODEL)),
        "w_ple_gate": nrm((DEPTH, D_MODEL, D_MODEL), D_MODEL ** -0.5),
        "w_ple": nrm((DEPTH, D_PLE, D_MODEL), D_PLE ** -0.5),
    }


def reference(x_prompt, x_sample, cache_kv_w128, cache_kv_w512, cache_kv_w2048, state_conv, state_pool,
              p_prompt, p_sample, rel_bias, norm_mix, w_in, conv_w, conv_b, conv_ln_g, conv_ln_b, w_a_out,
              q_norm, k_norm, w_b_out, sgu_ln_g, sgu_ln_b, sgu_w, sgu_b, w_c_out, pool_w, pool_scale,
              w_d_out, w_o, norm_ffn, w_gate, w_up, w_down, ple_norm, w_ple_gate, w_ple):
    caches = (cache_kv_w128, cache_kv_w512, cache_kv_w2048)
    yp, ys = x_prompt, x_sample
    bp = x_prompt.shape[0]
    dt = x_prompt.dtype
    kvp = [[] for _ in DIL_GROUPS]
    kvs = [[] for _ in DIL_GROUPS]
    conv_p, pool_p, conv_s, pool_s, sgu_s = [], [], [], [], []
    for i in range(DEPTH):
        lp = {
            "norm_mix": norm_mix[i], "w_in": w_in[i],
            "conv_w": conv_w[i], "conv_b": conv_b[i],
            "conv_ln_g": conv_ln_g[i], "conv_ln_b": conv_ln_b[i], "w_a_out": w_a_out[i],
            "q_norm": q_norm[i], "k_norm": k_norm[i], "w_b_out": w_b_out[i],
            "sgu_ln_g": sgu_ln_g[i], "sgu_ln_b": sgu_ln_b[i],
            "sgu_w": sgu_w[i], "sgu_b": sgu_b[i], "w_c_out": w_c_out[i],
            "pool_w": pool_w[i], "pool_scale": pool_scale[i], "w_d_out": w_d_out[i],
            "w_o": w_o[i], "norm_ffn": norm_ffn[i],
            "w_gate": w_gate[i], "w_up": w_up[i], "w_down": w_down[i],
            "ple_norm": ple_norm[i], "w_ple_gate": w_ple_gate[i], "w_ple": w_ple[i],
        }
        zero_kv = tuple(jnp.zeros((bp, 0, 2, HEADS_PER_GROUP, HEAD_DIM), dt) for _ in DIL_GROUPS)
        yp, nkv, nconv, npool, _ = _layer(
            yp, p_prompt[i],
            jnp.zeros((bp, CONV_STATE, D_CONV), dt), jnp.zeros((bp, POOL_STATE, D_POOL), dt),
            zero_kv, 0, lp, rel_bias)
        for g in range(len(DIL_GROUPS)):
            kvp[g].append(nkv[g])
        conv_p.append(nconv)
        pool_p.append(npool)
        ys, nkv, nconv, npool, nv = _layer(
            ys, p_sample[i], state_conv[i], state_pool[i],
            tuple(c[i] for c in caches), PAST_LEN, lp, rel_bias)
        for g in range(len(DIL_GROUPS)):
            kvs[g].append(nkv[g])
        conv_s.append(nconv)
        pool_s.append(npool)
        sgu_s.append(nv)
    return (yp, ys,
            jnp.stack(kvp[0]), jnp.stack(kvp[1]), jnp.stack(kvp[2]),
            jnp.stack(conv_p), jnp.stack(pool_p),
            jnp.stack(kvs[0]), jnp.stack(kvs[1]), jnp.stack(kvs[2]),
            jnp.stack(conv_s), jnp.stack(pool_s), jnp.stack(sgu_s))
```

```cpp
#include <hip/hip_runtime.h>
#include <hip/hip_cooperative_groups.h>
#include <cstdio>
#include <cstdint>
namespace cg = cooperative_groups;

#ifndef MK_ONE_LAUNCH
#define MK_ONE_LAUNCH 1
#endif

#ifndef REP_P0
#define REP_P0 1
#endif
#ifndef DRY_SUB
#define DRY_SUB -1
#endif
#ifndef P0R_T
#define P0R_T 1
#define P0R_X 1
#define P0R_C 1
#endif
#ifndef REP_Z
#define REP_Z 1
#endif
#ifndef REP_POSTZ
#define REP_POSTZ 1
#endif
#ifndef REP_MIX
#define REP_MIX 1
#endif
#ifndef REP_COMB
#define REP_COMB 1
#endif
#ifndef REP_BR
#define REP_BR 1
#endif
#ifndef REP_GU
#define REP_GU 1
#endif
constexpr int D = 1024, TP = 16384, NSEQ = 32, TS = 8, MP = TP, MS = NSEQ * TS, M = MP + MS;
constexpr int DC = 384, NH = 12, HD = 64, DQ = NH * HD, DFF = 2816, DPLE = 256, DIN = 8320, NZ = 8448, ZP = 4352;
constexpr int ZA = 0, ZB = 384, ZQ = 768, ZK = 1536, ZV = 2304, ZU = 3072, ZVV = 3456, ZD = 3840, ZG = 4224;
constexpr float EPS = 1e-6f, LN_EPS = 1e-5f;
constexpr float LOG2E = 1.4426950408889634f, LN2 = 0.6931471805599453f, ATT_C2 = 12.0f;

constexpr size_t O_YP = 0, O_YS = O_YP + (size_t)MP * D, O_KVP0 = O_YS + (size_t)MS * D,
    O_KVP1 = O_KVP0 + 2ull * 128 * 512, O_KVP2 = O_KVP1 + 2ull * 512 * 512, O_CONVP = O_KVP2 + 2ull * 2048 * 512,
    O_POOLP = O_CONVP + 2ull * 30 * 384, O_KVS0 = O_POOLP + 2ull * 15 * 384, O_KVS1 = O_KVS0 + 2ull * 32 * 128 * 512,
    O_KVS2 = O_KVS1 + 2ull * 32 * 512 * 512, O_CONVS = O_KVS2 + 2ull * 32 * 2048 * 512, O_POOLS = O_CONVS + 2ull * 32 * 30 * 384,
    O_SGUS = O_POOLS + 2ull * 32 * 15 * 384, O_END = O_SGUS + 2ull * 32 * 8 * 384;
static_assert(O_END == 109209344ull, "output size");

constexpr size_t MiB = 1u << 20;
constexpr size_t WS_CTL = 0, CTL_ZERO_BYTES = 1 * MiB;
constexpr size_t WS_W = 2 * MiB, WL = 44 * MiB;
constexpr size_t W_IN = 0, W_A = 17 * MiB, W_B = 18 * MiB, W_C = 19 * MiB, W_D = 20 * MiB, W_O = 21 * MiB, W_GU = 23 * MiB, W_DN = 34 * MiB, W_PG = 40 * MiB, W_PLE = 42 * MiB;
constexpr size_t WS_XB = 90 * MiB;
constexpr size_t WS_XRES = 123 * MiB;
constexpr size_t WS_Z = 188 * MiB;
constexpr size_t WS_ZG8 = 340 * MiB;
static_assert(WS_Z + (size_t)M * ZP * 2 <= WS_ZG8 && WS_ZG8 + (size_t)M * 4096 <= 457 * MiB, "ws map z");
constexpr size_t WS_PEB = 457 * MiB;
constexpr size_t WS_GLU = 474 * MiB;
constexpr size_t WS_QN = 487 * MiB;
constexpr size_t WS_KN = 512 * MiB;
constexpr size_t WS_VLN = 537 * MiB;
constexpr size_t WS_ACTA = 550 * MiB, WS_ACTB = 563 * MiB, WS_ACTC = 572 * MiB, WS_ACTD = 585 * MiB;
constexpr size_t WS_MG = 598 * MiB;
constexpr size_t WS_MGB = 663 * MiB;
constexpr size_t WS_HFF = 696 * MiB;
constexpr size_t WS_PL = 786 * MiB;
constexpr size_t WS_OPART = 852 * MiB;
constexpr size_t WS_LSE = 877 * MiB;
constexpr size_t WS_XB2 = 879 * MiB;
constexpr size_t WS_SGUW = 912 * MiB;
constexpr size_t WS_END = 913 * MiB;
static_assert(WS_XB2 + (size_t)M * D * 2 <= WS_SGUW && WS_SGUW + 2ull * 4 * 128 * 128 * 2 <= WS_END, "ws map 6");
static_assert(WS_OPART + (size_t)M * DQ * 2 <= WS_LSE && WS_LSE + (size_t)M * 12 * 4 <= WS_XB2, "ws map 5");
static_assert(W_IN + (size_t)NZ * D * 2 <= W_A && W_GU + 2ull * DFF * D * 2 <= W_DN && W_DN + (size_t)D * DFF * 2 <= W_PG && W_PLE + (size_t)D * DPLE * 2 <= WL, "weight map");
static_assert(WS_W + 2 * WL <= WS_XB && WS_XB + (size_t)M * D * 2 <= WS_XRES && WS_XRES + (size_t)M * D * 4 <= WS_Z && WS_Z + (size_t)M * ZP * 2 <= WS_PEB, "ws map 1");
static_assert(WS_PEB + 2ull * M * DPLE * 2 <= WS_GLU && WS_GLU + (size_t)M * 384 * 2 <= WS_QN && WS_QN + (size_t)M * DQ * 2 <= WS_KN && WS_KN + (size_t)M * DQ * 2 <= WS_VLN, "ws map 2");
static_assert(WS_VLN + (size_t)M * 384 * 2 <= WS_ACTA && WS_ACTA + (size_t)M * 384 * 2 <= WS_ACTB && WS_ACTB + (size_t)M * 256 * 2 <= WS_ACTC && WS_ACTC + (size_t)M * 384 * 2 <= WS_ACTD, "ws map 3");
static_assert(WS_ACTD + (size_t)M * 384 * 2 <= WS_MG && WS_MG + (size_t)M * D * 4 <= WS_MGB && WS_MGB + (size_t)M * D * 2 <= WS_HFF && WS_HFF + (size_t)M * DFF * 2 <= WS_PL && WS_PL + (size_t)M * D * 4 <= WS_OPART, "ws map 4");
constexpr int RS_STRIDE = 16896;
constexpr int RS_MIX0 = 0, RS_FFN0 = 1, RS_PLE0 = 2, RS_MIX1 = 3, RS_FFN1 = 4, RS_PLE1 = 5;
static_assert(6ull * RS_STRIDE * 4 <= CTL_ZERO_BYTES, "ctl");

constexpr int RING_BYTES = 131072, LDS_BYTES = 147456;

#define LAS __attribute__((address_space(3)))
typedef unsigned short bf16_t;
typedef short bf16x8 __attribute__((ext_vector_type(8)));
typedef float f32x4 __attribute__((ext_vector_type(4)));
typedef float f32x16 __attribute__((ext_vector_type(16)));
typedef float f32x2 __attribute__((ext_vector_type(2)));
typedef unsigned u32x4 __attribute__((ext_vector_type(4)));
typedef unsigned u32x2 __attribute__((ext_vector_type(2)));

__device__ __forceinline__ unsigned cvt_pk_bf16(float lo, float hi) { unsigned r; asm("v_cvt_pk_bf16_f32 %0, %1, %2" : "=v"(r) : "v"(lo), "v"(hi)); return r; }
__device__ __forceinline__ float bf_lo(unsigned w) { return __uint_as_float(w << 16); }
__device__ __forceinline__ float bf_hi(unsigned w) { return __uint_as_float(w & 0xffff0000u); }
__device__ __forceinline__ void unpack8(const u32x4 w, float (&f)[8]) { f[0] = bf_lo(w.x); f[1] = bf_hi(w.x); f[2] = bf_lo(w.y); f[3] = bf_hi(w.y); f[4] = bf_lo(w.z); f[5] = bf_hi(w.z); f[6] = bf_lo(w.w); f[7] = bf_hi(w.w); }
__device__ __forceinline__ u32x4 pack8(const float (&f)[8]) { u32x4 w; w.x = cvt_pk_bf16(f[0], f[1]); w.y = cvt_pk_bf16(f[2], f[3]); w.z = cvt_pk_bf16(f[4], f[5]); w.w = cvt_pk_bf16(f[6], f[7]); return w; }
__device__ __forceinline__ float bf1(bf16_t b) { return __uint_as_float((unsigned)b << 16); }
__device__ __forceinline__ float sigmoidf_(float x) { return __builtin_amdgcn_rcpf(1.0f + __expf(-x)); }
__device__ __forceinline__ float wave_sum(float v) {
#pragma unroll
    for (int o = 1; o < 64; o <<= 1) v += __shfl_xor(v, o);
    return v;
}

namespace pg8 {
#define PG8_LAS __attribute__((address_space(3)))
typedef unsigned short bf16_t;
typedef short bf16x8 __attribute__((ext_vector_type(8)));
typedef float f32x4 __attribute__((ext_vector_type(4)));
typedef unsigned u32x4 __attribute__((ext_vector_type(4)));
constexpr int BM = 256, BK = 64, HALF = 128, HTB = HALF * BK * 2  , STAGE_BYTES = 8 * HTB, NXCD = 8, WGM = 8;

__host__ __device__ __forceinline__ int lds_byte(int r, int c) { const int st = (r >> 4) * 2 + (c >> 5), rr = r & 15, cc = c & 31, ob = rr * 64 + cc * 2; return st * 1024 + (ob ^ (((ob >> 9) & 1) << 5)); }
__host__ __device__ __forceinline__ void stage_rc(int b, int& R, int& C) { const int st = b / 1024, sb = b % 1024, swz = sb ^ (((sb >> 9) & 1) << 5); R = (st >> 1) * 16 + swz / 64; C = (st & 1) * 32 + (swz % 64) / 2; }
__host__ __device__ __forceinline__ int perm32(int rho) { const int n = rho >> 4, i = rho & 15; return 8 * (i >> 2) + 4 * n + (i & 3); }

struct Unit { int pm, pn; };
struct Gemm { const bf16_t* A; const bf16_t* Bt; int M, N, K; };

struct StaticOrder {
    int nM, nN, nwg, G, c;
    __host__ __device__ __forceinline__ void init(int M, int N, int G_, int c_) { nM = M / BM; nN = N / BM; nwg = nM * nN; G = G_; c = c_; }
    __host__ __device__ __forceinline__ bool next(int i, Unit& u) const { return next_at((long)i * G + c, u); }
    __host__ __device__ __forceinline__ bool next_at(long L, Unit& u) const {
        if (L >= nwg) return false;
        int wgid = (int)L; { const int q = nwg / NXCD, r = nwg % NXCD, xcd = wgid % NXCD, off = wgid / NXCD; wgid = (xcd < r ? xcd * (q + 1) : r * (q + 1) + (xcd - r) * q) + off; }
        const int nig = WGM * nN, gid = wgid / nig, fm = gid * WGM, gsz = (nM - fm) < WGM ? (nM - fm) : WGM;
        u.pm = fm + ((wgid % nig) % gsz); u.pn = (wgid % nig) / gsz; return true;
    }
    __device__ __forceinline__ void a_ready(const Unit&) const {}
    __device__ __forceinline__ void done(const Unit&) const {}
};


enum EpiMode { EP_Z = 0, EP_BR_FIRST = 1, EP_BR_MID = 2, EP_BR_LAST = 3, EP_RES = 4, EP_GLU = 5, EP_PL = 6, EP_PLE = 7, EP_BRC = 8 };
struct UnitX;
__device__ __forceinline__ void unpackg8(const u32x2 w, float (&g)[8]) {
#pragma unroll
    for (int j = 0; j < 4; ++j) { g[j] = (float)((w.x >> (8 * j)) & 0xffu) + 0.5f; g[4 + j] = (float)((w.y >> (8 * j)) & 0xffu) + 0.5f; }
}
struct Epi {
    static constexpr bool PERM = true, AFTER_DRAIN = false;
    int mode;
    const float* rowss;
    bf16_t* ob; int ldb;
    float* of;
    const float* rin_p; const float* rin_s;
    const bf16_t* rin_b;
    float* rs_out;
    unsigned char* gate8;
    const bf16_t* pl;
    float* mg;
    __device__ __forceinline__ bool needs_rstd() const { return mode == EP_Z || mode == EP_PLE || mode == EP_GLU; }
    __device__ __forceinline__ float row_rstd(int row) const { return rsqrtf(rowss[row] * (1.0f / 1024.0f) + EPS); }
    __device__ __forceinline__ const float* res_base(int row) const { return (row < MP) ? rin_p : (rin_s - (size_t)MP * 1024); }
    __device__ __forceinline__ float epi8(int row, int col, f32x4 v0, f32x4 v1, float r, const float* rbase) const {
        float ss = 0.f;
        if (mode == EP_Z) {
            v0 *= r; v1 *= r;
            if (col < ZG) {
                u32x4 w; w.x = cvt_pk_bf16(v0[0], v0[1]); w.y = cvt_pk_bf16(v0[2], v0[3]); w.z = cvt_pk_bf16(v1[0], v1[1]); w.w = cvt_pk_bf16(v1[2], v1[3]);
                *(u32x4*)(ob + (size_t)row * ldb + col) = w;
            } else if (col < DIN) {
                unsigned q[8];
#pragma unroll
                for (int j = 0; j < 4; ++j) { q[j] = (unsigned)(sigmoidf_(v0[j]) * 256.0f); q[4 + j] = (unsigned)(sigmoidf_(v1[j]) * 256.0f); }
#pragma unroll
                for (int j = 0; j < 8; ++j) q[j] = q[j] > 255u ? 255u : q[j];
                u32x2 w; w.x = q[0] | (q[1] << 8) | (q[2] << 16) | (q[3] << 24); w.y = q[4] | (q[5] << 8) | (q[6] << 16) | (q[7] << 24);
                *(u32x2*)(gate8 + (size_t)row * 4096 + (col - ZG)) = w;
            }
        } else if (mode == EP_BR_FIRST || mode == EP_BR_MID || mode == EP_BR_LAST) {
            float g[8]; unpackg8(*(const u32x2*)(gate8 + (size_t)row * 4096 + col), g);
#pragma unroll
            for (int j = 0; j < 8; ++j) g[j] *= (1.0f / 256.0f);
            v0[0] *= g[0]; v0[1] *= g[1]; v0[2] *= g[2]; v0[3] *= g[3];
            v1[0] *= g[4]; v1[1] *= g[5]; v1[2] *= g[6]; v1[3] *= g[7];
            float* mp = mg + (size_t)row * 1024 + col;
            if (mode != EP_BR_FIRST) { v0 += *(const f32x4*)mp; v1 += *(const f32x4*)(mp + 4); }
            if (mode != EP_BR_LAST) { *(f32x4*)mp = v0; *(f32x4*)(mp + 4) = v1; }
            else {
                u32x4 w; w.x = cvt_pk_bf16(v0[0], v0[1]); w.y = cvt_pk_bf16(v0[2], v0[3]); w.z = cvt_pk_bf16(v1[0], v1[1]); w.w = cvt_pk_bf16(v1[2], v1[3]);
                *(u32x4*)(ob + (size_t)row * ldb + col) = w;
            }
        } else if (mode == EP_RES || mode == EP_PLE) {
            f32x4 x0, x1;
            if (rin_b) { float xr[8]; unpack8(*(const u32x4*)(rin_b + (size_t)row * 1024 + col), xr); x0 = (f32x4){xr[0], xr[1], xr[2], xr[3]}; x1 = (f32x4){xr[4], xr[5], xr[6], xr[7]}; }
            else { const float* rp = rbase + (size_t)row * 1024 + col; x0 = *(const f32x4*)rp; x1 = *(const f32x4*)(rp + 4); }
            if (mode == EP_PLE) {
                float p[8]; unpack8(*(const u32x4*)(pl + (size_t)row * 1024 + col), p);
                v0[0] = p[0] * sigmoidf_(v0[0] * r); v0[1] = p[1] * sigmoidf_(v0[1] * r); v0[2] = p[2] * sigmoidf_(v0[2] * r); v0[3] = p[3] * sigmoidf_(v0[3] * r);
                v1[0] = p[4] * sigmoidf_(v1[0] * r); v1[1] = p[5] * sigmoidf_(v1[1] * r); v1[2] = p[6] * sigmoidf_(v1[2] * r); v1[3] = p[7] * sigmoidf_(v1[3] * r);
            }
            x0 += v0; x1 += v1;
            if (of) { float* op = of + (size_t)row * 1024 + col; *(f32x4*)op = x0; *(f32x4*)(op + 4) = x1; }
            if (ob) {
                u32x4 w; w.x = cvt_pk_bf16(x0[0], x0[1]); w.y = cvt_pk_bf16(x0[2], x0[3]); w.z = cvt_pk_bf16(x1[0], x1[1]); w.w = cvt_pk_bf16(x1[2], x1[3]);
                *(u32x4*)(ob + (size_t)row * ldb + col) = w;
            }
            ss = (x0[0] * x0[0] + x0[1] * x0[1]) + (x0[2] * x0[2] + x0[3] * x0[3]) + (x1[0] * x1[0] + x1[1] * x1[1]) + (x1[2] * x1[2] + x1[3] * x1[3]);
        } else {
            u32x4 w; w.x = cvt_pk_bf16(v0[0], v0[1]); w.y = cvt_pk_bf16(v0[2], v0[3]); w.z = cvt_pk_bf16(v1[0], v1[1]); w.w = cvt_pk_bf16(v1[2], v1[3]);
            *(u32x4*)(ob + (size_t)row * ldb + col) = w;
        }
        return ss;
    }
    template <class U>
    __device__ __forceinline__ void rescale(f32x4 (&acc)[2][2][4][2], const U& u, int wr, int wc, int fr, int fq) const {
        const int rowb = u.pm * BM + wr * 64 + fr;
        const int colb = u.pn * BM + wc * 32 + 8 * fq;
        const bool zero = u.zero_after;
        const unsigned char* gb = gate8 + u.seg * 1024;
#pragma unroll
        for (int ai = 0; ai < 2; ++ai)
#pragma unroll
            for (int m = 0; m < 4; ++m) {
                const int row = rowb + ai * HALF + m * 16;
#pragma unroll
                for (int bj = 0; bj < 2; ++bj) {
                    f32x4 r0 = {0.f, 0.f, 0.f, 0.f}, r1 = {0.f, 0.f, 0.f, 0.f};
                    if (!zero) {
                        const unsigned char* gp = gb + (size_t)row * 4096 + colb + bj * HALF;
                        float g0[8], g1[8]; unpackg8(*(const u32x2*)gp, g0); unpackg8(*(const u32x2*)(gp + 1024), g1);
#pragma unroll
                        for (int j = 0; j < 4; ++j) { r0[j] = g0[j] * __builtin_amdgcn_rcpf(g1[j]); r1[j] = g0[4 + j] * __builtin_amdgcn_rcpf(g1[4 + j]); }
                    }
                    acc[ai][bj][m][0] = acc[ai][bj][m][0] * r0; acc[ai][bj][m][1] = acc[ai][bj][m][1] * r1;
                }
            }
    }
    __device__ __forceinline__ void brc_store(const f32x4 (&acc)[2][2][4][2], int seg, int rowb, int colb) const {
        const unsigned char* gb = gate8 + seg * 1024 + colb;
        u32x2 cg[2];
#define BRS_LOAD(I, G) do { const unsigned char* _gp = gb + (size_t)(rowb + ((I) >> 2) * HALF + ((I) & 3) * 16) * 4096; (G)[0] = *(const u32x2*)_gp; (G)[1] = *(const u32x2*)(_gp + HALF); } while (0)
        BRS_LOAD(0, cg);
#pragma unroll
        for (int i = 0; i < 8; ++i) {
            u32x2 ng[2];
            if (i < 7) BRS_LOAD(i + 1, ng);
            const int ai = i >> 2, m = i & 3;
            const int row = rowb + ai * HALF + m * 16;
#pragma unroll
            for (int bj = 0; bj < 2; ++bj) {
                float g0[8]; unpackg8(cg[bj], g0);
#pragma unroll
                for (int j = 0; j < 8; ++j) g0[j] *= (1.0f / 256.0f);
                const f32x4 v0 = acc[ai][bj][m][0], v1 = acc[ai][bj][m][1];
                u32x4 w; w.x = cvt_pk_bf16(v0[0] * g0[0], v0[1] * g0[1]); w.y = cvt_pk_bf16(v0[2] * g0[2], v0[3] * g0[3]); w.z = cvt_pk_bf16(v1[0] * g0[4], v1[1] * g0[5]); w.w = cvt_pk_bf16(v1[2] * g0[6], v1[3] * g0[7]);
                *(u32x4*)(ob + (size_t)row * ldb + colb + bj * HALF) = w;
            }
            if (i < 7) { cg[0] = ng[0]; cg[1] = ng[1]; }
            asm volatile("" ::: "memory");
        }
#undef BRS_LOAD
    }
    template <bool BFRES, bool PLE>
    __device__ __forceinline__ void res_loop(const f32x4 (&acc)[2][2][4][2], int rowb, int colb, int fq, const float (&rs8)[8]) const {
        const float* rbase = res_base(rowb);
        const bool ssq = rs_out != nullptr;
        u32x4 cb[2], cp[2]; f32x4 cf[2][2];
#define RES_LOAD(I, B, F, P) do { const int _row = rowb + ((I) >> 2) * HALF + ((I) & 3) * 16; _Pragma("unroll") for (int _bj = 0; _bj < 2; ++_bj) { const size_t _o = (size_t)_row * 1024 + colb + _bj * HALF; \
            if constexpr (BFRES) (B)[_bj] = *(const u32x4*)(rin_b + _o); else { (F)[_bj][0] = *(const f32x4*)(rbase + _o); (F)[_bj][1] = *(const f32x4*)(rbase + _o + 4); } \
            if constexpr (PLE) (P)[_bj] = *(const u32x4*)(pl + _o); } } while (0)
        RES_LOAD(0, cb, cf, cp);
#pragma unroll
        for (int i = 0; i < 8; ++i) {
            u32x4 nb[2], np[2]; f32x4 nf[2][2];
            if (i < 7) RES_LOAD(i + 1, nb, nf, np);
            const int ai = i >> 2, m = i & 3;
            const int row = rowb + ai * HALF + m * 16;
            const float r = rs8[i];
            float ss = 0.f;
#pragma unroll
            for (int bj = 0; bj < 2; ++bj) {
                const int col = colb + bj * HALF;
                f32x4 x0, x1;
                if constexpr (BFRES) { float xr[8]; unpack8(cb[bj], xr); x0 = (f32x4){xr[0], xr[1], xr[2], xr[3]}; x1 = (f32x4){xr[4], xr[5], xr[6], xr[7]}; }
                else { x0 = cf[bj][0]; x1 = cf[bj][1]; }
                f32x4 v0 = acc[ai][bj][m][0], v1 = acc[ai][bj][m][1];
                if constexpr (PLE) {
                    float p[8]; unpack8(cp[bj], p);
                    v0[0] = p[0] * sigmoidf_(v0[0] * r); v0[1] = p[1] * sigmoidf_(v0[1] * r); v0[2] = p[2] * sigmoidf_(v0[2] * r); v0[3] = p[3] * sigmoidf_(v0[3] * r);
                    v1[0] = p[4] * sigmoidf_(v1[0] * r); v1[1] = p[5] * sigmoidf_(v1[1] * r); v1[2] = p[6] * sigmoidf_(v1[2] * r); v1[3] = p[7] * sigmoidf_(v1[3] * r);
                }
                x0 += v0; x1 += v1;
                if (of) { float* op = of + (size_t)row * 1024 + col; *(f32x4*)op = x0; *(f32x4*)(op + 4) = x1; }
                if (ob) {
                    u32x4 w; w.x = cvt_pk_bf16(x0[0], x0[1]); w.y = cvt_pk_bf16(x0[2], x0[3]); w.z = cvt_pk_bf16(x1[0], x1[1]); w.w = cvt_pk_bf16(x1[2], x1[3]);
                    *(u32x4*)(ob + (size_t)row * ldb + col) = w;
                }
                ss += (x0[0] * x0[0] + x0[1] * x0[1]) + (x0[2] * x0[2] + x0[3] * x0[3]) + (x1[0] * x1[0] + x1[1] * x1[1]) + (x1[2] * x1[2] + x1[3] * x1[3]);
            }
            if (ssq) { ss += __shfl_xor(ss, 16); ss += __shfl_xor(ss, 32); if (fq == 0) unsafeAtomicAdd(rs_out + row, ss); }
            if (i < 7) {
#pragma unroll
                for (int bj = 0; bj < 2; ++bj) { cb[bj] = nb[bj]; cp[bj] = np[bj]; cf[bj][0] = nf[bj][0]; cf[bj][1] = nf[bj][1]; }
            }
            asm volatile("" ::: "memory");
        }
#undef RES_LOAD
    }
    template <class U>
    __device__ __forceinline__ void operator()(const f32x4 (&acc)[2][2][4][2], const U& u, int wr, int wc, int fr, int fq) const {
        const int rowb = u.pm * BM + wr * 64 + fr;
        const int colb = u.pn * BM + wc * 32 + 8 * fq;
        if (mode == EP_BRC) { brc_store(acc, u.seg, rowb, colb); return; }
        float rs8[8];
        if (needs_rstd()) {
#pragma unroll
            for (int i = 0; i < 8; ++i) rs8[i] = rowss[rowb + (i >> 2) * HALF + (i & 3) * 16];
            __builtin_amdgcn_sched_barrier(0);
#pragma unroll
            for (int i = 0; i < 8; ++i) rs8[i] = rsqrtf(rs8[i] * (1.0f / 1024.0f) + EPS);
        } else {
#pragma unroll
            for (int i = 0; i < 8; ++i) rs8[i] = 1.0f;
        }
        if (mode == EP_GLU) {
            const int colh = u.pn * HALF + wc * 32 + 8 * fq;
#pragma unroll
            for (int ai = 0; ai < 2; ++ai)
#pragma unroll
                for (int m = 0; m < 4; ++m) {
                    const int row = rowb + ai * HALF + m * 16;
                    const float r = rs8[ai * 4 + m];
                    float h[8];
#pragma unroll
                    for (int n = 0; n < 2; ++n)
#pragma unroll
                        for (int j = 0; j < 4; ++j) { const float g = acc[ai][0][m][n][j] * r, uu = acc[ai][1][m][n][j] * r; h[4 * n + j] = g * sigmoidf_(g) * uu; }
                    *(u32x4*)(ob + (size_t)row * ldb + colh) = pack8(h);
                }
            return;
        }
        if (mode == EP_RES) { if (rin_b) res_loop<true, false>(acc, rowb, colb, fq, rs8); else res_loop<false, false>(acc, rowb, colb, fq, rs8); return; }
        if (mode == EP_PLE) { res_loop<true, true>(acc, rowb, colb, fq, rs8); return; }
#pragma unroll
        for (int ai = 0; ai < 2; ++ai)
#pragma unroll
            for (int m = 0; m < 4; ++m) {
                const int row = rowb + ai * HALF + m * 16;
#pragma unroll
                for (int bj = 0; bj < 2; ++bj) (void)epi8(row, colb + bj * HALF, acc[ai][bj][m][0], acc[ai][bj][m][1], rs8[ai * 4 + m], nullptr);
            }
    }
};


struct UnitX { int pm, pn; const bf16_t* A; const bf16_t* Bt; int K; int seg; bool zero_after; };
template <class Epi, class Sched, bool ALIGN_EPI = false>
__device__ __forceinline__ void gemm_phase(PG8_LAS unsigned char* lds, const Sched& S, const Epi& E, const int tid) {
    const int wid = __builtin_amdgcn_readfirstlane(tid >> 6), lane = tid & 63, wr = wid >> 2, wc = wid & 3, fr = lane & 15, fq = lane >> 4;
    const size_t kstep = (size_t)(BK * 2);
    const unsigned ldsw = (unsigned)wid * 1024u;
    const int aoff = lds_byte(wr * 64 + fr, fq * 8), boff = lds_byte(wc * 32 + fr, fq * 8);
#define PG8_SA(b, h) (((b) * 2 + (h)) * HTB)
#define PG8_SB(b, h) ((4 + (b) * 2 + (h)) * HTB)
#define PG8_STAGE(bufoff, gbase, voff) do { _Pragma("unroll") for (int _i = 0; _i < 2; ++_i) \
        __builtin_amdgcn_global_load_lds((const unsigned*)((const char*)(gbase) + (voff)[_i]), (PG8_LAS unsigned*)(lds + (bufoff) + ldsw + _i * 8192), 16, 0, 0); } while (0)
#define PG8_VOFF(KK, vA, vB) do { int _t = tid; asm volatile("" : "+v"(_t)); _Pragma("unroll") for (int _i = 0; _i < 2; ++_i) { int _R, _C; stage_rc(_t * 16 + _i * 8192, _R, _C); \
        const int _Rb = Epi::PERM ? ((_R & ~31) + perm32(_R & 31)) : _R; (vA)[_i] = (unsigned)(_R * (KK) + _C) * 2u; (vB)[_i] = (unsigned)(_Rb * (KK) + _C) * 2u; } } while (0)
#define PG8_LDA(dst, b, h) do { _Pragma("unroll") for (int m = 0; m < 4; ++m) _Pragma("unroll") for (int k = 0; k < 2; ++k) dst[m][k] = *(const PG8_LAS bf16x8*)(lds + PG8_SA(b, h) + aoff + m * 2048 + k * 1024); } while (0)
#define PG8_LDB(dst, b, h) do { _Pragma("unroll") for (int n = 0; n < 2; ++n) _Pragma("unroll") for (int k = 0; k < 2; ++k) dst[n][k] = *(const PG8_LAS bf16x8*)(lds + PG8_SB(b, h) + boff + n * 2048 + k * 1024); } while (0)
#define PG8_MMA(ai, bj, At, Bt) do { __builtin_amdgcn_s_setprio(1); _Pragma("unroll") for (int m = 0; m < 4; ++m) _Pragma("unroll") for (int n = 0; n < 2; ++n) _Pragma("unroll") for (int k = 0; k < 2; ++k) \
        acc[ai][bj][m][n] = __builtin_amdgcn_mfma_f32_16x16x32_bf16(Bt[n][k], At[m][k], acc[ai][bj][m][n], 0, 0, 0); __builtin_amdgcn_s_setprio(0); } while (0)
#define PG8_WAIT_V(n) asm volatile("s_waitcnt vmcnt(" #n ")" ::: "memory")
#define PG8_WAIT_L(n) asm volatile("s_waitcnt lgkmcnt(" #n ")" ::: "memory")
#define PG8_BAR __builtin_amdgcn_s_barrier()
#define PG8_SCHED __builtin_amdgcn_sched_barrier(0)
#define PG8_SETUNIT(u, pA, pB, hs) do { (hs) = (size_t)HALF * (u).K * 2; (pA) = (const char*)(u).A + (size_t)(u).pm * 2 * (hs); (pB) = (const char*)(u).Bt + (size_t)(u).pn * 2 * (hs); } while (0)
    UnitX cur, nxt; int ui = 0;
    if (!S.next(0, cur)) return;
    f32x4 acc[2][2][4][2];
#pragma unroll
    for (int a = 0; a < 2; ++a)
#pragma unroll
        for (int b = 0; b < 2; ++b)
#pragma unroll
            for (int m = 0; m < 4; ++m)
#pragma unroll
                for (int n = 0; n < 2; ++n) acc[a][b][m][n] = (f32x4){0.f, 0.f, 0.f, 0.f};
    bf16x8 At[4][2], B0[2][2], B1[2][2];
    const char* cA; const char* cB; size_t hstep;
    PG8_SETUNIT(cur, cA, cB, hstep);
    int cK = cur.K;
    unsigned voffA[2], voffB[2];
    PG8_VOFF(cK, voffA, voffB);
    PG8_STAGE(PG8_SB(0, 0), cB, voffB); PG8_STAGE(PG8_SB(0, 1), cB + hstep, voffB); PG8_STAGE(PG8_SA(0, 0), cA, voffA); PG8_STAGE(PG8_SA(0, 1), cA + hstep, voffA);
    if (wr == 1) PG8_BAR;
    PG8_WAIT_V(2); PG8_BAR;
    PG8_STAGE(PG8_SB(1, 0), cB + kstep, voffB); PG8_STAGE(PG8_SA(1, 0), cA + kstep, voffA); PG8_STAGE(PG8_SB(1, 1), cB + hstep + kstep, voffB);
    PG8_WAIT_V(6); PG8_BAR;
    for (;;) {
        const bool has_next = S.next(ui + 1, nxt);
        const char* nA = cA; const char* nB = cB; size_t nhstep = hstep; int nK = cK;
        if (has_next) { PG8_SETUNIT(nxt, nA, nB, nhstep); nK = nxt.K; }
        const int nt = cK / BK;
        for (int t = 0; t < nt; t += 2) {
            const bool last = (t == nt - 2);
            const char* a1 = cA + (size_t)(t + 1) * kstep;
            const char* a2 = last ? nA : cA + (size_t)(t + 2) * kstep; const char* b2 = last ? nB : cB + (size_t)(t + 2) * kstep;
            const char* a3 = a2 + kstep; const char* b3 = b2 + kstep;
            PG8_LDB(B0, 0, 0); PG8_LDB(B1, 0, 1); PG8_SCHED; PG8_LDA(At, 0, 0); PG8_STAGE(PG8_SA(1, 1), a1 + hstep, voffA);
            if (last) { PG8_VOFF(nK, voffA, voffB); hstep = nhstep; }
            PG8_WAIT_V(8); PG8_WAIT_L(0); PG8_BAR; PG8_MMA(0, 0, At, B0); PG8_MMA(0, 1, At, B1); PG8_BAR; PG8_SCHED;
            PG8_LDA(At, 0, 1); PG8_STAGE(PG8_SB(0, 0), b2, voffB); PG8_STAGE(PG8_SB(0, 1), b2 + hstep, voffB); PG8_STAGE(PG8_SA(0, 0), a2, voffA);
            PG8_WAIT_V(8); PG8_WAIT_L(0); PG8_BAR; PG8_MMA(1, 0, At, B0); PG8_MMA(1, 1, At, B1); PG8_BAR; PG8_SCHED;
            PG8_LDB(B0, 1, 0); PG8_LDB(B1, 1, 1); PG8_SCHED; PG8_LDA(At, 1, 0); PG8_STAGE(PG8_SA(0, 1), a2 + hstep, voffA);
            PG8_WAIT_V(8); PG8_WAIT_L(0); PG8_BAR; PG8_MMA(0, 0, At, B0); PG8_MMA(0, 1, At, B1); PG8_BAR; PG8_SCHED;
            PG8_LDA(At, 1, 1); PG8_STAGE(PG8_SB(1, 0), b3, voffB); PG8_STAGE(PG8_SB(1, 1), b3 + hstep, voffB); PG8_STAGE(PG8_SA(1, 0), a3, voffA);
            PG8_WAIT_V(8); PG8_WAIT_L(0); PG8_BAR; PG8_MMA(1, 0, At, B0); PG8_MMA(1, 1, At, B1); PG8_BAR; PG8_SCHED;
        }
        if constexpr (ALIGN_EPI) { if (wr == 0) PG8_BAR; }
        if (cur.zero_after) E(acc, cur, wr, wc, fr, fq);
        if (!has_next) break;
        E.rescale(acc, cur, wr, wc, fr, fq);
        cur = nxt; cA = nA; cB = nB; cK = nK;
        ++ui;
        if constexpr (ALIGN_EPI) { if (wr == 1) PG8_BAR; }
    }
    PG8_WAIT_V(0);
    if constexpr (!ALIGN_EPI) { if (wr == 0) PG8_BAR; }
    PG8_BAR;
#undef PG8_SA
#undef PG8_SB
#undef PG8_STAGE
#undef PG8_VOFF
#undef PG8_LDA
#undef PG8_LDB
#undef PG8_MMA
#undef PG8_WAIT_V
#undef PG8_WAIT_L
#undef PG8_BAR
#undef PG8_SCHED
#undef PG8_SETUNIT
}

struct SegSched {
    StaticOrder so; int nseg;
    int split_rounds;
    const bf16_t* A0; const bf16_t* B0; int K0;
    const unsigned char* ws; const unsigned char* wl;
    __device__ __forceinline__ bool next(int i, UnitX& u) const {
        const int q = (nseg == 1) ? i : (i >> 2), sg = (nseg == 1) ? 0 : (i & 3);
        Unit b;
        if (split_rounds > 0) {
            const int c = so.c; long L;
            if (c < 128) L = (q < split_rounds) ? (long)c + 128 * q : (long)128 * split_rounds + c + 256 * (q - split_rounds);
            else L = (long)128 * split_rounds + c + 256 * q;
            if (!so.next_at(L, b)) return false;
        } else if (!so.next(q, b)) return false;
        u.pm = b.pm; u.pn = b.pn; u.seg = sg; u.zero_after = (sg == nseg - 1);
        if (nseg == 1) { u.A = A0; u.Bt = B0; u.K = K0; }
        else {
            const size_t ao = sg == 0 ? WS_ACTA : (sg == 1 ? WS_ACTB : (sg == 2 ? WS_ACTC : WS_ACTD));
            const size_t bo = sg == 0 ? W_A : (sg == 1 ? W_B : (sg == 2 ? W_C : W_D));
            u.A = (const bf16_t*)(ws + ao); u.Bt = (const bf16_t*)(wl + bo); u.K = (sg == 1) ? 256 : 384;
        }
        return true;
    }
};
}


__device__ const unsigned char T5_BUCKET[3][132] = {
 {0,1,2,3,4,5,6,7,8,9,10,11,12,13,14,15,16,16,16,16,16,16,17,17,17,17,17,17,17,17,18,18,18,18,18,18,18,18,18,18,19,19,19,19,19,19,19,19,19,19,19,19,19,19,20,20,20,20,20,20,20,20,20,20,20,20,20,20,20,20,20,20,20,21,21,21,21,21,21,21,21,21,21,21,21,21,21,21,21,21,21,21,21,21,21,21,21,21,21,22,22,22,22,22,22,22,22,22,22,22,22,22,22,22,22,22,22,22,22,22,22,22,22,22,22,22,22,22,22,0,0,0},
 {0,4,8,12,16,16,17,17,18,18,19,19,19,19,20,20,20,20,20,21,21,21,21,21,21,22,22,22,22,22,22,22,22,22,23,23,23,23,23,23,23,23,23,23,23,23,24,24,24,24,24,24,24,24,24,24,24,24,24,24,24,24,25,25,25,25,25,25,25,25,25,25,25,25,25,25,25,25,25,25,25,25,25,26,26,26,26,26,26,26,26,26,26,26,26,26,26,26,26,26,26,26,26,26,26,26,26,26,26,26,26,26,26,27,27,27,27,27,27,27,27,27,27,27,27,27,27,27,27,0,0,0},
 {0,16,18,19,20,21,21,22,22,23,23,23,24,24,24,24,25,25,25,25,25,26,26,26,26,26,26,26,26,27,27,27,27,27,27,27,27,27,27,28,28,28,28,28,28,28,28,28,28,28,28,28,29,29,29,29,29,29,29,29,29,29,29,29,29,29,29,29,29,29,30,30,30,30,30,30,30,30,30,30,30,30,30,30,30,30,30,30,30,30,30,30,30,30,30,31,31,31,31,31,31,31,31,31,31,31,31,31,31,31,31,31,31,31,31,31,31,31,31,31,31,31,31,31,31,31,31,31,31,0,0,0}};

struct Args { const float* in[36]; float* out; unsigned char* ws; int ph_lo, ph_hi; };
typedef const __attribute__((address_space(4))) Args* ArgsP;


enum { IN_XP = 0, IN_XS, IN_C128, IN_C512, IN_C2048, IN_SCONV, IN_SPOOL, IN_PP, IN_PS, IN_RELB, IN_NMIX, IN_WIN, IN_CONVW, IN_CONVB, IN_CLNG, IN_CLNB, IN_WA,
       IN_QN, IN_KN, IN_WB, IN_SLNG, IN_SLNB, IN_SGUW, IN_SGUB, IN_WC, IN_POOLW, IN_POOLS, IN_WD, IN_WO, IN_NFFN, IN_WGATE, IN_WUP, IN_WDOWN, IN_NPLE, IN_WPG, IN_WPLE };

#define LDS_WAIT() asm volatile("s_waitcnt lgkmcnt(0)" ::: "memory")

__device__ __forceinline__ void transpose_item(const float* W, int K, int N, bf16_t* WT, const float* gain, int mode, LAS float* scr, int item, int lane) {
    const int nblk = N / 64, kb = item / nblk, nb = item % nblk, k0 = 64 * kb, n0 = 64 * nb;
    {
        const int kk = lane >> 4, n4 = (lane & 15) * 4;
        f32x4 v[16];
#pragma unroll
        for (int i = 0; i < 16; ++i) v[i] = *(const f32x4*)(W + (size_t)(k0 + kk + 4 * i) * N + n0 + n4);
#pragma unroll
        for (int i = 0; i < 16; ++i) { LAS float* d = scr + (kk + 4 * i) * 65 + n4; d[0] = v[i][0]; d[1] = v[i][1]; d[2] = v[i][2]; d[3] = v[i][3]; }
    }
    LDS_WAIT(); asm volatile("" ::: "memory");
    const int c = lane & 7;
    f32x4 g0 = {1.f, 1.f, 1.f, 1.f}, g1 = {1.f, 1.f, 1.f, 1.f};
    if (gain) { g0 = *(const f32x4*)(gain + k0 + 8 * c); g1 = *(const f32x4*)(gain + k0 + 8 * c + 4); }
#pragma unroll
    for (int j = 0; j < 8; ++j) {
        const int n = (lane >> 3) + 8 * j; const LAS float* s = scr + (8 * c) * 65 + n;
        u32x4 o; o.x = cvt_pk_bf16(s[0 * 65] * g0[0], s[1 * 65] * g0[1]); o.y = cvt_pk_bf16(s[2 * 65] * g0[2], s[3 * 65] * g0[3]); o.z = cvt_pk_bf16(s[4 * 65] * g1[0], s[5 * 65] * g1[1]); o.w = cvt_pk_bf16(s[6 * 65] * g1[2], s[7 * 65] * g1[3]);
        const int nn = n0 + n;
        const int row = (mode == 0) ? nn : ((nn >> 7) * 256 + (nn & 127) + (mode == 2 ? 128 : 0));
        *(u32x4*)(WT + (size_t)row * K + k0 + 8 * c) = o;
    }
    LDS_WAIT(); asm volatile("" ::: "memory");
}

__device__ __forceinline__ void poolfold_item(const float* pw, const float* psc, const float* wd, bf16_t* WT, int item, int lane) {
    const int nb = item / 48, cb = item - nb * 48, c0 = 8 * cb, g = c0 / 96, cl0 = c0 - 96 * g, n = 64 * nb + lane;
    float acc[8];
#pragma unroll
    for (int i = 0; i < 8; ++i) acc[i] = 0.f;
    const float* pwg = pw + (size_t)(g * 96 + cl0) * 96;
    const float* wdg = wd + (size_t)(g * 96) * D + n;
    const float* scg = psc + g * 96;
#pragma unroll 32
    for (int cp = 0; cp < 96; ++cp) {
        const float x = wdg[(size_t)cp * D] * scg[cp];
#pragma unroll
        for (int i = 0; i < 8; ++i) acc[i] += pwg[i * 96 + cp] * x;
    }
    *(u32x4*)(WT + (size_t)n * 384 + c0) = pack8(acc);
}

constexpr int STAG_Q_Z = 224, STAG_Q_GU = 320;
constexpr int STAG_TOT_Z = STAG_Q_Z * (159 * 158 / 2), STAG_TOT_GU = STAG_Q_GU * (106 * 105 / 2), STAG_TOT = 2 * (STAG_TOT_Z + STAG_TOT_GU);
static_assert(2145 - 8 * 256 == 97 && 1430 - 5 * 256 == 150, "stagger geometry");
constexpr int CP_N0 = 64 * (128 - 8) * 128, CP_N1 = 64 * (512 - 8) * 128, CP_N2 = 64 * (2048 - 8) * 128, CP_TOT = CP_N0 + CP_N1 + CP_N2;
__device__ __forceinline__ void cache_copy_addr(ArgsP a, int i, const f32x4*& src, f32x4*& dst) {
    if (i < CP_N0) { constexpr int n4 = 120 * 128; const int ls = i / n4, off = i - ls * n4; src = (const f32x4*)a->in[IN_C128] + (size_t)ls * 128 * 128 + 1024 + off; dst = (f32x4*)(a->out + O_KVS0) + (size_t)ls * 128 * 128 + off; }
    else if (i < CP_N0 + CP_N1) { constexpr int n4 = 504 * 128; const int k = i - CP_N0, ls = k / n4, off = k - ls * n4; src = (const f32x4*)a->in[IN_C512] + (size_t)ls * 512 * 128 + 1024 + off; dst = (f32x4*)(a->out + O_KVS1) + (size_t)ls * 512 * 128 + off; }
    else { constexpr int n4 = 2040 * 128; const int k = i - CP_N0 - CP_N1, ls = k / n4, off = k - ls * n4; src = (const f32x4*)a->in[IN_C2048] + (size_t)ls * 2048 * 128 + 1024 + off; dst = (f32x4*)(a->out + O_KVS2) + (size_t)ls * 2048 * 128 + off; }
}
__device__ __forceinline__ void cache_copy_range(ArgsP a, int lo, int hi, int ith, int nth) {
    constexpr int U = 16;
    for (int i0 = lo + ith; i0 < hi; i0 += U * nth) {
        f32x4 v[U];
#pragma unroll
        for (int k = 0; k < U; ++k) { int i = i0 + k * nth; i = i < hi ? i : hi - 1; const f32x4* src; f32x4* dst; cache_copy_addr(a, i, src, dst); v[k] = __builtin_nontemporal_load(src); }
#pragma unroll
        for (int k = 0; k < U; ++k) { const int i = i0 + k * nth; if (i < hi) { const f32x4* src; f32x4* dst; cache_copy_addr(a, i, src, dst); __builtin_nontemporal_store(v[k], dst); } }
    }
}

__device__ __forceinline__ void p0_prologue(ArgsP a, LAS unsigned char* lds, int tid, int lane, int wave, int NCU, int cu, int part, bool stag_z0_here) {
    const int G = NCU, bid = cu;
    const bool do0 = part != 1, do1 = part != 0;
    unsigned char* ws = a->ws;
    LAS float* scr = (LAS float*)(lds + wave * 16640);
    const int gw = bid * 8 + wave, NGW = G * 8;
    const int gtid = bid * 512 + tid, NT = G * 512;
    constexpr int I_IN = 16 * 130, I_A = 6 * 16, I_B = 4 * 16, I_O = 16 * 16, I_G = 16 * 44, I_DN = 44 * 16, I_PLE = 4 * 16, I_PF = 16 * 48;
    constexpr int I_LAYER = I_IN + 2 * I_A + I_PF + I_B + 2 * I_O + 2 * I_G + I_DN + I_PLE;
    for (int it0 = gw; it0 < 2 * I_LAYER * P0R_T; it0 += NGW) {
        const int it = it0 % (2 * I_LAYER);
        const int l = it / I_LAYER; int r = it - l * I_LAYER;
        const bool crit = (l == 0 && r < I_IN);
        if (crit ? !do0 : !do1) continue;
        unsigned char* wl = ws + WS_W + (size_t)l * WL;
        if (r < I_IN) { transpose_item(a->in[IN_WIN] + (size_t)l * D * DIN, D, DIN, (bf16_t*)(wl + W_IN), a->in[IN_NMIX] + l * D, 0, scr, r, lane); continue; } r -= I_IN;
        if (r < I_A) { transpose_item(a->in[IN_WA] + (size_t)l * 384 * D, 384, D, (bf16_t*)(wl + W_A), nullptr, 0, scr, r, lane); continue; } r -= I_A;
        if (r < I_B) { transpose_item(a->in[IN_WB] + (size_t)l * 256 * D, 256, D, (bf16_t*)(wl + W_B), nullptr, 0, scr, r, lane); continue; } r -= I_B;
        if (r < I_A) { transpose_item(a->in[IN_WC] + (size_t)l * 384 * D, 384, D, (bf16_t*)(wl + W_C), nullptr, 0, scr, r, lane); continue; } r -= I_A;
        if (r < I_PF) { poolfold_item(a->in[IN_POOLW] + (size_t)l * 4 * 96 * 96, a->in[IN_POOLS] + l * 384, a->in[IN_WD] + (size_t)l * 384 * D, (bf16_t*)(wl + W_D), r, lane); continue; } r -= I_PF;
        if (r < I_O) { transpose_item(a->in[IN_WO] + (size_t)l * D * D, D, D, (bf16_t*)(wl + W_O), nullptr, 0, scr, r, lane); continue; } r -= I_O;
        if (r < I_G) { transpose_item(a->in[IN_WGATE] + (size_t)l * D * DFF, D, DFF, (bf16_t*)(wl + W_GU), a->in[IN_NFFN] + l * D, 1, scr, r, lane); continue; } r -= I_G;
        if (r < I_G) { transpose_item(a->in[IN_WUP] + (size_t)l * D * DFF, D, DFF, (bf16_t*)(wl + W_GU), a->in[IN_NFFN] + l * D, 2, scr, r, lane); continue; } r -= I_G;
        if (r < I_DN) { transpose_item(a->in[IN_WDOWN] + (size_t)l * DFF * D, DFF, D, (bf16_t*)(wl + W_DN), nullptr, 0, scr, r, lane); continue; } r -= I_DN;
        if (r < I_O) { transpose_item(a->in[IN_WPG] + (size_t)l * D * D, D, D, (bf16_t*)(wl + W_PG), a->in[IN_NPLE] + l * D, 0, scr, r, lane); continue; } r -= I_O;
        transpose_item(a->in[IN_WPLE] + (size_t)l * DPLE * D, DPLE, D, (bf16_t*)(wl + W_PLE), nullptr, 0, scr, r, lane);
    }
    for (int i = gtid; i < 2 * (NZ - DIN) * D / 8; i += NT) { const int l = i / ((NZ - DIN) * D / 8), o = i - l * ((NZ - DIN) * D / 8);
        if (l == 0 ? !do0 : !do1) continue;
        u32x4 z4 = {0u, 0u, 0u, 0u}; asm volatile("" : "+v"(z4));
        *(u32x4*)(ws + WS_W + (size_t)l * WL + W_IN + ((size_t)DIN * D + (size_t)o * 8) * 2) = z4; }
    float* rs0 = (float*)(ws + WS_CTL) + RS_MIX0 * RS_STRIDE;
    bf16_t* xb = (bf16_t*)(ws + WS_XB);
    if (do0) for (int m0 = gw; m0 < M * P0R_X; m0 += NGW) {
        const int m = m0 % M;
        const float* xr = (m < MP) ? a->in[IN_XP] + (size_t)m * D : a->in[IN_XS] + (size_t)(m - MP) * D;
        f32x4 v[4]; float s = 0.f;
#pragma unroll
        for (int j = 0; j < 4; ++j) { v[j] = ((const f32x4*)xr)[lane + 64 * j]; s += (v[j][0] * v[j][0] + v[j][1] * v[j][1]) + (v[j][2] * v[j][2] + v[j][3] * v[j][3]); }
        s = wave_sum(s);
        if (lane == 0) rs0[m] = s;
#pragma unroll
        for (int j = 0; j < 4; ++j) { u32x2 w; w.x = cvt_pk_bf16(v[j][0], v[j][1]); w.y = cvt_pk_bf16(v[j][2], v[j][3]); ((u32x2*)(xb + (size_t)m * D))[lane + 64 * j] = w; }
    }
    if (!do1) return;
    bf16_t* peb = (bf16_t*)(ws + WS_PEB);
    for (int i = gtid; i < 2 * M * 32; i += NT) {
        const int l = i / (M * 32), rem = i - l * (M * 32), m = rem >> 5, c8 = rem & 31;
        const float* src = (m < MP) ? a->in[IN_PP] + ((size_t)l * MP + m) * DPLE + c8 * 8 : a->in[IN_PS] + ((size_t)l * MS + (m - MP)) * DPLE + c8 * 8;
        const f32x4 p0 = *(const f32x4*)src, p1 = *(const f32x4*)(src + 4);
        u32x4 w; w.x = cvt_pk_bf16(p0[0], p0[1]); w.y = cvt_pk_bf16(p0[2], p0[3]); w.z = cvt_pk_bf16(p1[0], p1[1]); w.w = cvt_pk_bf16(p1[2], p1[3]);
        *(u32x4*)(peb + ((size_t)l * M + m) * DPLE + c8 * 8) = w;
    }
    cache_copy_range(a, STAG_TOT, CP_TOT, gtid, NT);
    if (stag_z0_here) cache_copy_range(a, 0, STAG_TOT_Z, gtid, NT);
    if (!stag_z0_here && part == 2) cache_copy_range(a, 0, STAG_TOT, gtid, NT);
    for (int i = gtid; i < 2 * 4 * 128 * 16; i += NT) {
        const int row = i >> 4, j8 = (i & 15) * 8, ii = row & 127;
        const float* src = a->in[IN_SGUW] + (size_t)row * 128 + j8; const f32x4 p0 = *(const f32x4*)src, p1 = *(const f32x4*)(src + 4);
        float v[8] = {p0[0], p0[1], p0[2], p0[3], p1[0], p1[1], p1[2], p1[3]};
#pragma unroll
        for (int k = 0; k < 8; ++k) v[k] = (j8 + k <= ii) ? v[k] : 0.f;
        *(u32x4*)((bf16_t*)(ws + WS_SGUW) + (size_t)row * 128 + j8) = pack8(v);
    }
    for (int i = gtid; i < 64 * 22 * 96; i += NT) { const int ls = i / (22 * 96), off = i - ls * (22 * 96);
        ((f32x4*)(a->out + O_CONVS))[(size_t)ls * 30 * 96 + off] = ((const f32x4*)a->in[IN_SCONV])[(size_t)ls * 30 * 96 + 8 * 96 + off]; }
    for (int i = gtid; i < 64 * 7 * 96; i += NT) { const int ls = i / (7 * 96), off = i - ls * (7 * 96);
        ((f32x4*)(a->out + O_POOLS))[(size_t)ls * 15 * 96 + off] = ((const f32x4*)a->in[IN_SPOOL])[(size_t)ls * 15 * 96 + 8 * 96 + off]; }
}

__device__ __forceinline__ float* kv_out_ptr(float* out, int g, bool isP, int l, int s, int pos) {
    const int W = 128 << (2 * g);
    const size_t base = isP ? (g == 0 ? O_KVP0 : (g == 1 ? O_KVP1 : O_KVP2)) : (g == 0 ? O_KVS0 : (g == 1 ? O_KVS1 : O_KVS2));
    const size_t seq = isP ? (size_t)l : (size_t)(l * 32 + s);
    return out + base + (seq * W + pos) * 512;
}

struct PzRow { u32x4 La, Lb, Lvv, Lq0, Lk0, Lq1, Lk1; };
__device__ __forceinline__ PzRow postz_load(ArgsP a, int m, int lane) {
    const bf16_t* zr = (const bf16_t*)(a->ws + WS_Z) + (size_t)m * ZP;
    const int lc48 = lane < 48 ? lane : 47, ch1 = 64 + (lane & 31);
    PzRow R;
    R.La = *(const u32x4*)(zr + ZA + 8 * lc48); R.Lb = *(const u32x4*)(zr + ZB + 8 * lc48); R.Lvv = *(const u32x4*)(zr + ZVV + 8 * lc48);
    R.Lq0 = *(const u32x4*)(zr + ZQ + 8 * lane); R.Lk0 = *(const u32x4*)(zr + ZK + 8 * lane); R.Lq1 = *(const u32x4*)(zr + ZQ + 8 * ch1); R.Lk1 = *(const u32x4*)(zr + ZK + 8 * ch1);
    return R;
}
__device__ __forceinline__ u32x4 postz_row(ArgsP a, int l, int m, int lane, const PzRow& R) {
    u32x4 vvpk = {0u, 0u, 0u, 0u};
    unsigned char* ws = a->ws;
    const bf16_t* zr = (const bf16_t*)(ws + WS_Z) + (size_t)m * ZP;
    const bool isP = m < MP; const int t = isP ? m : ((m - MP) & 7); const int s = isP ? 0 : ((m - MP) >> 3);
    const int ch1 = 64 + (lane & 31);
    const u32x4 La = R.La, Lb = R.Lb, Lvv = R.Lvv, Lq0 = R.Lq0, Lk0 = R.Lk0, Lq1 = R.Lq1, Lk1 = R.Lk1;
    if (lane < 48) {
        float av[8], bv[8], g[8]; unpack8(La, av); unpack8(Lb, bv);
#pragma unroll
        for (int i = 0; i < 8; ++i) g[i] = av[i] * sigmoidf_(bv[i]);
        *(u32x4*)((bf16_t*)(ws + WS_GLU) + (size_t)m * 384 + 8 * lane) = pack8(g);
        float* dst = nullptr;
        if (isP) { if (t >= TP - 30) dst = a->out + O_CONVP + ((size_t)l * 30 + (t - (TP - 30))) * 384 + 8 * lane; }
        else dst = a->out + O_CONVS + ((size_t)(l * 32 + s) * 30 + 22 + t) * 384 + 8 * lane;
        if (dst) { *(f32x4*)dst = (f32x4){g[0], g[1], g[2], g[3]}; *(f32x4*)(dst + 4) = (f32x4){g[4], g[5], g[6], g[7]}; }
        float* pd = nullptr;
        if (isP) { if (t >= TP - 15) pd = a->out + O_POOLP + ((size_t)l * 15 + (t - (TP - 15))) * 384 + 8 * lane; }
        else pd = a->out + O_POOLS + ((size_t)(l * 32 + s) * 15 + 7 + t) * 384 + 8 * lane;
        if (pd) { float zd[8]; unpack8(*(const u32x4*)(zr + ZD + 8 * lane), zd); *(f32x4*)pd = (f32x4){zd[0], zd[1], zd[2], zd[3]}; *(f32x4*)(pd + 4) = (f32x4){zd[4], zd[5], zd[6], zd[7]}; }
    }
    const float* qw = a->in[IN_QN] + l * HD; const float* kw = a->in[IN_KN] + l * HD;
#pragma unroll
    for (int it = 0; it < 2; ++it) {
        const int ch = lane + 64 * it; const bool act = ch < 96; const int chc = (it == 0) ? lane : ch1;
        const int h = chc >> 3, dc = (chc & 7) * 8, g = h >> 2, hs = h & 3;
        float q[8], k[8];
        unpack8(it == 0 ? Lq0 : Lq1, q); unpack8(it == 0 ? Lk0 : Lk1, k);
        float sq = 0.f, sk = 0.f;
#pragma unroll
        for (int i = 0; i < 8; ++i) { sq += q[i] * q[i]; sk += k[i] * k[i]; }
        sq += __shfl_xor(sq, 1); sq += __shfl_xor(sq, 2); sq += __shfl_xor(sq, 4);
        sk += __shfl_xor(sk, 1); sk += __shfl_xor(sk, 2); sk += __shfl_xor(sk, 4);
        const float rq = rsqrtf(sq * (1.0f / 64.0f) + EPS) * (0.125f * LOG2E), rk = rsqrtf(sk * (1.0f / 64.0f) + EPS);
        const f32x4 qw0 = *(const f32x4*)(qw + dc), qw1 = *(const f32x4*)(qw + dc + 4), kw0 = *(const f32x4*)(kw + dc), kw1 = *(const f32x4*)(kw + dc + 4);
#pragma unroll
        for (int i = 0; i < 4; ++i) { q[i] *= rq * qw0[i]; q[4 + i] *= rq * qw1[i]; k[i] *= rk * kw0[i]; k[4 + i] *= rk * kw1[i]; }
        if (act) {
            *(u32x4*)((bf16_t*)(ws + WS_QN) + (size_t)m * DQ + 8 * ch) = pack8(q);
            *(u32x4*)((bf16_t*)(ws + WS_KN) + (size_t)m * DQ + 8 * ch) = pack8(k);
            const int W = 128 << (2 * g);
            const int pos = isP ? t - (TP - W) : W - 8 + t;
            if (pos >= 0) {
                float* kvp = kv_out_ptr(a->out, g, isP, l, s, pos) + hs * 64 + dc;
                *(f32x4*)kvp = (f32x4){k[0], k[1], k[2], k[3]}; *(f32x4*)(kvp + 4) = (f32x4){k[4], k[5], k[6], k[7]};
                float v[8]; unpack8(*(const u32x4*)(zr + ZV + 8 * ch), v);
                *(f32x4*)(kvp + 256) = (f32x4){v[0], v[1], v[2], v[3]}; *(f32x4*)(kvp + 260) = (f32x4){v[4], v[5], v[6], v[7]};
            }
        }
    }
    {
        float x[8]; const bool act = lane < 48;
        unpack8(Lvv, x);
        float sm = 0.f;
#pragma unroll
        for (int i = 0; i < 8; ++i) sm += x[i];
        sm = wave_sum(act ? sm : 0.f);
        const float mean = sm * (1.0f / 384.0f);
        float sv = 0.f;
#pragma unroll
        for (int i = 0; i < 8; ++i) { x[i] -= mean; sv += x[i] * x[i]; }
        sv = wave_sum(act ? sv : 0.f);
        const float rstd = rsqrtf(sv * (1.0f / 384.0f) + LN_EPS);
        if (act) {
            const float* gg = a->in[IN_SLNG] + l * 384 + 8 * lane; const float* bb = a->in[IN_SLNB] + l * 384 + 8 * lane;
            const f32x4 g0 = *(const f32x4*)gg, g1 = *(const f32x4*)(gg + 4), b0 = *(const f32x4*)bb, b1 = *(const f32x4*)(bb + 4);
#pragma unroll
            for (int i = 0; i < 4; ++i) { x[i] = x[i] * rstd * g0[i] + b0[i]; x[4 + i] = x[4 + i] * rstd * g1[i] + b1[i]; }
            vvpk = pack8(x);
            if (!isP) *(u32x4*)((bf16_t*)(ws + WS_VLN) + (size_t)m * 384 + 8 * lane) = vvpk;
            if (!isP) { float* sp = a->out + O_SGUS + ((size_t)(l * 32 + s) * 8 + t) * 384 + 8 * lane; *(f32x4*)sp = (f32x4){x[0], x[1], x[2], x[3]}; *(f32x4*)(sp + 4) = (f32x4){x[4], x[5], x[6], x[7]}; }
        }
    }
    return vvpk;
}
__device__ __forceinline__ void postz_rows8(ArgsP a, int l, int m0, int lane) {
    u32x4 pk[8];
    PzRow cur = postz_load(a, m0, lane);
#pragma unroll
    for (int r = 0; r < 8; ++r) {
        PzRow nxt = cur;
        if (r < 7) nxt = postz_load(a, m0 + r + 1, lane);
        __builtin_amdgcn_sched_barrier(0);
        pk[r] = postz_row(a, l, m0 + r, lane, cur);
        cur = nxt;
    }
    if (lane < 48) {
        bf16_t* vt = (bf16_t*)(a->ws + WS_VLN) + ((size_t)(m0 >> 7) * 384 + 8 * lane) * 128 + (m0 & 127);
#define PZ_LO(w) ((w) & 0xffffu)
#define PZ_HI(w) ((w) >> 16)
#define PZ_ROW(sel, comp) (u32x4){ sel(pk[0].comp) | (sel(pk[1].comp) << 16), sel(pk[2].comp) | (sel(pk[3].comp) << 16), sel(pk[4].comp) | (sel(pk[5].comp) << 16), sel(pk[6].comp) | (sel(pk[7].comp) << 16) }
        *(u32x4*)(vt + 0 * 128) = PZ_ROW(PZ_LO, x); *(u32x4*)(vt + 1 * 128) = PZ_ROW(PZ_HI, x);
        *(u32x4*)(vt + 2 * 128) = PZ_ROW(PZ_LO, y); *(u32x4*)(vt + 3 * 128) = PZ_ROW(PZ_HI, y);
        *(u32x4*)(vt + 4 * 128) = PZ_ROW(PZ_LO, z); *(u32x4*)(vt + 5 * 128) = PZ_ROW(PZ_HI, z);
        *(u32x4*)(vt + 6 * 128) = PZ_ROW(PZ_LO, w); *(u32x4*)(vt + 7 * 128) = PZ_ROW(PZ_HI, w);
#undef PZ_LO
#undef PZ_HI
#undef PZ_ROW
    }
}

constexpr int TAB_OFF = 122880;
__device__ __forceinline__ void attn_sample_task(ArgsP a, int l, int m, int h, int lane, const LAS float* tab) {
    unsigned char* ws = a->ws;
    const bf16_t* qn = (const bf16_t*)(ws + WS_QN); const bf16_t* kn = (const bf16_t*)(ws + WS_KN); const bf16_t* z = (const bf16_t*)(ws + WS_Z);
    const int g = h >> 2, hs = h & 3, sh = 2 * g, W = 128 << sh;
    const int t = (m - MP) & 7, s = (m - MP) >> 3;
    const int ks = lane >> 3, c = lane & 7;
    float qf[8]; unpack8(*(const u32x4*)(qn + (size_t)m * DQ + h * 64 + 8 * c), qf);
    const float* cache = a->in[IN_C128 + g] + ((size_t)(l * 32 + s) * W) * 512 + hs * 64 + 8 * c;
    const LAS float* tb = tab + h * 132;
    float sc[17];
    const int tk0 = t - (ks << sh);
    const size_t nrow = (size_t)(MP + 8 * s + (tk0 < 0 ? 0 : tk0));
    const int prow0 = tk0 < 0 ? W + tk0 : W - 1;
    {
        float kf[8]; unpack8(*(const u32x4*)(kn + nrow * DQ + h * 64 + 8 * c), kf);
        const float* p = cache + (size_t)prow0 * 512; const f32x4 x0 = *(const f32x4*)p, x1 = *(const f32x4*)(p + 4);
        if (tk0 < 0) { kf[0] = x0[0]; kf[1] = x0[1]; kf[2] = x0[2]; kf[3] = x0[3]; kf[4] = x1[0]; kf[5] = x1[1]; kf[6] = x1[2]; kf[7] = x1[3]; }
        float d = 0.f;
#pragma unroll
        for (int i = 0; i < 8; ++i) d += qf[i] * kf[i];
        d += __shfl_xor(d, 1); d += __shfl_xor(d, 2); d += __shfl_xor(d, 4);
        sc[0] = d + tb[ks];
    }
#pragma unroll
    for (int hb = 0; hb < 2; ++hb) {
        f32x4 x0[8], x1[8];
#pragma unroll
        for (int q = 0; q < 8; ++q) { const int it = 1 + 8 * hb + q; const int j = it * 8 + ks; const int jj = j <= 128 ? j : 128; const float* p = cache + (size_t)(W + t - (jj << sh)) * 512; x0[q] = *(const f32x4*)p; x1[q] = *(const f32x4*)(p + 4); }
        __builtin_amdgcn_sched_barrier(0);
#pragma unroll
        for (int q = 0; q < 8; ++q) {
            const int it = 1 + 8 * hb + q; const int j = it * 8 + ks; const bool inr = j <= 128; const int jj = inr ? j : 128;
            const f32x4 a0 = x0[q], a1 = x1[q];
            float d = (qf[0] * a0[0] + qf[1] * a0[1]) + (qf[2] * a0[2] + qf[3] * a0[3]) + (qf[4] * a1[0] + qf[5] * a1[1]) + (qf[6] * a1[2] + qf[7] * a1[3]);
            d += __shfl_xor(d, 1); d += __shfl_xor(d, 2); d += __shfl_xor(d, 4);
            d += tb[jj];
            sc[it] = inr ? d : -1.0e30f;
        }
        __builtin_amdgcn_sched_barrier(0);
    }
    float mx = sc[0];
#pragma unroll
    for (int it = 1; it < 17; ++it) mx = fmaxf(mx, sc[it]);
    mx = fmaxf(mx, __shfl_xor(mx, 8)); mx = fmaxf(mx, __shfl_xor(mx, 16)); mx = fmaxf(mx, __shfl_xor(mx, 32));
    float sum = 0.f;
#pragma unroll
    for (int it = 0; it < 17; ++it) { sc[it] = __builtin_amdgcn_exp2f(sc[it] - mx); sum += sc[it]; }
    sum += __shfl_xor(sum, 8); sum += __shfl_xor(sum, 16); sum += __shfl_xor(sum, 32);
    float acc[8];
    {
        float vf[8]; unpack8(*(const u32x4*)(z + nrow * ZP + ZV + h * 64 + 8 * c), vf);
        const float* p = cache + (size_t)prow0 * 512 + 256; const f32x4 x0 = *(const f32x4*)p, x1 = *(const f32x4*)(p + 4);
        if (tk0 < 0) { vf[0] = x0[0]; vf[1] = x0[1]; vf[2] = x0[2]; vf[3] = x0[3]; vf[4] = x1[0]; vf[5] = x1[1]; vf[6] = x1[2]; vf[7] = x1[3]; }
#pragma unroll
        for (int i = 0; i < 8; ++i) acc[i] = sc[0] * vf[i];
    }
#pragma unroll
    for (int hb = 0; hb < 2; ++hb) {
        f32x4 x0[8], x1[8];
#pragma unroll
        for (int q = 0; q < 8; ++q) { const int it = 1 + 8 * hb + q; const int j = it * 8 + ks; const int jj = j <= 128 ? j : 128; const float* p = cache + (size_t)(W + t - (jj << sh)) * 512 + 256; x0[q] = *(const f32x4*)p; x1[q] = *(const f32x4*)(p + 4); }
        __builtin_amdgcn_sched_barrier(0);
#pragma unroll
        for (int q = 0; q < 8; ++q) {
            const float pw = sc[1 + 8 * hb + q]; const f32x4 a0 = x0[q], a1 = x1[q];
            acc[0] += pw * a0[0]; acc[1] += pw * a0[1]; acc[2] += pw * a0[2]; acc[3] += pw * a0[3]; acc[4] += pw * a1[0]; acc[5] += pw * a1[1]; acc[6] += pw * a1[2]; acc[7] += pw * a1[3];
        }
        __builtin_amdgcn_sched_barrier(0);
    }
    const float inv = 1.0f / sum;
#pragma unroll
    for (int i = 0; i < 8; ++i) { float v = acc[i]; v += __shfl_xor(v, 8); v += __shfl_xor(v, 16); v += __shfl_xor(v, 32); acc[i] = v * inv; }
    if (lane < 8) *(u32x4*)((bf16_t*)(ws + WS_OPART) + (size_t)m * DQ + h * 64 + 8 * c) = pack8(acc);
    if (lane == 0) ((float*)(ws + WS_LSE))[(size_t)m * 12 + h] = (mx + __builtin_amdgcn_logf(sum) + ATT_C2) * LN2;
}

constexpr int VSP = 72;
typedef short v4i16_t __attribute__((ext_vector_type(4)));
constexpr int NT_ATTP = 12 * (TP / 32);
__device__ __forceinline__ void attn_mfma_task(ArgsP a, LAS unsigned char* wlds, int l, int task, int lane, const LAS float* tab) {
    unsigned char* ws = a->ws;
    const bf16_t* qn = (const bf16_t*)(ws + WS_QN); const bf16_t* kn = (const bf16_t*)(ws + WS_KN); const bf16_t* z = (const bf16_t*)(ws + WS_Z);
    LAS bf16_t* Vs = (LAS bf16_t*)wlds;
    const int h = task / (TP / 32); const int rem = task - h * (TP / 32);
    const int sh = 2 * (h >> 2);
    const int nb = (TP / 32) >> sh;
    const int r = rem / nb, ib = rem - r * nb;
    const int c = lane & 31, hh = lane >> 5;
    const int tq = ((32 * ib + c) << sh) + r;
    bf16x8 qf[4];
#pragma unroll
    for (int s = 0; s < 4; ++s) qf[s] = *(const bf16x8*)(qn + (size_t)tq * DQ + h * 64 + 16 * s + 8 * hh);
    f32x16 o0, o1;
#pragma unroll
    for (int i = 0; i < 16; ++i) { o0[i] = 0.f; o1[i] = 0.f; }
    float lrun = 0.f;
    const int i0 = 32 * ib - 128;
    const LAS float* tb = tab + h * 132;
    bf16x8 kf[4]; u32x4 vr[4];
    {
        int ik = i0 + c; ik = ik < 0 ? 0 : ik; const size_t tk = ((size_t)ik << sh) + r;
#pragma unroll
        for (int s = 0; s < 4; ++s) kf[s] = *(const bf16x8*)(kn + tk * DQ + h * 64 + 16 * s + 8 * hh);
#pragma unroll
        for (int q = 0; q < 4; ++q) { int ikv = i0 + (lane >> 3) + 8 * q; ikv = ikv < 0 ? 0 : ikv; const size_t tv = ((size_t)ikv << sh) + r;
            vr[q] = *(const u32x4*)(z + tv * ZP + ZV + h * 64 + 8 * (lane & 7)); }
    }
#pragma unroll 1
    for (int kt = 0; kt < 5; ++kt) {
        const int ib0 = i0 + 32 * kt;
        bf16x8 kfn[4]; u32x4 vrn[4];
        { const int ibn = i0 + 32 * (kt < 4 ? kt + 1 : 4);
          int ik = ibn + c; ik = ik < 0 ? 0 : ik; const size_t tk = ((size_t)ik << sh) + r;
#pragma unroll
          for (int s = 0; s < 4; ++s) kfn[s] = *(const bf16x8*)(kn + tk * DQ + h * 64 + 16 * s + 8 * hh);
#pragma unroll
          for (int q = 0; q < 4; ++q) { int ikv = ibn + (lane >> 3) + 8 * q; ikv = ikv < 0 ? 0 : ikv; const size_t tv = ((size_t)ikv << sh) + r;
              vrn[q] = *(const u32x4*)(z + tv * ZP + ZV + h * 64 + 8 * (lane & 7)); }
        }
        const bool need_mask = (kt == 0) || (kt == 4) || (ib < 4);
        f32x16 sa;
        if (need_mask) {
#pragma unroll
            for (int reg = 0; reg < 16; ++reg) { const int kr = (reg & 3) + 8 * (reg >> 2) + 4 * hh; const int j = c + 128 - 32 * kt - kr; const int jj = j < 0 ? 0 : (j > 128 ? 128 : j); sa[reg] = tb[jj]; }
        } else {
            const LAS float* tbl = tb + (c + 128 - 32 * kt - 4 * hh);
#pragma unroll
            for (int reg = 0; reg < 16; ++reg) sa[reg] = tbl[-((reg & 3) + 8 * (reg >> 2))];
        }
#pragma unroll
        for (int s = 0; s < 4; ++s) sa = __builtin_amdgcn_mfma_f32_32x32x16_bf16(kf[s], qf[s], sa, 0, 0, 0);
        if (need_mask) {
#pragma unroll
            for (int reg = 0; reg < 16; ++reg) {
                const int kr = (reg & 3) + 8 * (reg >> 2) + 4 * hh;
                const int j = c + 128 - 32 * kt - kr;
                const bool valid = (j >= 0) && (j <= 128) && (ib0 + kr >= 0);
                sa[reg] = valid ? sa[reg] : -1.0e30f;
            }
        }
        float lsum = 0.f;
#pragma unroll
        for (int reg = 0; reg < 16; ++reg) { const float p = __builtin_amdgcn_exp2f(sa[reg]); sa[reg] = p; lsum += p; }
        lrun += lsum;
#pragma unroll
        for (int q = 0; q < 4; ++q) *(LAS u32x4*)(Vs + ((lane >> 3) + 8 * q) * VSP + 8 * (lane & 7)) = vr[q];
#pragma unroll
        for (int s = 0; s < 2; ++s) {
            u32x4 pw; pw.x = cvt_pk_bf16(sa[8 * s + 0], sa[8 * s + 1]); pw.y = cvt_pk_bf16(sa[8 * s + 2], sa[8 * s + 3]); pw.z = cvt_pk_bf16(sa[8 * s + 4], sa[8 * s + 5]); pw.w = cvt_pk_bf16(sa[8 * s + 6], sa[8 * s + 7]);
            const bf16x8 pf = __builtin_bit_cast(bf16x8, pw);
            const LAS bf16_t* vq = Vs + (16 * s + 4 * hh + ((lane & 15) >> 2)) * VSP + 16 * ((lane >> 4) & 1) + 4 * (lane & 3);
            {   const v4i16_t lo = __builtin_amdgcn_ds_read_tr16_b64_v4i16((LAS v4i16_t*)vq), hi = __builtin_amdgcn_ds_read_tr16_b64_v4i16((LAS v4i16_t*)(vq + 8 * VSP));
                const bf16x8 af = {lo[0], lo[1], lo[2], lo[3], hi[0], hi[1], hi[2], hi[3]};
                o0 = __builtin_amdgcn_mfma_f32_32x32x16_bf16(af, pf, o0, 0, 0, 0); }
            {   const v4i16_t lo = __builtin_amdgcn_ds_read_tr16_b64_v4i16((LAS v4i16_t*)(vq + 32)), hi = __builtin_amdgcn_ds_read_tr16_b64_v4i16((LAS v4i16_t*)(vq + 8 * VSP + 32));
                const bf16x8 af = {lo[0], lo[1], lo[2], lo[3], hi[0], hi[1], hi[2], hi[3]};
                o1 = __builtin_amdgcn_mfma_f32_32x32x16_bf16(af, pf, o1, 0, 0, 0); }
        }
#pragma unroll
        for (int s = 0; s < 4; ++s) { kf[s] = kfn[s]; vr[s] = vrn[s]; }
    }
    const float ltot = lrun + __shfl_xor(lrun, 32);
    const float inv = 1.0f / ltot;
    bf16_t* op = (bf16_t*)(ws + WS_OPART) + (size_t)tq * DQ + h * 64 + 4 * hh;
#pragma unroll
    for (int q4 = 0; q4 < 4; ++q4) {
        u32x2 w0; w0.x = cvt_pk_bf16(o0[4 * q4 + 0] * inv, o0[4 * q4 + 1] * inv); w0.y = cvt_pk_bf16(o0[4 * q4 + 2] * inv, o0[4 * q4 + 3] * inv);
        u32x2 w1; w1.x = cvt_pk_bf16(o1[4 * q4 + 0] * inv, o1[4 * q4 + 1] * inv); w1.y = cvt_pk_bf16(o1[4 * q4 + 2] * inv, o1[4 * q4 + 3] * inv);
        *(u32x2*)(op + 8 * q4) = w0; *(u32x2*)(op + 32 + 8 * q4) = w1;
    }
    if (hh == 0) ((float*)(ws + WS_LSE))[(size_t)tq * 12 + h] = (__builtin_amdgcn_logf(ltot) + ATT_C2) * LN2;
}

struct CbRow { float l0, l1, l2; u32x2 w0, w1, w2; };
__device__ __forceinline__ CbRow combine_load(ArgsP a, int m, int lane) {
    unsigned char* ws = a->ws;
    const int hs = lane >> 4, d4 = 4 * (lane & 15);
    const float* ls = (const float*)(ws + WS_LSE) + (size_t)m * 12 + hs;
    const bf16_t* op = (const bf16_t*)(ws + WS_OPART) + (size_t)m * DQ + hs * 64 + d4;
    CbRow R; R.l0 = ls[0]; R.l1 = ls[4]; R.l2 = ls[8]; R.w0 = *(const u32x2*)op; R.w1 = *(const u32x2*)(op + 256); R.w2 = *(const u32x2*)(op + 512);
    return R;
}
__device__ __forceinline__ void combine_row(ArgsP a, int m, int lane, const CbRow& R) {
    unsigned char* ws = a->ws;
    const int hs = lane >> 4, d4 = 4 * (lane & 15);
    const float l0 = R.l0, l1 = R.l1, l2 = R.l2;
    const float mx = fmaxf(l0, fmaxf(l1, l2));
    float e0 = __expf(l0 - mx), e1 = __expf(l1 - mx), e2 = __expf(l2 - mx);
    const float inv = 1.0f / (e0 + e1 + e2); e0 *= inv; e1 *= inv; e2 *= inv;
    const u32x2 w0 = R.w0, w1 = R.w1, w2 = R.w2;
    const float r0 = e0 * bf_lo(w0.x) + e1 * bf_lo(w1.x) + e2 * bf_lo(w2.x), r1 = e0 * bf_hi(w0.x) + e1 * bf_hi(w1.x) + e2 * bf_hi(w2.x);
    const float r2 = e0 * bf_lo(w0.y) + e1 * bf_lo(w1.y) + e2 * bf_lo(w2.y), r3 = e0 * bf_hi(w0.y) + e1 * bf_hi(w1.y) + e2 * bf_hi(w2.y);
    u32x2 o; o.x = cvt_pk_bf16(r0, r1); o.y = cvt_pk_bf16(r2, r3);
    *(u32x2*)((bf16_t*)(ws + WS_ACTB) + (size_t)m * 256 + hs * 64 + d4) = o;
}

constexpr int CT = 32;
template <bool EDGE>
__device__ __forceinline__ void convpool_unit(ArgsP a, LAS unsigned char* lds, int l, int mbase, int s, int t0, int nt, int tid, int lane, int wave) {
    unsigned char* ws = a->ws;
    LAS bf16_t* Gs = (LAS bf16_t*)lds;
    LAS float* CV = (LAS float*)lds;
    LAS bf16_t* Zs = (LAS bf16_t*)(lds + 49152);
    const bf16_t* glub = (const bf16_t*)(ws + WS_GLU) + (size_t)mbase * 384;
    const bf16_t* zd = (const bf16_t*)(ws + WS_Z) + (size_t)mbase * ZP + ZD;
    float w[31]; float cb = 0.f;
    if (tid < 384) {
        const float* cw = a->in[IN_CONVW] + (size_t)l * 31 * 384 + tid;
#pragma unroll
        for (int k = 0; k < 31; ++k) w[k] = cw[k * 384];
        cb = a->in[IN_CONVB][l * 384 + tid];
    }
    __builtin_amdgcn_sched_barrier(0);
    if constexpr (!EDGE) {
        constexpr int NCH = (62 + 47) * 48, NIT = (NCH + 511) / 512;
        u32x4 v[NIT];
#pragma unroll
        for (int k = 0; k < NIT; ++k) {
            int i = tid + 512 * k; i = i < NCH ? i : NCH - 1;
            const bool isg = i < 62 * 48; const int kk = isg ? i : i - 62 * 48; const int r = kk / 48, c8 = kk - r * 48;
            v[k] = isg ? *(const u32x4*)(glub + (size_t)(t0 - 30 + r) * 384 + 8 * c8) : *(const u32x4*)(zd + (size_t)(t0 - 15 + r) * ZP + 8 * c8);
        }
#pragma unroll
        for (int k = 0; k < NIT; ++k) {
            const int i = tid + 512 * k;
            if (i < NCH) { const bool isg = i < 62 * 48; const int kk = isg ? i : i - 62 * 48; const int r = kk / 48, c8 = kk - r * 48; *(LAS u32x4*)((isg ? Gs : Zs) + r * 384 + 8 * c8) = v[k]; }
        }
    } else {
        for (int i = tid; i < (62 + 47) * 48; i += 512) {
            const bool isg = i < 62 * 48; const int k = isg ? i : i - 62 * 48; const int r = k / 48, c8 = k - r * 48;
            const int tt = isg ? t0 - 30 + r : t0 - 15 + r;
            u32x4 v = {0u, 0u, 0u, 0u};
            if (tt >= 0) { if (tt < t0 + nt) v = isg ? *(const u32x4*)(glub + (size_t)tt * 384 + 8 * c8) : *(const u32x4*)(zd + (size_t)tt * ZP + 8 * c8); }
            else if (s >= 0) {
                const float* p = isg ? a->in[IN_SCONV] + ((size_t)(l * 32 + s) * 30 + 30 + tt) * 384 + 8 * c8 : a->in[IN_SPOOL] + ((size_t)(l * 32 + s) * 15 + 15 + tt) * 384 + 8 * c8;
                const f32x4 x0 = *(const f32x4*)p, x1 = *(const f32x4*)(p + 4);
                v.x = cvt_pk_bf16(x0[0], x0[1]); v.y = cvt_pk_bf16(x0[2], x0[3]); v.z = cvt_pk_bf16(x1[0], x1[1]); v.w = cvt_pk_bf16(x1[2], x1[3]);
            }
            *(LAS u32x4*)((isg ? Gs : Zs) + r * 384 + 8 * c8) = v;
        }
    }
    __syncthreads();
    if (tid < 384) {
        const int c = tid;
        float x[CT + 30];
#pragma unroll
        for (int r = 0; r < CT + 30; ++r) x[r] = bf1(Gs[r * 384 + c]);
        asm volatile("s_waitcnt lgkmcnt(0)" ::: "memory");
        __syncthreads();
#pragma unroll
        for (int q = 0; q < CT; ++q) {
            float acc = cb;
#pragma unroll
            for (int k = 0; k < 31; ++k) acc += w[k] * x[q + k];
            CV[q * 384 + c] = acc;
        }
    } else {
        __syncthreads();
        const int c0 = tid - 384;
#pragma unroll 1
        for (int q3 = 0; q3 < 3; ++q3) {
            const int c = c0 + 128 * q3, wg = c / 96;
            float x[CT + 15];
#pragma unroll
            for (int r = 0; r < CT + 15; ++r) x[r] = bf1(Zs[r * 384 + c]);
            float lv[CT + 15], res[CT];
#pragma unroll
            for (int i = 0; i < CT + 15; ++i) lv[i] = x[i];
#pragma unroll
            for (int i = CT + 14; i >= 1; --i) lv[i] += lv[i - 1];
#pragma unroll
            for (int q = 0; q < CT; ++q) res[q] = lv[15 + q];
#pragma unroll
            for (int i = CT + 14; i >= 2; --i) lv[i] += lv[i - 2];
#pragma unroll
            for (int q = 0; q < CT; ++q) res[q] = wg >= 1 ? lv[15 + q] : res[q];
#pragma unroll
            for (int i = CT + 14; i >= 4; --i) lv[i] += lv[i - 4];
#pragma unroll
            for (int q = 0; q < CT; ++q) res[q] = wg >= 2 ? lv[15 + q] : res[q];
#pragma unroll
            for (int i = CT + 14; i >= 8; --i) lv[i] += lv[i - 8];
#pragma unroll
            for (int q = 0; q < CT; ++q) res[q] = wg >= 3 ? lv[15 + q] : res[q];
            const int wlen = 2 << wg;
            bf16_t* op = (bf16_t*)(ws + WS_ACTD) + (size_t)(mbase + t0) * 384 + c;
#pragma unroll
            for (int q = 0; q < CT; ++q) {
                const int cnt = (s < 0) ? min(wlen, t0 + q + 1) : wlen;
                const float pv = res[q] / (float)cnt - x[15 + q];
                if (q < nt) op[(size_t)q * 384] = (bf16_t)(cvt_pk_bf16(pv, 0.f) & 0xffffu);
            }
        }
    }
    float lg[6], lb[6];
    { const float* gp = a->in[IN_CLNG] + l * 384 + lane; const float* bp = a->in[IN_CLNB] + l * 384 + lane;
#pragma unroll
      for (int i = 0; i < 6; ++i) { lg[i] = gp[64 * i]; lb[i] = bp[64 * i]; } }
    __syncthreads();
    for (int tt = wave; tt < nt; tt += 8) {
        float x[6]; float sm = 0.f;
#pragma unroll
        for (int i = 0; i < 6; ++i) { x[i] = CV[tt * 384 + lane + 64 * i]; sm += x[i]; }
        const float mean = wave_sum(sm) * (1.0f / 384.0f);
        float sv = 0.f;
#pragma unroll
        for (int i = 0; i < 6; ++i) { x[i] -= mean; sv += x[i] * x[i]; }
        const float rstd = rsqrtf(wave_sum(sv) * (1.0f / 384.0f) + LN_EPS);
        bf16_t* o = (bf16_t*)(ws + WS_ACTA) + (size_t)(mbase + t0 + tt) * 384;
#pragma unroll
        for (int i = 0; i < 6; ++i) { const int c = lane + 64 * i; const float y = x[i] * rstd * lg[i] + lb[i]; o[c] = (bf16_t)(cvt_pk_bf16(y * sigmoidf_(y), 0.f) & 0xffffu); }
    }
    __syncthreads();
}

__device__ __forceinline__ void sgu_unit(ArgsP a, LAS unsigned char* lds, int l, int m0, int L, int g, int tid) {
    unsigned char* ws = a->ws;
    LAS float* V = (LAS float*)lds;
    LAS float* Wt = (LAS float*)(lds + 128 * 96 * 4);
    const bf16_t* vln = (const bf16_t*)(ws + WS_VLN); const bf16_t* z = (const bf16_t*)(ws + WS_Z);
    for (int i = tid; i < L * 12; i += 512) {
        const int j = i / 12, c8 = i - j * 12; float v[8]; unpack8(*(const u32x4*)(vln + (size_t)(m0 + j) * 384 + g * 96 + 8 * c8), v);
        *(LAS f32x4*)(V + j * 96 + 8 * c8) = (f32x4){v[0], v[1], v[2], v[3]}; *(LAS f32x4*)(V + j * 96 + 8 * c8 + 4) = (f32x4){v[4], v[5], v[6], v[7]};
    }
    const float* sw = a->in[IN_SGUW] + ((size_t)(l * 4 + g) * 128) * 128;
    const int L4 = L / 4;
    for (int i = tid; i < L * L4; i += 512) { const int r = i / L4, j4 = i - r * L4; *(LAS f32x4*)(Wt + r * 128 + 4 * j4) = *(const f32x4*)(sw + (size_t)r * 128 + 4 * j4); }
    __syncthreads();
    if (tid < 384) {
        const int c = tid % 96, iq = tid / 96;
        for (int i = iq; i < L; i += 4) {
            float acc = a->in[IN_SGUB][(l * 4 + g) * 128 + i];
            for (int j = 0; j <= i; ++j) acc += Wt[i * 128 + j] * V[j * 96 + c];
            const float u = bf1(z[(size_t)(m0 + i) * ZP + ZU + g * 96 + c]);
            ((bf16_t*)(ws + WS_ACTC))[(size_t)(m0 + i) * 384 + g * 96 + c] = (bf16_t)(cvt_pk_bf16(u * acc, 0.f) & 0xffffu);
        }
    }
    __syncthreads();
}

template <int IT>
__device__ __forceinline__ void sgu_mfma_tile(ArgsP a, int l, int m0, int g, int ct, int lane) {
    unsigned char* ws = a->ws;
    const int c = lane & 31, hh = lane >> 5;
    const bf16_t* wsb = (const bf16_t*)(ws + WS_SGUW) + ((size_t)(l * 4 + g) * 128 + 32 * IT + c) * 128 + 8 * hh;
    const bf16_t* vp = (const bf16_t*)(ws + WS_VLN) + ((size_t)(m0 >> 7) * 384 + g * 96 + 32 * ct + c) * 128 + 8 * hh;
    f32x16 acc;
#pragma unroll
    for (int i = 0; i < 16; ++i) acc[i] = 0.f;
    constexpr int NST = 2 * (IT + 1);
    bf16x8 afr[NST], bfr[NST];
#pragma unroll
    for (int st = 0; st < NST; ++st) { bfr[st] = *(const bf16x8*)(wsb + 16 * st); afr[st] = *(const bf16x8*)(vp + 16 * st); }
#pragma unroll
    for (int st = 0; st < NST; ++st) acc = __builtin_amdgcn_mfma_f32_32x32x16_bf16(afr[st], bfr[st], acc, 0, 0, 0);
    const int tok = m0 + 32 * IT + c;
    const float bias = a->in[IN_SGUB][(l * 4 + g) * 128 + 32 * IT + c];
    const bf16_t* up = (const bf16_t*)(ws + WS_Z) + (size_t)tok * ZP + ZU + g * 96 + 32 * ct + 4 * hh;
    bf16_t* op = (bf16_t*)(ws + WS_ACTC) + (size_t)tok * 384 + g * 96 + 32 * ct + 4 * hh;
#pragma unroll
    for (int q4 = 0; q4 < 4; ++q4) {
        const u32x2 uw = *(const u32x2*)(up + 8 * q4);
        u32x2 o; o.x = cvt_pk_bf16(bf_lo(uw.x) * (acc[4 * q4 + 0] + bias), bf_hi(uw.x) * (acc[4 * q4 + 1] + bias)); o.y = cvt_pk_bf16(bf_lo(uw.y) * (acc[4 * q4 + 2] + bias), bf_hi(uw.y) * (acc[4 * q4 + 3] + bias));
        *(u32x2*)(op + 8 * q4) = o;
    }
}
__device__ __forceinline__ void sgu_mfma_unit(ArgsP a, int l, int m0, int g, int lane, int wave) {
    if (wave < 3) sgu_mfma_tile<3>(a, l, m0, g, wave, lane);
    else if (wave < 6) { sgu_mfma_tile<2>(a, l, m0, g, wave - 3, lane); sgu_mfma_tile<0>(a, l, m0, g, wave - 3, lane); }
    else if (wave == 6) { sgu_mfma_tile<1>(a, l, m0, g, 0, lane); sgu_mfma_tile<1>(a, l, m0, g, 1, lane); }
    else sgu_mfma_tile<1>(a, l, m0, g, 2, lane);
}

constexpr int NU_ATTP = NT_ATTP / 8;
constexpr int NU_ATTS = MS * 12 / 8;
constexpr int NU_ATT = NU_ATTP + NU_ATTS;
constexpr int NU_SGU = 128 * 4 + 32 * 4;
constexpr int NU_CONV = MP / CT + 32;
constexpr int NU_MIX = NU_ATT + NU_SGU + NU_CONV;
#ifndef MIX_EXTRA_LO
#define MIX_EXTRA_LO 0
#define MIX_EXTRA_HI 0
#endif

__device__ __forceinline__ void p3_mixer(ArgsP a, LAS unsigned char* lds, int l, int tid, int lane, int wave, int G, int bid) {
    LAS float* tab = (LAS float*)(lds + TAB_OFF);
    for (int i = tid; i < 12 * 132; i += 512) { const int h = i / 132, j = i - h * 132; tab[i] = (j <= 128) ? a->in[IN_RELB][(int)T5_BUCKET[h >> 2][j] * 12 + h] * LOG2E - ATT_C2 : 0.f; }
    __syncthreads();
    for (int u = bid; u < NU_MIX + (MIX_EXTRA_HI - MIX_EXTRA_LO); u += G) {
        int r = u < NU_MIX ? u : MIX_EXTRA_LO + (u - NU_MIX);
        if (r < NU_ATTP) { attn_mfma_task(a, lds + wave * 8192, l, r * 8 + wave, lane, tab); __syncthreads(); continue; } r -= NU_ATTP;
        if (r < NU_ATTS) { const int task = r * 8 + wave; attn_sample_task(a, l, MP + task / 12, task % 12, lane, tab); continue; } r -= NU_ATTS;
        if (r < NU_SGU) { if (r < 512) sgu_mfma_unit(a, l, (r >> 2) * 128, r & 3, lane, wave); else { r -= 512; sgu_unit(a, lds, l, MP + (r >> 2) * 8, 8, r & 3, tid); } continue; } r -= NU_SGU;
        if (r == 0) convpool_unit<true>(a, lds, l, 0, -1, 0, CT, tid, lane, wave); else if (r < MP / CT) convpool_unit<false>(a, lds, l, 0, -1, r * CT, CT, tid, lane, wave); else { r -= MP / CT; convpool_unit<true>(a, lds, l, MP + r * 8, r, 0, 8, tid, lane, wave); }
    }
}


__device__ __forceinline__ void small_gemm_tile(LAS unsigned char* lds, const pg8::Gemm& g, const pg8::Epi& e, int mt, int nt, int tid, int lane, int wave) {
    const int K = g.K, kw = K >> 3, nsteps = kw >> 4;
    const int c = lane & 31, hh = lane >> 5;
    const bf16_t* ap = g.A + (size_t)(MP + 32 * mt + c) * K + wave * kw + 8 * hh;
    const bf16_t* bp = g.Bt + (size_t)(32 * nt + c) * K + wave * kw + 8 * hh;
    f32x16 acc;
#pragma unroll
    for (int i = 0; i < 16; ++i) acc[i] = 0.f;
    for (int s0 = 0; s0 < nsteps; s0 += 8) {
        bf16x8 af[8], bf[8];
#pragma unroll
        for (int i = 0; i < 8; ++i) { const int st = (s0 + i < nsteps) ? s0 + i : nsteps - 1; af[i] = *(const bf16x8*)(ap + 16 * st); bf[i] = *(const bf16x8*)(bp + 16 * st); }
#pragma unroll
        for (int i = 0; i < 8; ++i) { const bf16x8 zz = {0, 0, 0, 0, 0, 0, 0, 0}; const bf16x8 aa = (s0 + i < nsteps) ? af[i] : zz; acc = __builtin_amdgcn_mfma_f32_32x32x16_bf16(bf[i], aa, acc, 0, 0, 0); }
    }
    LAS float* P = (LAS float*)lds;
#pragma unroll
    for (int i = 0; i < 16; ++i) P[(wave * 16 + i) * 64 + lane] = acc[i];
    __syncthreads();
    if (tid < 128) {
        const int m = tid & 31, q4 = tid >> 5;
        f32x4 v0 = {0.f, 0.f, 0.f, 0.f}, v1 = {0.f, 0.f, 0.f, 0.f};
#pragma unroll
        for (int w = 0; w < 8; ++w)
#pragma unroll
            for (int j = 0; j < 4; ++j) { v0[j] += P[(w * 16 + 4 * q4 + j) * 64 + m]; v1[j] += P[(w * 16 + 4 * q4 + j) * 64 + 32 + m]; }
        const int row = MP + 32 * mt + m, col = 32 * nt + 8 * q4;
        const float r = e.needs_rstd() ? e.row_rstd(row) : 1.0f;
        const float ss = e.epi8(row, col, v0, v1, r, e.res_base(row));
        if ((e.mode == pg8::EP_RES || e.mode == pg8::EP_PLE) && e.rs_out) unsafeAtomicAdd(e.rs_out + row, ss);
    }
    __syncthreads();
}

enum { SUB_Z = 0, SUB_POSTZ = 1, SUB_MIX = 2, SUB_COMB = 3, SUB_BR = 4, SUB_WO = 5, SUB_GU = 6, SUB_DN = 7, SUB_PLE = 8, NSUB = 9 };
constexpr int N_PHASES = 1 + 2 * NSUB;
__device__ __forceinline__ int n_passes(int sub) { return sub == SUB_BR ? 4 : (sub == SUB_PLE ? 2 : 1); }
__device__ __forceinline__ void make_pass(ArgsP a, int l, int sub, int p, pg8::Gemm& g, pg8::Epi& e) {
    unsigned char* ws = a->ws; unsigned char* wl = ws + WS_W + (size_t)l * WL;
    float* rs = (float*)(ws + WS_CTL);
    bf16_t* xb = (bf16_t*)(ws + WS_XB); bf16_t* xb2 = (bf16_t*)(ws + WS_XB2); float* xres = (float*)(ws + WS_XRES); bf16_t* z = (bf16_t*)(ws + WS_Z);
    e.mode = 0; e.rowss = nullptr; e.ob = nullptr; e.ldb = 0; e.of = nullptr; e.rin_p = nullptr; e.rin_s = nullptr; e.rin_b = nullptr; e.rs_out = nullptr; e.gate8 = nullptr; e.pl = nullptr; e.mg = nullptr;
    g.M = (sub == SUB_Z || sub == SUB_GU) ? M : MP;
    if (sub == SUB_Z) {
        g.A = xb; g.Bt = (const bf16_t*)(wl + W_IN); g.N = NZ; g.K = D;
        e.mode = pg8::EP_Z; e.rowss = rs + (l == 0 ? RS_MIX0 : RS_MIX1) * RS_STRIDE; e.ob = z; e.ldb = ZP; e.gate8 = ws + WS_ZG8;
    } else if (sub == SUB_BR) {
        g.N = D;
        if (p == 0) { g.A = (const bf16_t*)(ws + WS_ACTA); g.Bt = (const bf16_t*)(wl + W_A); g.K = 384; e.mode = pg8::EP_BR_FIRST; }
        else if (p == 1) { g.A = (const bf16_t*)(ws + WS_ACTB); g.Bt = (const bf16_t*)(wl + W_B); g.K = 256; e.mode = pg8::EP_BR_MID; }
        else if (p == 2) { g.A = (const bf16_t*)(ws + WS_ACTC); g.Bt = (const bf16_t*)(wl + W_C); g.K = 384; e.mode = pg8::EP_BR_MID; }
        else { g.A = (const bf16_t*)(ws + WS_ACTD); g.Bt = (const bf16_t*)(wl + W_D); g.K = 384; e.mode = pg8::EP_BR_LAST; }
        e.gate8 = ws + WS_ZG8 + p * 1024; e.mg = (float*)(ws + WS_MG); e.ob = (bf16_t*)(ws + WS_MGB); e.ldb = D;
    } else if (sub == SUB_WO) {
        g.A = (const bf16_t*)(ws + WS_MGB); g.Bt = (const bf16_t*)(wl + W_O); g.N = D; g.K = D;
        e.mode = pg8::EP_RES; e.ob = xb2; e.ldb = D; e.rs_out = rs + (l == 0 ? RS_FFN0 : RS_FFN1) * RS_STRIDE;
        if (l == 0) { e.rin_p = a->in[IN_XP]; e.rin_s = a->in[IN_XS]; } else e.rin_b = xb;
    } else if (sub == SUB_GU) {
        g.A = xb2; g.Bt = (const bf16_t*)(wl + W_GU); g.N = 2 * DFF; g.K = D;
        e.mode = pg8::EP_GLU; e.rowss = rs + (l == 0 ? RS_FFN0 : RS_FFN1) * RS_STRIDE; e.ob = (bf16_t*)(ws + WS_HFF); e.ldb = DFF;
    } else if (sub == SUB_DN) {
        g.A = (const bf16_t*)(ws + WS_HFF); g.Bt = (const bf16_t*)(wl + W_DN); g.N = D; g.K = DFF;
        e.mode = pg8::EP_RES; e.ob = xb2; e.ldb = D; e.rs_out = rs + (l == 0 ? RS_PLE0 : RS_PLE1) * RS_STRIDE;
        e.rin_b = xb2;
    } else {
        g.N = D;
        if (p == 0) { g.A = (const bf16_t*)(ws + WS_PEB) + (size_t)l * M * DPLE; g.Bt = (const bf16_t*)(wl + W_PLE); g.K = DPLE; e.mode = pg8::EP_PL; e.ob = (bf16_t*)(ws + WS_PL); e.ldb = D; }
        else {
            g.A = xb2; g.Bt = (const bf16_t*)(wl + W_PG); g.K = D;
            e.mode = pg8::EP_PLE; e.rowss = rs + (l == 0 ? RS_PLE0 : RS_PLE1) * RS_STRIDE; e.pl = (const bf16_t*)(ws + WS_PL);
            e.rin_b = xb2;
            if (l == 0) { e.ob = xb; e.ldb = D; e.rs_out = rs + RS_MIX1 * RS_STRIDE; }
            else { e.of = a->out + O_YP; e.ob = nullptr; e.ldb = D; e.rs_out = nullptr; }
        }
    }
}


#ifndef MK_XCD_BARRIER
#define MK_XCD_BARRIER 1
#endif
constexpr int CW_BAR = 131072;
constexpr int LDS_BARST_OFF = LDS_BYTES - 64;
static_assert((CW_BAR + 3456) * 4 <= (int)CTL_ZERO_BYTES, "barrier words inside the memset region");
#define XB_TMO      128
#define XB_XCNT(j)  (256  + 64 * (j))
#define XB_XSUB(j)  (1280 + 64 * (j))
#define XB_XGEN(j)  (2304 + 64 * (j))
#define XB_TOP      3328
#define XB_TOPGEN   3392
#define XCD_BAR_WORDS 3456
#define XB_SPIN_CAP (1u << 18)

__device__ __forceinline__ unsigned xb_ld(unsigned* p)              { return __hip_atomic_load(p, __ATOMIC_RELAXED, __HIP_MEMORY_SCOPE_AGENT); }
__device__ __forceinline__ unsigned xb_add(unsigned* p, unsigned v) { return __hip_atomic_fetch_add(p, v, __ATOMIC_RELAXED, __HIP_MEMORY_SCOPE_AGENT); }
__device__ __forceinline__ unsigned xb_xcc_id() { return (unsigned)__builtin_amdgcn_s_getreg((3 << 11) | 20) & 0xFu; }
#define XB_SPIN(cond, bar) do { unsigned _sp = 0; while (cond) { __builtin_amdgcn_s_sleep(1); \
    if ((++_sp & 255u) == 0u) { if (xb_ld(&(bar)[XB_TMO])) break; if (_sp > XB_SPIN_CAP) { atomicAdd(&(bar)[XB_TMO], 1u); break; } } } } while (0)

struct XcdBarrier {
    unsigned* bar; unsigned x;
    volatile LAS unsigned* st;
};

__device__ __forceinline__ XcdBarrier xcd_barrier_post(unsigned* bar, volatile LAS unsigned* st) {
    XcdBarrier b; b.bar = bar; b.x = xb_xcc_id(); b.st = st;
    if (threadIdx.x == 0) (void)xb_add(&bar[XB_XCNT(b.x)], 1u);
    return b;
}
__device__ __forceinline__ void xcd_barrier_complete(unsigned* bar, unsigned x, unsigned& nloc, unsigned& nx) {
    const unsigned G = gridDim.x * gridDim.y * gridDim.z;
    unsigned sum, cnt, mine, sp = 0u;
    for (;;) {
        sum = 0u; cnt = 0u; mine = 0u;
#pragma unroll
        for (unsigned j = 0; j < 16; ++j) { const unsigned c = xb_ld(&bar[XB_XCNT(j)]); sum += c; cnt += (c > 0u) ? 1u : 0u; mine = (j == x) ? c : mine; }
        if (sum == G) break;
        __builtin_amdgcn_s_sleep(1);
        if ((++sp & 255u) == 0u) { if (xb_ld(&bar[XB_TMO])) break; if (sp > XB_SPIN_CAP) { atomicAdd(&bar[XB_TMO], 1u); break; } }
    }
    nloc = mine > 0u ? mine : 1u; nx = cnt > 0u ? cnt : 1u;
}

__device__ __forceinline__ void xcd_barrier(const XcdBarrier& b) {
    asm volatile("s_waitcnt vmcnt(0)" ::: "memory");
    __syncthreads();
    if (threadIdx.x == 0) {
        unsigned* bar = b.bar;
        __builtin_amdgcn_s_waitcnt(0);
        unsigned nloc = b.st[0], nx = b.st[1];
        if (nloc == 0u) { xcd_barrier_complete(bar, b.x, nloc, nx); b.st[0] = nloc; b.st[1] = nx; }
        const unsigned old = xb_add(&bar[XB_XSUB(b.x)], 1u);
        const unsigned gen = old / nloc;
        if (old + 1u == (gen + 1u) * nloc) {
            __builtin_amdgcn_fence(__ATOMIC_RELEASE, "agent");
            asm volatile("s_waitcnt vmcnt(0)" ::: "memory");
            const unsigned og = xb_add(&bar[XB_TOP], 1u);
            const unsigned tg = og / nx;
            if (og + 1u == (tg + 1u) * nx) xb_add(&bar[XB_TOPGEN], 1u);
            else XB_SPIN(xb_ld(&bar[XB_TOPGEN]) == tg, bar);
            __builtin_amdgcn_fence(__ATOMIC_ACQUIRE, "agent");
            xb_add(&bar[XB_XGEN(b.x)], 1u);
            asm volatile("s_waitcnt vmcnt(0)" ::: "memory");
        } else {
            XB_SPIN(xb_ld(&bar[XB_XGEN(b.x)]) == gen, bar);
            __builtin_amdgcn_fence(__ATOMIC_ACQUIRE, "agent");
            asm volatile("s_waitcnt vmcnt(0)" ::: "memory");
        }
    }
    __syncthreads();
}


constexpr int Z0_SPLIT_ROUNDS = 8;
__device__ __forceinline__ int phase_reps(int ph, int sub) {
    return ph == 0 ? REP_P0 : sub == SUB_Z ? REP_Z : sub == SUB_POSTZ ? REP_POSTZ : sub == SUB_MIX ? REP_MIX : sub == SUB_COMB ? REP_COMB : sub == SUB_BR ? REP_BR : sub == SUB_GU ? REP_GU : 1;
}
__global__ void __launch_bounds__(512, 2) mega_fwd(Args a) {
    extern __shared__ __attribute__((aligned(16))) unsigned char lds_raw[];
    LAS unsigned char* lds = (LAS unsigned char*)lds_raw;
    const int G = gridDim.x, bid = blockIdx.x;
    const int ph_lo = a.ph_lo, ph_hi = a.ph_hi;
#if MK_XCD_BARRIER
    if (threadIdx.x < 2) ((volatile LAS unsigned*)(lds + LDS_BARST_OFF))[threadIdx.x] = 0u;
    __syncthreads();
    (void)xcd_barrier_post((unsigned*)(((ArgsP)__builtin_amdgcn_kernarg_segment_ptr())->ws + WS_CTL) + CW_BAR, (volatile LAS unsigned*)(lds + LDS_BARST_OFF));
#else
    cg::grid_group grid = cg::this_grid();
#endif
    for (int ph = ph_lo; ph < ph_hi; ++ph) {
#if MK_XCD_BARRIER
        if (ph > ph_lo) {
            XcdBarrier xb; xb.bar = (unsigned*)(((ArgsP)__builtin_amdgcn_kernarg_segment_ptr())->ws + WS_CTL) + CW_BAR; xb.x = xb_xcc_id(); xb.st = (volatile LAS unsigned*)(lds + LDS_BARST_OFF);
            xcd_barrier(xb);
        }
#else
        if (ph > ph_lo) grid.sync();
#endif
        ArgsP ap = (ArgsP)__builtin_amdgcn_kernarg_segment_ptr(); asm volatile("" : "+s"(ap));
        int tid = threadIdx.x; asm volatile("" : "+v"(tid));
        const int lane = tid & 63, wave = __builtin_amdgcn_readfirstlane(tid >> 6);
        if (ph == 0 || (ph == 1 && G == 256 && bid >= 128)) {
            p0_prologue(ap, lds, tid, lane, wave, ph == 0 ? G : 128, ph == 0 ? bid : bid - 128, ph == 0 ? (G == 256 ? 0 : 2) : 1, ph == 1);
            if (ph == 0) continue;
            __syncthreads();
        }
        const int l = (ph - 1) / NSUB, sub = (ph - 1) - l * NSUB;
        if (sub == SUB_POSTZ) {
            for (int rep = 0; rep < REP_POSTZ; ++rep) {
                for (int t8 = bid * 8 + wave; t8 < MP / 8; t8 += G * 8) postz_rows8(ap, l, t8 * 8, lane);
                for (int m = MP + bid * 8 + wave; m < M; m += G * 8) { const PzRow R = postz_load(ap, m, lane); __builtin_amdgcn_sched_barrier(0); (void)postz_row(ap, l, m, lane, R); }
            }
            continue;
        }
        if (sub == SUB_MIX) { p3_mixer(ap, lds, l, tid, lane, wave, G, bid); __syncthreads(); continue; }
        if (sub == SUB_COMB) { for (int rep = 0; rep < REP_COMB; ++rep) {
                int m = bid * 8 + wave; if (m >= M) continue;
                CbRow cur = combine_load(ap, m, lane);
                for (; m < M; m += G * 8) { const int mn = m + G * 8; CbRow nxt = cur; if (mn < M) nxt = combine_load(ap, mn, lane); __builtin_amdgcn_sched_barrier(0); combine_row(ap, m, lane, cur); cur = nxt; }
            } continue; }
        const int np = n_passes(sub);
        const int nrep = phase_reps(ph, sub) + ((DRY_SUB >= 0 && sub == DRY_SUB) ? 1 : 0);
        const int nmain = (sub == SUB_BR ? 1 : np) * nrep;
        for (int pp = 0; pp < nmain; ++pp) {
            const int p = (sub == SUB_BR) ? 0 : pp % np;
            pg8::Gemm g; pg8::Epi e; pg8::SegSched S;
            make_pass(ap, l, sub, p, g, e);
#if DRY_SUB >= 0
            if (sub == DRY_SUB && pp < np) {
                if (e.ob) e.ob = (bf16_t*)(ap->ws + WS_XRES); if (e.of) e.of = (float*)(ap->ws + WS_MG); if (e.rs_out) e.rs_out = (float*)(ap->ws + WS_CTL) + 6 * RS_STRIDE;
            }
#endif
            S.nseg = 1; S.A0 = g.A; S.B0 = g.Bt; S.K0 = g.K; S.ws = ap->ws; S.wl = ap->ws + WS_W + (size_t)l * WL;
            if (sub == SUB_BR) { S.nseg = 4; e.mode = pg8::EP_BRC; }
            S.so.init(g.M, g.N, G, bid);
            S.split_rounds = 0;
            if (G == 256 && sub == SUB_Z && l == 0 && pp == 0) {
                S.split_rounds = Z0_SPLIT_ROUNDS;
            }
            if (G == 256 && (sub == SUB_Z || sub == SUB_GU) && pp == 0 && !(sub == SUB_Z && l == 0)) {
                const int nwg = (g.M / 256) * (g.N / 256), rem = nwg - (nwg / G) * G;
                if (bid >= rem) {
                    const int k = bid - rem, Q = (sub == SUB_Z) ? STAG_Q_Z : STAG_Q_GU;
                    const int base = ((sub == SUB_GU) ? STAG_TOT_Z : 0) + l * (STAG_TOT_Z + STAG_TOT_GU);
                    const int lo = base + Q * (k * (k - 1) / 2);
                    cache_copy_range(ap, lo, lo + Q * k, tid, 512);
                }
            }
            const bool has_small = (sub != SUB_BR && g.M == MP);
            const bool small_first = has_small && ((bid >> 3) & 1);
#pragma unroll 1
            for (int step = 0; step < 2; ++step) {
                if ((step == 0) != small_first) pg8::gemm_phase<pg8::Epi, pg8::SegSched, true>(lds, S, e, tid);
                else if (has_small) { for (int tile = bid; tile < 256; tile += G) small_gemm_tile(lds, g, e, tile >> 5, tile & 31, tid, lane, wave); }
            }
        }
        if (sub == SUB_BR) {
            for (int pp = 0; pp < 4 * nrep; ++pp) {
                pg8::Gemm g; pg8::Epi e; make_pass(ap, l, sub, pp & 3, g, e);
                for (int tile = bid; tile < 256; tile += G) small_gemm_tile(lds, g, e, tile >> 5, tile & 31, tid, lane, wave);
            }
        }
    }
}

extern "C" void kernel_launch(void* const* d_in, const int* in_sizes, int n_in, void* d_out, int out_size, void* d_ws, size_t ws_size, hipStream_t stream) {
    static int grid = 0;
    if (grid == 0) {
        if (n_in != 36 || (size_t)out_size != O_END || ws_size < WS_END) { fprintf(stderr, "kernel_launch: unexpected shapes: n_in %d out %d ws %zu (need %zu)\n", n_in, out_size, ws_size, (size_t)WS_END); grid = -1; return; }
        int dev = 0, cus = 0, per_cu = 0;
        if (hipGetDevice(&dev) != hipSuccess || hipDeviceGetAttribute(&cus, hipDeviceAttributeMultiprocessorCount, dev) != hipSuccess) { grid = -1; return; }
        if (hipFuncSetAttribute((const void*)mega_fwd, hipFuncAttributeMaxDynamicSharedMemorySize, LDS_BYTES) != hipSuccess) { fprintf(stderr, "kernel_launch: hipFuncSetAttribute failed\n"); grid = -1; return; }
        if (hipOccupancyMaxActiveBlocksPerMultiprocessor(&per_cu, (const void*)mega_fwd, 512, LDS_BYTES) != hipSuccess || per_cu < 1) { fprintf(stderr, "kernel_launch: occupancy query says %d blocks per CU\n", per_cu); per_cu = 1; }
        (void)hipGetLastError();
        grid = cus;
    }
    if (grid < 0) return;
    (void)hipMemsetAsync((char*)d_ws + WS_CTL, 0, CTL_ZERO_BYTES, stream);
    Args a{};
    for (int i = 0; i < 36; ++i) a.in[i] = (const float*)d_in[i];
    a.out = (float*)d_out; a.ws = (unsigned char*)d_ws;
#if MK_ONE_LAUNCH
    a.ph_lo = 0; a.ph_hi = N_PHASES;
    void* args[] = {&a};
    hipError_t e = hipLaunchCooperativeKernel((const void*)mega_fwd, dim3(grid), dim3(512), args, LDS_BYTES, stream);
    if (e != hipSuccess) fprintf(stderr, "cooperative launch failed: %s (grid %d)\n", hipGetErrorString(e), grid);
#else
    for (int ph = 0; ph < N_PHASES; ++ph) {
        a.ph_lo = ph; a.ph_hi = ph + 1;
        hipLaunchKernelGGL(mega_fwd, dim3(grid), dim3(512), LDS_BYTES, stream, a);
    }
#endif
}
```

```cpp
#include <hip/hip_runtime.h>
#include <hip/hip_cooperative_groups.h>
#include <cstdio>
#include <cstdint>
namespace cg = cooperative_groups;

#ifndef MK_ONE_LAUNCH
#define MK_ONE_LAUNCH 1
#endif

#ifndef REP_P0
#define REP_P0 1
#endif
#ifndef DRY_SUB
#define DRY_SUB -1
#endif
#ifndef P0R_T
#define P0R_T 1
#define P0R_X 1
#define P0R_C 1
#endif
#ifndef REP_Z
#define REP_Z 1
#endif
#ifndef REP_POSTZ
#define REP_POSTZ 1
#endif
#ifndef REP_MIX
#define REP_MIX 1
#endif
#ifndef REP_COMB
#define REP_COMB 1
#endif
#ifndef REP_BR
#define REP_BR 1
#endif
#ifndef REP_GU
#define REP_GU 1
#endif
constexpr int D = 1024, TP = 16384, NSEQ = 32, TS = 8, MP = TP, MS = NSEQ * TS, M = MP + MS;
constexpr int DC = 384, NH = 12, HD = 64, DQ = NH * HD, DFF = 2816, DPLE = 256, DIN = 8320, NZ = 8448, ZP = 4352;
constexpr int ZA = 0, ZB = 384, ZQ = 768, ZK = 1536, ZV = 2304, ZU = 3072, ZVV = 3456, ZD = 3840, ZG = 4224;
constexpr float EPS = 1e-6f, LN_EPS = 1e-5f;
constexpr float LOG2E = 1.4426950408889634f, LN2 = 0.6931471805599453f, ATT_C2 = 12.0f;

constexpr size_t O_YP = 0, O_YS = O_YP + (size_t)MP * D, O_KVP0 = O_YS + (size_t)MS * D,
    O_KVP1 = O_KVP0 + 2ull * 128 * 512, O_KVP2 = O_KVP1 + 2ull * 512 * 512, O_CONVP = O_KVP2 + 2ull * 2048 * 512,
    O_POOLP = O_CONVP + 2ull * 30 * 384, O_KVS0 = O_POOLP + 2ull * 15 * 384, O_KVS1 = O_KVS0 + 2ull * 32 * 128 * 512,
    O_KVS2 = O_KVS1 + 2ull * 32 * 512 * 512, O_CONVS = O_KVS2 + 2ull * 32 * 2048 * 512, O_POOLS = O_CONVS + 2ull * 32 * 30 * 384,
    O_SGUS = O_POOLS + 2ull * 32 * 15 * 384, O_END = O_SGUS + 2ull * 32 * 8 * 384;
static_assert(O_END == 109209344ull, "output size");

constexpr size_t MiB = 1u << 20;
constexpr size_t WS_CTL = 0, CTL_ZERO_BYTES = 1 * MiB;
constexpr size_t WS_W = 2 * MiB, WL = 44 * MiB;
constexpr size_t W_IN = 0, W_A = 17 * MiB, W_B = 18 * MiB, W_C = 19 * MiB, W_D = 20 * MiB, W_O = 21 * MiB, W_GU = 23 * MiB, W_DN = 34 * MiB, W_PG = 40 * MiB, W_PLE = 42 * MiB;
constexpr size_t WS_XB = 90 * MiB;
constexpr size_t WS_XRES = 123 * MiB;
constexpr size_t WS_Z = 188 * MiB;
constexpr size_t WS_ZG8 = 340 * MiB;
static_assert(WS_Z + (size_t)M * ZP * 2 <= WS_ZG8 && WS_ZG8 + (size_t)M * 4096 <= 457 * MiB, "ws map z");
constexpr size_t WS_PEB = 457 * MiB;
constexpr size_t WS_GLU = 474 * MiB;
constexpr size_t WS_QN = 487 * MiB;
constexpr size_t WS_KN = 512 * MiB;
constexpr size_t WS_VLN = 537 * MiB;
constexpr size_t WS_ACTA = 550 * MiB, WS_ACTB = 563 * MiB, WS_ACTC = 572 * MiB, WS_ACTD = 585 * MiB;
constexpr size_t WS_MG = 598 * MiB;
constexpr size_t WS_MGB = 663 * MiB;
constexpr size_t WS_HFF = 696 * MiB;
constexpr size_t WS_PL = 786 * MiB;
constexpr size_t WS_OPART = 852 * MiB;
constexpr size_t WS_LSE = 877 * MiB;
constexpr size_t WS_XB2 = 879 * MiB;
constexpr size_t WS_SGUW = 912 * MiB;
constexpr size_t WS_END = 913 * MiB;
static_assert(WS_XB2 + (size_t)M * D * 2 <= WS_SGUW && WS_SGUW + 2ull * 4 * 128 * 128 * 2 <= WS_END, "ws map 6");
static_assert(WS_OPART + (size_t)M * DQ * 2 <= WS_LSE && WS_LSE + (size_t)M * 12 * 4 <= WS_XB2, "ws map 5");
static_assert(W_IN + (size_t)NZ * D * 2 <= W_A && W_GU + 2ull * DFF * D * 2 <= W_DN && W_DN + (size_t)D * DFF * 2 <= W_PG && W_PLE + (size_t)D * DPLE * 2 <= WL, "weight map");
static_assert(WS_W + 2 * WL <= WS_XB && WS_XB + (size_t)M * D * 2 <= WS_XRES && WS_XRES + (size_t)M * D * 4 <= WS_Z && WS_Z + (size_t)M * ZP * 2 <= WS_PEB, "ws map 1");
static_assert(WS_PEB + 2ull * M * DPLE * 2 <= WS_GLU && WS_GLU + (size_t)M * 384 * 2 <= WS_QN && WS_QN + (size_t)M * DQ * 2 <= WS_KN && WS_KN + (size_t)M * DQ * 2 <= WS_VLN, "ws map 2");
static_assert(WS_VLN + (size_t)M * 384 * 2 <= WS_ACTA && WS_ACTA + (size_t)M * 384 * 2 <= WS_ACTB && WS_ACTB + (size_t)M * 256 * 2 <= WS_ACTC && WS_ACTC + (size_t)M * 384 * 2 <= WS_ACTD, "ws map 3");
static_assert(WS_ACTD + (size_t)M * 384 * 2 <= WS_MG && WS_MG + (size_t)M * D * 4 <= WS_MGB && WS_MGB + (size_t)M * D * 2 <= WS_HFF && WS_HFF + (size_t)M * DFF * 2 <= WS_PL && WS_PL + (size_t)M * D * 4 <= WS_OPART, "ws map 4");
constexpr int RS_STRIDE = 16896;
constexpr int RS_MIX0 = 0, RS_FFN0 = 1, RS_PLE0 = 2, RS_MIX1 = 3, RS_FFN1 = 4, RS_PLE1 = 5;
static_assert(6ull * RS_STRIDE * 4 <= CTL_ZERO_BYTES, "ctl");

constexpr int RING_BYTES = 131072, LDS_BYTES = 147456;

#define LAS __attribute__((address_space(3)))
typedef unsigned short bf16_t;
typedef short bf16x8 __attribute__((ext_vector_type(8)));
typedef float f32x4 __attribute__((ext_vector_type(4)));
typedef float f32x16 __attribute__((ext_vector_type(16)));
typedef float f32x2 __attribute__((ext_vector_type(2)));
typedef unsigned u32x4 __attribute__((ext_vector_type(4)));
typedef unsigned u32x2 __attribute__((ext_vector_type(2)));

__device__ __forceinline__ unsigned cvt_pk_bf16(float lo, float hi) { unsigned r; asm("v_cvt_pk_bf16_f32 %0, %1, %2" : "=v"(r) : "v"(lo), "v"(hi)); return r; }
__device__ __forceinline__ float bf_lo(unsigned w) { return __uint_as_float(w << 16); }
__device__ __forceinline__ float bf_hi(unsigned w) { return __uint_as_float(w & 0xffff0000u); }
__device__ __forceinline__ void unpack8(const u32x4 w, float (&f)[8]) { f[0] = bf_lo(w.x); f[1] = bf_hi(w.x); f[2] = bf_lo(w.y); f[3] = bf_hi(w.y); f[4] = bf_lo(w.z); f[5] = bf_hi(w.z); f[6] = bf_lo(w.w); f[7] = bf_hi(w.w); }
__device__ __forceinline__ u32x4 pack8(const float (&f)[8]) { u32x4 w; w.x = cvt_pk_bf16(f[0], f[1]); w.y = cvt_pk_bf16(f[2], f[3]); w.z = cvt_pk_bf16(f[4], f[5]); w.w = cvt_pk_bf16(f[6], f[7]); return w; }
__device__ __forceinline__ float bf1(bf16_t b) { return __uint_as_float((unsigned)b << 16); }
__device__ __forceinline__ float sigmoidf_(float x) { return __builtin_amdgcn_rcpf(1.0f + __expf(-x)); }
__device__ __forceinline__ float wave_sum(float v) {
#pragma unroll
    for (int o = 1; o < 64; o <<= 1) v += __shfl_xor(v, o);
    return v;
}

namespace pg8 {
#define PG8_LAS __attribute__((address_space(3)))
typedef unsigned short bf16_t;
typedef short bf16x8 __attribute__((ext_vector_type(8)));
typedef float f32x4 __attribute__((ext_vector_type(4)));
typedef unsigned u32x4 __attribute__((ext_vector_type(4)));
constexpr int BM = 256, BK = 64, HALF = 128, HTB = HALF * BK * 2  , STAGE_BYTES = 8 * HTB, NXCD = 8, WGM = 8;

__host__ __device__ __forceinline__ int lds_byte(int r, int c) { const int st = (r >> 4) * 2 + (c >> 5), rr = r & 15, cc = c & 31, ob = rr * 64 + cc * 2; return st * 1024 + (ob ^ (((ob >> 9) & 1) << 5)); }
__host__ __device__ __forceinline__ void stage_rc(int b, int& R, int& C) { const int st = b / 1024, sb = b % 1024, swz = sb ^ (((sb >> 9) & 1) << 5); R = (st >> 1) * 16 + swz / 64; C = (st & 1) * 32 + (swz % 64) / 2; }
__host__ __device__ __forceinline__ int perm32(int rho) { const int n = rho >> 4, i = rho & 15; return 8 * (i >> 2) + 4 * n + (i & 3); }

struct Unit { int pm, pn; };
struct Gemm { const bf16_t* A; const bf16_t* Bt; int M, N, K; };

struct StaticOrder {
    int nM, nN, nwg, G, c, wgm;
    __host__ __device__ __forceinline__ void init(int M, int N, int G_, int c_, int wgm_) { nM = M / BM; nN = N / BM; nwg = nM * nN; G = G_; c = c_; wgm = wgm_; }
    __host__ __device__ __forceinline__ bool next(int i, Unit& u) const { return next_at((long)i * G + c, u); }
    __host__ __device__ __forceinline__ bool next_at(long L, Unit& u) const {
        if (L >= nwg) return false;
        int wgid = (int)L; { const int q = nwg / NXCD, r = nwg % NXCD, xcd = wgid % NXCD, off = wgid / NXCD; wgid = (xcd < r ? xcd * (q + 1) : r * (q + 1) + (xcd - r) * q) + off; }
        const int nig = wgm * nN, gid = wgid / nig, fm = gid * wgm, gsz = (nM - fm) < wgm ? (nM - fm) : wgm;
        u.pm = fm + ((wgid % nig) % gsz); u.pn = (wgid % nig) / gsz; return true;
    }
    __device__ __forceinline__ void a_ready(const Unit&) const {}
    __device__ __forceinline__ void done(const Unit&) const {}
};


enum EpiMode { EP_Z = 0, EP_BR_FIRST = 1, EP_BR_MID = 2, EP_BR_LAST = 3, EP_RES = 4, EP_GLU = 5, EP_PL = 6, EP_PLE = 7, EP_BRC = 8 };
struct UnitX;
__device__ __forceinline__ void unpackg8(const u32x2 w, float (&g)[8]) {
#pragma unroll
    for (int j = 0; j < 4; ++j) { g[j] = (float)((w.x >> (8 * j)) & 0xffu) + 0.5f; g[4 + j] = (float)((w.y >> (8 * j)) & 0xffu) + 0.5f; }
}
struct Epi {
    static constexpr bool PERM = true, AFTER_DRAIN = false;
    int mode;
    const float* rowss;
    bf16_t* ob; int ldb;
    float* of;
    const float* rin_p; const float* rin_s;
    const bf16_t* rin_b;
    float* rs_out;
    unsigned char* gate8;
    const bf16_t* pl;
    float* mg;
    __device__ __forceinline__ bool needs_rstd() const { return mode == EP_Z || mode == EP_PLE || mode == EP_GLU; }
    __device__ __forceinline__ float row_rstd(int row) const { return rsqrtf(rowss[row] * (1.0f / 1024.0f) + EPS); }
    __device__ __forceinline__ const float* res_base(int row) const { return (row < MP) ? rin_p : (rin_s - (size_t)MP * 1024); }
    __device__ __forceinline__ float epi8(int row, int col, f32x4 v0, f32x4 v1, float r, const float* rbase) const {
        float ss = 0.f;
        if (mode == EP_Z) {
            v0 *= r; v1 *= r;
            if (col < ZG) {
                u32x4 w; w.x = cvt_pk_bf16(v0[0], v0[1]); w.y = cvt_pk_bf16(v0[2], v0[3]); w.z = cvt_pk_bf16(v1[0], v1[1]); w.w = cvt_pk_bf16(v1[2], v1[3]);
                *(u32x4*)(ob + (size_t)row * ldb + col) = w;
            } else if (col < DIN) {
                unsigned q[8];
#pragma unroll
                for (int j = 0; j < 4; ++j) { q[j] = (unsigned)(sigmoidf_(v0[j]) * 256.0f); q[4 + j] = (unsigned)(sigmoidf_(v1[j]) * 256.0f); }
#pragma unroll
                for (int j = 0; j < 8; ++j) q[j] = q[j] > 255u ? 255u : q[j];
                u32x2 w; w.x = q[0] | (q[1] << 8) | (q[2] << 16) | (q[3] << 24); w.y = q[4] | (q[5] << 8) | (q[6] << 16) | (q[7] << 24);
                *(u32x2*)(gate8 + (size_t)row * 4096 + (col - ZG)) = w;
            }
        } else if (mode == EP_BR_FIRST || mode == EP_BR_MID || mode == EP_BR_LAST) {
            float g[8]; unpackg8(*(const u32x2*)(gate8 + (size_t)row * 4096 + col), g);
#pragma unroll
            for (int j = 0; j < 8; ++j) g[j] *= (1.0f / 256.0f);
            v0[0] *= g[0]; v0[1] *= g[1]; v0[2] *= g[2]; v0[3] *= g[3];
            v1[0] *= g[4]; v1[1] *= g[5]; v1[2] *= g[6]; v1[3] *= g[7];
            float* mp = mg + (size_t)row * 1024 + col;
            if (mode != EP_BR_FIRST) { v0 += *(const f32x4*)mp; v1 += *(const f32x4*)(mp + 4); }
            if (mode != EP_BR_LAST) { *(f32x4*)mp = v0; *(f32x4*)(mp + 4) = v1; }
            else {
                u32x4 w; w.x = cvt_pk_bf16(v0[0], v0[1]); w.y = cvt_pk_bf16(v0[2], v0[3]); w.z = cvt_pk_bf16(v1[0], v1[1]); w.w = cvt_pk_bf16(v1[2], v1[3]);
                *(u32x4*)(ob + (size_t)row * ldb + col) = w;
            }
        } else if (mode == EP_RES || mode == EP_PLE) {
            f32x4 x0, x1;
            if (rin_b) { float xr[8]; unpack8(*(const u32x4*)(rin_b + (size_t)row * 1024 + col), xr); x0 = (f32x4){xr[0], xr[1], xr[2], xr[3]}; x1 = (f32x4){xr[4], xr[5], xr[6], xr[7]}; }
            else { const float* rp = rbase + (size_t)row * 1024 + col; x0 = *(const f32x4*)rp; x1 = *(const f32x4*)(rp + 4); }
            if (mode == EP_PLE) {
                float p[8]; unpack8(*(const u32x4*)(pl + (size_t)row * 1024 + col), p);
                v0[0] = p[0] * sigmoidf_(v0[0] * r); v0[1] = p[1] * sigmoidf_(v0[1] * r); v0[2] = p[2] * sigmoidf_(v0[2] * r); v0[3] = p[3] * sigmoidf_(v0[3] * r);
                v1[0] = p[4] * sigmoidf_(v1[0] * r); v1[1] = p[5] * sigmoidf_(v1[1] * r); v1[2] = p[6] * sigmoidf_(v1[2] * r); v1[3] = p[7] * sigmoidf_(v1[3] * r);
            }
            x0 += v0; x1 += v1;
            if (of) { float* op = of + (size_t)row * 1024 + col; *(f32x4*)op = x0; *(f32x4*)(op + 4) = x1; }
            if (ob) {
                u32x4 w; w.x = cvt_pk_bf16(x0[0], x0[1]); w.y = cvt_pk_bf16(x0[2], x0[3]); w.z = cvt_pk_bf16(x1[0], x1[1]); w.w = cvt_pk_bf16(x1[2], x1[3]);
                *(u32x4*)(ob + (size_t)row * ldb + col) = w;
            }
            ss = (x0[0] * x0[0] + x0[1] * x0[1]) + (x0[2] * x0[2] + x0[3] * x0[3]) + (x1[0] * x1[0] + x1[1] * x1[1]) + (x1[2] * x1[2] + x1[3] * x1[3]);
        } else {
            u32x4 w; w.x = cvt_pk_bf16(v0[0], v0[1]); w.y = cvt_pk_bf16(v0[2], v0[3]); w.z = cvt_pk_bf16(v1[0], v1[1]); w.w = cvt_pk_bf16(v1[2], v1[3]);
            *(u32x4*)(ob + (size_t)row * ldb + col) = w;
        }
        return ss;
    }
    template <class U>
    __device__ __forceinline__ void rescale(f32x4 (&acc)[2][2][4][2], const U& u, int wr, int wc, int fr, int fq) const {
        const int rowb = u.pm * BM + wr * 64 + fr;
        const int colb = u.pn * BM + wc * 32 + 8 * fq;
        const bool zero = u.zero_after;
        const unsigned char* gb = gate8 + u.seg * 1024;
#pragma unroll
        for (int ai = 0; ai < 2; ++ai)
#pragma unroll
            for (int m = 0; m < 4; ++m) {
                const int row = rowb + ai * HALF + m * 16;
#pragma unroll
                for (int bj = 0; bj < 2; ++bj) {
                    f32x4 r0 = {0.f, 0.f, 0.f, 0.f}, r1 = {0.f, 0.f, 0.f, 0.f};
                    if (!zero) {
                        const unsigned char* gp = gb + (size_t)row * 4096 + colb + bj * HALF;
                        float g0[8], g1[8]; unpackg8(*(const u32x2*)gp, g0); unpackg8(*(const u32x2*)(gp + 1024), g1);
#pragma unroll
                        for (int j = 0; j < 4; ++j) { r0[j] = g0[j] * __builtin_amdgcn_rcpf(g1[j]); r1[j] = g0[4 + j] * __builtin_amdgcn_rcpf(g1[4 + j]); }
                    }
                    acc[ai][bj][m][0] = acc[ai][bj][m][0] * r0; acc[ai][bj][m][1] = acc[ai][bj][m][1] * r1;
                }
            }
    }
    __device__ __forceinline__ void brc_store(const f32x4 (&acc)[2][2][4][2], int seg, int rowb, int colb) const {
        const unsigned char* gb = gate8 + seg * 1024 + colb;
        u32x2 cg[2];
#define BRS_LOAD(I, G) do { const unsigned char* _gp = gb + (size_t)(rowb + ((I) >> 2) * HALF + ((I) & 3) * 16) * 4096; (G)[0] = *(const u32x2*)_gp; (G)[1] = *(const u32x2*)(_gp + HALF); } while (0)
        BRS_LOAD(0, cg);
#pragma unroll
        for (int i = 0; i < 8; ++i) {
            u32x2 ng[2];
            if (i < 7) BRS_LOAD(i + 1, ng);
            const int ai = i >> 2, m = i & 3;
            const int row = rowb + ai * HALF + m * 16;
#pragma unroll
            for (int bj = 0; bj < 2; ++bj) {
                float g0[8]; unpackg8(cg[bj], g0);
#pragma unroll
                for (int j = 0; j < 8; ++j) g0[j] *= (1.0f / 256.0f);
                const f32x4 v0 = acc[ai][bj][m][0], v1 = acc[ai][bj][m][1];
                u32x4 w; w.x = cvt_pk_bf16(v0[0] * g0[0], v0[1] * g0[1]); w.y = cvt_pk_bf16(v0[2] * g0[2], v0[3] * g0[3]); w.z = cvt_pk_bf16(v1[0] * g0[4], v1[1] * g0[5]); w.w = cvt_pk_bf16(v1[2] * g0[6], v1[3] * g0[7]);
                *(u32x4*)(ob + (size_t)row * ldb + colb + bj * HALF) = w;
            }
            if (i < 7) { cg[0] = ng[0]; cg[1] = ng[1]; }
            asm volatile("" ::: "memory");
        }
#undef BRS_LOAD
    }
    template <bool BFRES, bool PLE>
    __device__ __forceinline__ void res_loop(const f32x4 (&acc)[2][2][4][2], int rowb, int colb, int fq, const float (&rs8)[8]) const {
        const float* rbase = res_base(rowb);
        const bool ssq = rs_out != nullptr;
        u32x4 cb[2], cp[2]; f32x4 cf[2][2];
#define RES_LOAD(I, B, F, P) do { const int _row = rowb + ((I) >> 2) * HALF + ((I) & 3) * 16; _Pragma("unroll") for (int _bj = 0; _bj < 2; ++_bj) { const size_t _o = (size_t)_row * 1024 + colb + _bj * HALF; \
            if constexpr (BFRES) (B)[_bj] = *(const u32x4*)(rin_b + _o); else { (F)[_bj][0] = *(const f32x4*)(rbase + _o); (F)[_bj][1] = *(const f32x4*)(rbase + _o + 4); } \
            if constexpr (PLE) (P)[_bj] = *(const u32x4*)(pl + _o); } } while (0)
        RES_LOAD(0, cb, cf, cp);
#pragma unroll
        for (int i = 0; i < 8; ++i) {
            u32x4 nb[2], np[2]; f32x4 nf[2][2];
            if (i < 7) RES_LOAD(i + 1, nb, nf, np);
            const int ai = i >> 2, m = i & 3;
            const int row = rowb + ai * HALF + m * 16;
            const float r = rs8[i];
            float ss = 0.f;
#pragma unroll
            for (int bj = 0; bj < 2; ++bj) {
                const int col = colb + bj * HALF;
                f32x4 x0, x1;
                if constexpr (BFRES) { float xr[8]; unpack8(cb[bj], xr); x0 = (f32x4){xr[0], xr[1], xr[2], xr[3]}; x1 = (f32x4){xr[4], xr[5], xr[6], xr[7]}; }
                else { x0 = cf[bj][0]; x1 = cf[bj][1]; }
                f32x4 v0 = acc[ai][bj][m][0], v1 = acc[ai][bj][m][1];
                if constexpr (PLE) {
                    float p[8]; unpack8(cp[bj], p);
                    v0[0] = p[0] * sigmoidf_(v0[0] * r); v0[1] = p[1] * sigmoidf_(v0[1] * r); v0[2] = p[2] * sigmoidf_(v0[2] * r); v0[3] = p[3] * sigmoidf_(v0[3] * r);
                    v1[0] = p[4] * sigmoidf_(v1[0] * r); v1[1] = p[5] * sigmoidf_(v1[1] * r); v1[2] = p[6] * sigmoidf_(v1[2] * r); v1[3] = p[7] * sigmoidf_(v1[3] * r);
                }
                x0 += v0; x1 += v1;
                if (of) { float* op = of + (size_t)row * 1024 + col; *(f32x4*)op = x0; *(f32x4*)(op + 4) = x1; }
                if (ob) {
                    u32x4 w; w.x = cvt_pk_bf16(x0[0], x0[1]); w.y = cvt_pk_bf16(x0[2], x0[3]); w.z = cvt_pk_bf16(x1[0], x1[1]); w.w = cvt_pk_bf16(x1[2], x1[3]);
                    *(u32x4*)(ob + (size_t)row * ldb + col) = w;
                }
                ss += (x0[0] * x0[0] + x0[1] * x0[1]) + (x0[2] * x0[2] + x0[3] * x0[3]) + (x1[0] * x1[0] + x1[1] * x1[1]) + (x1[2] * x1[2] + x1[3] * x1[3]);
            }
            if (ssq) { ss += __shfl_xor(ss, 16); ss += __shfl_xor(ss, 32); if (fq == 0) unsafeAtomicAdd(rs_out + row, ss); }
            if (i < 7) {
#pragma unroll
                for (int bj = 0; bj < 2; ++bj) { cb[bj] = nb[bj]; cp[bj] = np[bj]; cf[bj][0] = nf[bj][0]; cf[bj][1] = nf[bj][1]; }
            }
            asm volatile("" ::: "memory");
        }
#undef RES_LOAD
    }
    template <class U>
    __device__ __forceinline__ void operator()(const f32x4 (&acc)[2][2][4][2], const U& u, int wr, int wc, int fr, int fq) const {
        const int rowb = u.pm * BM + wr * 64 + fr;
        const int colb = u.pn * BM + wc * 32 + 8 * fq;
        if (mode == EP_BRC) { brc_store(acc, u.seg, rowb, colb); return; }
        float rs8[8];
        if (needs_rstd()) {
#pragma unroll
            for (int i = 0; i < 8; ++i) rs8[i] = rowss[rowb + (i >> 2) * HALF + (i & 3) * 16];
            __builtin_amdgcn_sched_barrier(0);
#pragma unroll
            for (int i = 0; i < 8; ++i) rs8[i] = rsqrtf(rs8[i] * (1.0f / 1024.0f) + EPS);
        } else {
#pragma unroll
            for (int i = 0; i < 8; ++i) rs8[i] = 1.0f;
        }
        if (mode == EP_GLU) {
            const int colh = u.pn * HALF + wc * 32 + 8 * fq;
#pragma unroll
            for (int ai = 0; ai < 2; ++ai)
#pragma unroll
                for (int m = 0; m < 4; ++m) {
                    const int row = rowb + ai * HALF + m * 16;
                    const float r = rs8[ai * 4 + m];
                    float h[8];
#pragma unroll
                    for (int n = 0; n < 2; ++n)
#pragma unroll
                        for (int j = 0; j < 4; ++j) { const float g = acc[ai][0][m][n][j] * r, uu = acc[ai][1][m][n][j] * r; h[4 * n + j] = g * sigmoidf_(g) * uu; }
                    *(u32x4*)(ob + (size_t)row * ldb + colh) = pack8(h);
                }
            return;
        }
        if (mode == EP_RES) { if (rin_b) res_loop<true, false>(acc, rowb, colb, fq, rs8); else res_loop<false, false>(acc, rowb, colb, fq, rs8); return; }
        if (mode == EP_PLE) { res_loop<true, true>(acc, rowb, colb, fq, rs8); return; }
#pragma unroll
        for (int ai = 0; ai < 2; ++ai)
#pragma unroll
            for (int m = 0; m < 4; ++m) {
                const int row = rowb + ai * HALF + m * 16;
#pragma unroll
                for (int bj = 0; bj < 2; ++bj) (void)epi8(row, colb + bj * HALF, acc[ai][bj][m][0], acc[ai][bj][m][1], rs8[ai * 4 + m], nullptr);
            }
    }
};


struct UnitX { int pm, pn; const bf16_t* A; const bf16_t* Bt; int K; int seg; bool zero_after; };
template <class Epi, class Sched, bool ALIGN_EPI = false>
__device__ __forceinline__ void gemm_phase(PG8_LAS unsigned char* lds, const Sched& S, const Epi& E, const int tid) {
    const int wid = __builtin_amdgcn_readfirstlane(tid >> 6), lane = tid & 63, wr = wid >> 2, wc = wid & 3, fr = lane & 15, fq = lane >> 4;
    const size_t kstep = (size_t)(BK * 2);
    const unsigned ldsw = (unsigned)wid * 1024u;
    const int aoff = lds_byte(wr * 64 + fr, fq * 8), boff = lds_byte(wc * 32 + fr, fq * 8);
#define PG8_SA(b, h) (((b) * 2 + (h)) * HTB)
#define PG8_SB(b, h) ((4 + (b) * 2 + (h)) * HTB)
#define PG8_STAGE(bufoff, gbase, voff) do { _Pragma("unroll") for (int _i = 0; _i < 2; ++_i) \
        __builtin_amdgcn_global_load_lds((const unsigned*)((const char*)(gbase) + (voff)[_i]), (PG8_LAS unsigned*)(lds + (bufoff) + ldsw + _i * 8192), 16, 0, 0); } while (0)
#define PG8_VOFF(KK, vA, vB) do { int _t = tid; asm volatile("" : "+v"(_t)); _Pragma("unroll") for (int _i = 0; _i < 2; ++_i) { int _R, _C; stage_rc(_t * 16 + _i * 8192, _R, _C); \
        const int _Rb = Epi::PERM ? ((_R & ~31) + perm32(_R & 31)) : _R; (vA)[_i] = (unsigned)(_R * (KK) + _C) * 2u; (vB)[_i] = (unsigned)(_Rb * (KK) + _C) * 2u; } } while (0)
#define PG8_LDA(dst, b, h) do { _Pragma("unroll") for (int m = 0; m < 4; ++m) _Pragma("unroll") for (int k = 0; k < 2; ++k) dst[m][k] = *(const PG8_LAS bf16x8*)(lds + PG8_SA(b, h) + aoff + m * 2048 + k * 1024); } while (0)
#define PG8_LDB(dst, b, h) do { _Pragma("unroll") for (int n = 0; n < 2; ++n) _Pragma("unroll") for (int k = 0; k < 2; ++k) dst[n][k] = *(const PG8_LAS bf16x8*)(lds + PG8_SB(b, h) + boff + n * 2048 + k * 1024); } while (0)
#define PG8_MMA(ai, bj, At, Bt) do { __builtin_amdgcn_s_setprio(1); _Pragma("unroll") for (int m = 0; m < 4; ++m) _Pragma("unroll") for (int n = 0; n < 2; ++n) _Pragma("unroll") for (int k = 0; k < 2; ++k) \
        acc[ai][bj][m][n] = __builtin_amdgcn_mfma_f32_16x16x32_bf16(Bt[n][k], At[m][k], acc[ai][bj][m][n], 0, 0, 0); __builtin_amdgcn_s_setprio(0); } while (0)
#define PG8_WAIT_V(n) asm volatile("s_waitcnt vmcnt(" #n ")" ::: "memory")
#define PG8_WAIT_L(n) asm volatile("s_waitcnt lgkmcnt(" #n ")" ::: "memory")
#define PG8_BAR __builtin_amdgcn_s_barrier()
#define PG8_SCHED __builtin_amdgcn_sched_barrier(0)
#define PG8_SETUNIT(u, pA, pB, hs) do { (hs) = (size_t)HALF * (u).K * 2; (pA) = (const char*)(u).A + (size_t)(u).pm * 2 * (hs); (pB) = (const char*)(u).Bt + (size_t)(u).pn * 2 * (hs); } while (0)
    UnitX cur, nxt; int ui = 0;
    if (!S.next(0, cur)) return;
    f32x4 acc[2][2][4][2];
#pragma unroll
    for (int a = 0; a < 2; ++a)
#pragma unroll
        for (int b = 0; b < 2; ++b)
#pragma unroll
            for (int m = 0; m < 4; ++m)
#pragma unroll
                for (int n = 0; n < 2; ++n) acc[a][b][m][n] = (f32x4){0.f, 0.f, 0.f, 0.f};
    bf16x8 At[4][2], B0[2][2], B1[2][2];
    const char* cA; const char* cB; size_t hstep;
    PG8_SETUNIT(cur, cA, cB, hstep);
    int cK = cur.K;
    unsigned voffA[2], voffB[2];
    PG8_VOFF(cK, voffA, voffB);
    PG8_STAGE(PG8_SB(0, 0), cB, voffB); PG8_STAGE(PG8_SB(0, 1), cB + hstep, voffB); PG8_STAGE(PG8_SA(0, 0), cA, voffA); PG8_STAGE(PG8_SA(0, 1), cA + hstep, voffA);
    if (wr == 1) PG8_BAR;
    PG8_WAIT_V(2); PG8_BAR;
    PG8_STAGE(PG8_SB(1, 0), cB + kstep, voffB); PG8_STAGE(PG8_SA(1, 0), cA + kstep, voffA); PG8_STAGE(PG8_SB(1, 1), cB + hstep + kstep, voffB);
    PG8_WAIT_V(6); PG8_BAR;
    for (;;) {
        const bool has_next = S.next(ui + 1, nxt);
        const char* nA = cA; const char* nB = cB; size_t nhstep = hstep; int nK = cK;
        if (has_next) { PG8_SETUNIT(nxt, nA, nB, nhstep); nK = nxt.K; }
        const int nt = cK / BK;
        for (int t = 0; t < nt; t += 2) {
            const bool last = (t == nt - 2);
            const char* a1 = cA + (size_t)(t + 1) * kstep;
            const char* a2 = last ? nA : cA + (size_t)(t + 2) * kstep; const char* b2 = last ? nB : cB + (size_t)(t + 2) * kstep;
            const char* a3 = a2 + kstep; const char* b3 = b2 + kstep;
            PG8_LDB(B0, 0, 0); PG8_LDB(B1, 0, 1); PG8_SCHED; PG8_LDA(At, 0, 0); PG8_STAGE(PG8_SA(1, 1), a1 + hstep, voffA);
            if (last) { PG8_VOFF(nK, voffA, voffB); hstep = nhstep; }
            PG8_WAIT_V(8); PG8_WAIT_L(0); PG8_BAR; PG8_MMA(0, 0, At, B0); PG8_MMA(0, 1, At, B1); PG8_BAR; PG8_SCHED;
            PG8_LDA(At, 0, 1); PG8_STAGE(PG8_SB(0, 0), b2, voffB); PG8_STAGE(PG8_SB(0, 1), b2 + hstep, voffB); PG8_STAGE(PG8_SA(0, 0), a2, voffA);
            PG8_WAIT_V(8); PG8_WAIT_L(0); PG8_BAR; PG8_MMA(1, 0, At, B0); PG8_MMA(1, 1, At, B1); PG8_BAR; PG8_SCHED;
            PG8_LDB(B0, 1, 0); PG8_LDB(B1, 1, 1); PG8_SCHED; PG8_LDA(At, 1, 0); PG8_STAGE(PG8_SA(0, 1), a2 + hstep, voffA);
            PG8_WAIT_V(8); PG8_WAIT_L(0); PG8_BAR; PG8_MMA(0, 0, At, B0); PG8_MMA(0, 1, At, B1); PG8_BAR; PG8_SCHED;
            PG8_LDA(At, 1, 1); PG8_STAGE(PG8_SB(1, 0), b3, voffB); PG8_STAGE(PG8_SB(1, 1), b3 + hstep, voffB); PG8_STAGE(PG8_SA(1, 0), a3, voffA);
            PG8_WAIT_V(8); PG8_WAIT_L(0); PG8_BAR; PG8_MMA(1, 0, At, B0); PG8_MMA(1, 1, At, B1); PG8_BAR; PG8_SCHED;
        }
        if constexpr (ALIGN_EPI) { if (wr == 0) PG8_BAR; }
        if (cur.zero_after) E(acc, cur, wr, wc, fr, fq);
        if (!has_next) break;
        E.rescale(acc, cur, wr, wc, fr, fq);
        cur = nxt; cA = nA; cB = nB; cK = nK;
        ++ui;
        if constexpr (ALIGN_EPI) { if (wr == 1) PG8_BAR; }
    }
    PG8_WAIT_V(0);
    if constexpr (!ALIGN_EPI) { if (wr == 0) PG8_BAR; }
    PG8_BAR;
#undef PG8_SA
#undef PG8_SB
#undef PG8_STAGE
#undef PG8_VOFF
#undef PG8_LDA
#undef PG8_LDB
#undef PG8_MMA
#undef PG8_WAIT_V
#undef PG8_WAIT_L
#undef PG8_BAR
#undef PG8_SCHED
#undef PG8_SETUNIT
}

struct SegSched {
    StaticOrder so; int nseg;
    int split_rounds;
    const bf16_t* A0; const bf16_t* B0; int K0;
    const unsigned char* ws; const unsigned char* wl;
    __device__ __forceinline__ bool next(int i, UnitX& u) const {
        const int q = (nseg == 1) ? i : (i >> 2), sg = (nseg == 1) ? 0 : (i & 3);
        Unit b;
        if (split_rounds > 0) {
            const int c = so.c; long L;
            if (c < 128) L = (q < split_rounds) ? (long)c + 128 * q : (long)128 * split_rounds + c + 256 * (q - split_rounds);
            else L = (long)128 * split_rounds + c + 256 * q;
            if (!so.next_at(L, b)) return false;
        } else if (!so.next(q, b)) return false;
        u.pm = b.pm; u.pn = b.pn; u.seg = sg; u.zero_after = (sg == nseg - 1);
        if (nseg == 1) { u.A = A0; u.Bt = B0; u.K = K0; }
        else {
            const size_t ao = sg == 0 ? WS_ACTA : (sg == 1 ? WS_ACTB : (sg == 2 ? WS_ACTC : WS_ACTD));
            const size_t bo = sg == 0 ? W_A : (sg == 1 ? W_B : (sg == 2 ? W_C : W_D));
            u.A = (const bf16_t*)(ws + ao); u.Bt = (const bf16_t*)(wl + bo); u.K = (sg == 1) ? 256 : 384;
        }
        return true;
    }
};
}


__device__ const unsigned char T5_BUCKET[3][132] = {
 {0,1,2,3,4,5,6,7,8,9,10,11,12,13,14,15,16,16,16,16,16,16,17,17,17,17,17,17,17,17,18,18,18,18,18,18,18,18,18,18,19,19,19,19,19,19,19,19,19,19,19,19,19,19,20,20,20,20,20,20,20,20,20,20,20,20,20,20,20,20,20,20,20,21,21,21,21,21,21,21,21,21,21,21,21,21,21,21,21,21,21,21,21,21,21,21,21,21,21,22,22,22,22,22,22,22,22,22,22,22,22,22,22,22,22,22,22,22,22,22,22,22,22,22,22,22,22,22,22,0,0,0},
 {0,4,8,12,16,16,17,17,18,18,19,19,19,19,20,20,20,20,20,21,21,21,21,21,21,22,22,22,22,22,22,22,22,22,23,23,23,23,23,23,23,23,23,23,23,23,24,24,24,24,24,24,24,24,24,24,24,24,24,24,24,24,25,25,25,25,25,25,25,25,25,25,25,25,25,25,25,25,25,25,25,25,25,26,26,26,26,26,26,26,26,26,26,26,26,26,26,26,26,26,26,26,26,26,26,26,26,26,26,26,26,26,26,27,27,27,27,27,27,27,27,27,27,27,27,27,27,27,27,0,0,0},
 {0,16,18,19,20,21,21,22,22,23,23,23,24,24,24,24,25,25,25,25,25,26,26,26,26,26,26,26,26,27,27,27,27,27,27,27,27,27,27,28,28,28,28,28,28,28,28,28,28,28,28,28,29,29,29,29,29,29,29,29,29,29,29,29,29,29,29,29,29,29,30,30,30,30,30,30,30,30,30,30,30,30,30,30,30,30,30,30,30,30,30,30,30,30,30,31,31,31,31,31,31,31,31,31,31,31,31,31,31,31,31,31,31,31,31,31,31,31,31,31,31,31,31,31,31,31,31,31,31,0,0,0}};

struct Args { const float* in[36]; float* out; unsigned char* ws; int ph_lo, ph_hi; };
typedef const __attribute__((address_space(4))) Args* ArgsP;


enum { IN_XP = 0, IN_XS, IN_C128, IN_C512, IN_C2048, IN_SCONV, IN_SPOOL, IN_PP, IN_PS, IN_RELB, IN_NMIX, IN_WIN, IN_CONVW, IN_CONVB, IN_CLNG, IN_CLNB, IN_WA,
       IN_QN, IN_KN, IN_WB, IN_SLNG, IN_SLNB, IN_SGUW, IN_SGUB, IN_WC, IN_POOLW, IN_POOLS, IN_WD, IN_WO, IN_NFFN, IN_WGATE, IN_WUP, IN_WDOWN, IN_NPLE, IN_WPG, IN_WPLE };

#define LDS_WAIT() asm volatile("s_waitcnt lgkmcnt(0)" ::: "memory")

__device__ __forceinline__ void transpose_item(const float* W, int K, int N, bf16_t* WT, const float* gain, int mode, LAS float* scr, int item, int lane) {
    const int nblk = N / 64, kb = item / nblk, nb = item % nblk, k0 = 64 * kb, n0 = 64 * nb;
    {
        const int kk = lane >> 4, n4 = (lane & 15) * 4;
        f32x4 v[16];
#pragma unroll
        for (int i = 0; i < 16; ++i) v[i] = *(const f32x4*)(W + (size_t)(k0 + kk + 4 * i) * N + n0 + n4);
#pragma unroll
        for (int i = 0; i < 16; ++i) { LAS float* d = scr + (kk + 4 * i) * 65 + n4; d[0] = v[i][0]; d[1] = v[i][1]; d[2] = v[i][2]; d[3] = v[i][3]; }
    }
    LDS_WAIT(); asm volatile("" ::: "memory");
    const int c = lane & 7;
    f32x4 g0 = {1.f, 1.f, 1.f, 1.f}, g1 = {1.f, 1.f, 1.f, 1.f};
    if (gain) { g0 = *(const f32x4*)(gain + k0 + 8 * c); g1 = *(const f32x4*)(gain + k0 + 8 * c + 4); }
#pragma unroll
    for (int j = 0; j < 8; ++j) {
        const int n = (lane >> 3) + 8 * j; const LAS float* s = scr + (8 * c) * 65 + n;
        u32x4 o; o.x = cvt_pk_bf16(s[0 * 65] * g0[0], s[1 * 65] * g0[1]); o.y = cvt_pk_bf16(s[2 * 65] * g0[2], s[3 * 65] * g0[3]); o.z = cvt_pk_bf16(s[4 * 65] * g1[0], s[5 * 65] * g1[1]); o.w = cvt_pk_bf16(s[6 * 65] * g1[2], s[7 * 65] * g1[3]);
        const int nn = n0 + n;
        const int row = (mode == 0) ? nn : ((nn >> 7) * 256 + (nn & 127) + (mode == 2 ? 128 : 0));
        *(u32x4*)(WT + (size_t)row * K + k0 + 8 * c) = o;
    }
    LDS_WAIT(); asm volatile("" ::: "memory");
}

__device__ __forceinline__ void poolfold_item(const float* pw, const float* psc, const float* wd, bf16_t* WT, int item, int lane) {
    const int nb = item / 48, cb = item - nb * 48, c0 = 8 * cb, g = c0 / 96, cl0 = c0 - 96 * g, n = 64 * nb + lane;
    float acc[8];
#pragma unroll
    for (int i = 0; i < 8; ++i) acc[i] = 0.f;
    const float* pwg = pw + (size_t)(g * 96 + cl0) * 96;
    const float* wdg = wd + (size_t)(g * 96) * D + n;
    const float* scg = psc + g * 96;
#pragma unroll 32
    for (int cp = 0; cp < 96; ++cp) {
        const float x = wdg[(size_t)cp * D] * scg[cp];
#pragma unroll
        for (int i = 0; i < 8; ++i) acc[i] += pwg[i * 96 + cp] * x;
    }
    *(u32x4*)(WT + (size_t)n * 384 + c0) = pack8(acc);
}

constexpr int STAG_Q_Z = 224, STAG_Q_GU = 320;
constexpr int STAG_TOT_Z = STAG_Q_Z * (159 * 158 / 2), STAG_TOT_GU = STAG_Q_GU * (106 * 105 / 2), STAG_TOT = 2 * (STAG_TOT_Z + STAG_TOT_GU);
static_assert(2145 - 8 * 256 == 97 && 1430 - 5 * 256 == 150, "stagger geometry");
constexpr int CP_N0 = 64 * (128 - 8) * 128, CP_N1 = 64 * (512 - 8) * 128, CP_N2 = 64 * (2048 - 8) * 128, CP_TOT = CP_N0 + CP_N1 + CP_N2;
__device__ __forceinline__ void cache_copy_addr(ArgsP a, int i, const f32x4*& src, f32x4*& dst) {
    if (i < CP_N0) { constexpr int n4 = 120 * 128; const int ls = i / n4, off = i - ls * n4; src = (const f32x4*)a->in[IN_C128] + (size_t)ls * 128 * 128 + 1024 + off; dst = (f32x4*)(a->out + O_KVS0) + (size_t)ls * 128 * 128 + off; }
    else if (i < CP_N0 + CP_N1) { constexpr int n4 = 504 * 128; const int k = i - CP_N0, ls = k / n4, off = k - ls * n4; src = (const f32x4*)a->in[IN_C512] + (size_t)ls * 512 * 128 + 1024 + off; dst = (f32x4*)(a->out + O_KVS1) + (size_t)ls * 512 * 128 + off; }
    else { constexpr int n4 = 2040 * 128; const int k = i - CP_N0 - CP_N1, ls = k / n4, off = k - ls * n4; src = (const f32x4*)a->in[IN_C2048] + (size_t)ls * 2048 * 128 + 1024 + off; dst = (f32x4*)(a->out + O_KVS2) + (size_t)ls * 2048 * 128 + off; }
}
__device__ __forceinline__ void cache_copy_range(ArgsP a, int lo, int hi, int ith, int nth) {
    constexpr int U = 16;
    for (int i0 = lo + ith; i0 < hi; i0 += U * nth) {
        f32x4 v[U];
#pragma unroll
        for (int k = 0; k < U; ++k) { int i = i0 + k * nth; i = i < hi ? i : hi - 1; const f32x4* src; f32x4* dst; cache_copy_addr(a, i, src, dst); v[k] = __builtin_nontemporal_load(src); }
#pragma unroll
        for (int k = 0; k < U; ++k) { const int i = i0 + k * nth; if (i < hi) { const f32x4* src; f32x4* dst; cache_copy_addr(a, i, src, dst); __builtin_nontemporal_store(v[k], dst); } }
    }
}

__device__ __forceinline__ void p0_prologue(ArgsP a, LAS unsigned char* lds, int tid, int lane, int wave, int NCU, int cu, int part, bool stag_z0_here) {
    const int G = NCU, bid = cu;
    const bool do0 = part != 1, do1 = part != 0;
    unsigned char* ws = a->ws;
    LAS float* scr = (LAS float*)(lds + wave * 16640);
    const int gw = bid * 8 + wave, NGW = G * 8;
    const int gtid = bid * 512 + tid, NT = G * 512;
    constexpr int I_IN = 16 * 130, I_A = 6 * 16, I_B = 4 * 16, I_O = 16 * 16, I_G = 16 * 44, I_DN = 44 * 16, I_PLE = 4 * 16, I_PF = 16 * 48;
    constexpr int I_LAYER = I_IN + 2 * I_A + I_PF + I_B + 2 * I_O + 2 * I_G + I_DN + I_PLE;
    for (int it0 = gw; it0 < 2 * I_LAYER * P0R_T; it0 += NGW) {
        const int it = it0 % (2 * I_LAYER);
        const int l = it / I_LAYER; int r = it - l * I_LAYER;
        const bool crit = (l == 0 && r < I_IN);
        if (crit ? !do0 : !do1) continue;
        unsigned char* wl = ws + WS_W + (size_t)l * WL;
        if (r < I_IN) { transpose_item(a->in[IN_WIN] + (size_t)l * D * DIN, D, DIN, (bf16_t*)(wl + W_IN), a->in[IN_NMIX] + l * D, 0, scr, r, lane); continue; } r -= I_IN;
        if (r < I_A) { transpose_item(a->in[IN_WA] + (size_t)l * 384 * D, 384, D, (bf16_t*)(wl + W_A), nullptr, 0, scr, r, lane); continue; } r -= I_A;
        if (r < I_B) { transpose_item(a->in[IN_WB] + (size_t)l * 256 * D, 256, D, (bf16_t*)(wl + W_B), nullptr, 0, scr, r, lane); continue; } r -= I_B;
        if (r < I_A) { transpose_item(a->in[IN_WC] + (size_t)l * 384 * D, 384, D, (bf16_t*)(wl + W_C), nullptr, 0, scr, r, lane); continue; } r -= I_A;
        if (r < I_PF) { poolfold_item(a->in[IN_POOLW] + (size_t)l * 4 * 96 * 96, a->in[IN_POOLS] + l * 384, a->in[IN_WD] + (size_t)l * 384 * D, (bf16_t*)(wl + W_D), r, lane); continue; } r -= I_PF;
        if (r < I_O) { transpose_item(a->in[IN_WO] + (size_t)l * D * D, D, D, (bf16_t*)(wl + W_O), nullptr, 0, scr, r, lane); continue; } r -= I_O;
        if (r < I_G) { transpose_item(a->in[IN_WGATE] + (size_t)l * D * DFF, D, DFF, (bf16_t*)(wl + W_GU), a->in[IN_NFFN] + l * D, 1, scr, r, lane); continue; } r -= I_G;
        if (r < I_G) { transpose_item(a->in[IN_WUP] + (size_t)l * D * DFF, D, DFF, (bf16_t*)(wl + W_GU), a->in[IN_NFFN] + l * D, 2, scr, r, lane); continue; } r -= I_G;
        if (r < I_DN) { transpose_item(a->in[IN_WDOWN] + (size_t)l * DFF * D, DFF, D, (bf16_t*)(wl + W_DN), nullptr, 0, scr, r, lane); continue; } r -= I_DN;
        if (r < I_O) { transpose_item(a->in[IN_WPG] + (size_t)l * D * D, D, D, (bf16_t*)(wl + W_PG), a->in[IN_NPLE] + l * D, 0, scr, r, lane); continue; } r -= I_O;
        transpose_item(a->in[IN_WPLE] + (size_t)l * DPLE * D, DPLE, D, (bf16_t*)(wl + W_PLE), nullptr, 0, scr, r, lane);
    }
    for (int i = gtid; i < 2 * (NZ - DIN) * D / 8; i += NT) { const int l = i / ((NZ - DIN) * D / 8), o = i - l * ((NZ - DIN) * D / 8);
        if (l == 0 ? !do0 : !do1) continue;
        u32x4 z4 = {0u, 0u, 0u, 0u}; asm volatile("" : "+v"(z4));
        *(u32x4*)(ws + WS_W + (size_t)l * WL + W_IN + ((size_t)DIN * D + (size_t)o * 8) * 2) = z4; }
    float* rs0 = (float*)(ws + WS_CTL) + RS_MIX0 * RS_STRIDE;
    bf16_t* xb = (bf16_t*)(ws + WS_XB);
    if (do0) for (int m0 = gw; m0 < M * P0R_X; m0 += NGW) {
        const int m = m0 % M;
        const float* xr = (m < MP) ? a->in[IN_XP] + (size_t)m * D : a->in[IN_XS] + (size_t)(m - MP) * D;
        f32x4 v[4]; float s = 0.f;
#pragma unroll
        for (int j = 0; j < 4; ++j) { v[j] = ((const f32x4*)xr)[lane + 64 * j]; s += (v[j][0] * v[j][0] + v[j][1] * v[j][1]) + (v[j][2] * v[j][2] + v[j][3] * v[j][3]); }
        s = wave_sum(s);
        if (lane == 0) rs0[m] = s;
#pragma unroll
        for (int j = 0; j < 4; ++j) { u32x2 w; w.x = cvt_pk_bf16(v[j][0], v[j][1]); w.y = cvt_pk_bf16(v[j][2], v[j][3]); ((u32x2*)(xb + (size_t)m * D))[lane + 64 * j] = w; }
    }
    if (!do1) return;
    bf16_t* peb = (bf16_t*)(ws + WS_PEB);
    for (int i = gtid; i < 2 * M * 32; i += NT) {
        const int l = i / (M * 32), rem = i - l * (M * 32), m = rem >> 5, c8 = rem & 31;
        const float* src = (m < MP) ? a->in[IN_PP] + ((size_t)l * MP + m) * DPLE + c8 * 8 : a->in[IN_PS] + ((size_t)l * MS + (m - MP)) * DPLE + c8 * 8;
        const f32x4 p0 = *(const f32x4*)src, p1 = *(const f32x4*)(src + 4);
        u32x4 w; w.x = cvt_pk_bf16(p0[0], p0[1]); w.y = cvt_pk_bf16(p0[2], p0[3]); w.z = cvt_pk_bf16(p1[0], p1[1]); w.w = cvt_pk_bf16(p1[2], p1[3]);
        *(u32x4*)(peb + ((size_t)l * M + m) * DPLE + c8 * 8) = w;
    }
    cache_copy_range(a, STAG_TOT, CP_TOT, gtid, NT);
    if (stag_z0_here) cache_copy_range(a, 0, STAG_TOT_Z, gtid, NT);
    if (!stag_z0_here && part == 2) cache_copy_range(a, 0, STAG_TOT, gtid, NT);
    for (int i = gtid; i < 2 * 4 * 128 * 16; i += NT) {
        const int row = i >> 4, j8 = (i & 15) * 8, ii = row & 127;
        const float* src = a->in[IN_SGUW] + (size_t)row * 128 + j8; const f32x4 p0 = *(const f32x4*)src, p1 = *(const f32x4*)(src + 4);
        float v[8] = {p0[0], p0[1], p0[2], p0[3], p1[0], p1[1], p1[2], p1[3]};
#pragma unroll
        for (int k = 0; k < 8; ++k) v[k] = (j8 + k <= ii) ? v[k] : 0.f;
        *(u32x4*)((bf16_t*)(ws + WS_SGUW) + (size_t)row * 128 + j8) = pack8(v);
    }
    for (int i = gtid; i < 64 * 22 * 96; i += NT) { const int ls = i / (22 * 96), off = i - ls * (22 * 96);
        ((f32x4*)(a->out + O_CONVS))[(size_t)ls * 30 * 96 + off] = ((const f32x4*)a->in[IN_SCONV])[(size_t)ls * 30 * 96 + 8 * 96 + off]; }
    for (int i = gtid; i < 64 * 7 * 96; i += NT) { const int ls = i / (7 * 96), off = i - ls * (7 * 96);
        ((f32x4*)(a->out + O_POOLS))[(size_t)ls * 15 * 96 + off] = ((const f32x4*)a->in[IN_SPOOL])[(size_t)ls * 15 * 96 + 8 * 96 + off]; }
}

__device__ __forceinline__ float* kv_out_ptr(float* out, int g, bool isP, int l, int s, int pos) {
    const int W = 128 << (2 * g);
    const size_t base = isP ? (g == 0 ? O_KVP0 : (g == 1 ? O_KVP1 : O_KVP2)) : (g == 0 ? O_KVS0 : (g == 1 ? O_KVS1 : O_KVS2));
    const size_t seq = isP ? (size_t)l : (size_t)(l * 32 + s);
    return out + base + (seq * W + pos) * 512;
}

struct PzRow { u32x4 La, Lb, Lvv, Lq0, Lk0, Lq1, Lk1; };
__device__ __forceinline__ PzRow postz_load(ArgsP a, int m, int lane) {
    const bf16_t* zr = (const bf16_t*)(a->ws + WS_Z) + (size_t)m * ZP;
    const int lc48 = lane < 48 ? lane : 47, ch1 = 64 + (lane & 31);
    PzRow R;
    R.La = *(const u32x4*)(zr + ZA + 8 * lc48); R.Lb = *(const u32x4*)(zr + ZB + 8 * lc48); R.Lvv = *(const u32x4*)(zr + ZVV + 8 * lc48);
    R.Lq0 = *(const u32x4*)(zr + ZQ + 8 * lane); R.Lk0 = *(const u32x4*)(zr + ZK + 8 * lane); R.Lq1 = *(const u32x4*)(zr + ZQ + 8 * ch1); R.Lk1 = *(const u32x4*)(zr + ZK + 8 * ch1);
    return R;
}
__device__ __forceinline__ u32x4 postz_row(ArgsP a, int l, int m, int lane, const PzRow& R) {
    u32x4 vvpk = {0u, 0u, 0u, 0u};
    unsigned char* ws = a->ws;
    const bf16_t* zr = (const bf16_t*)(ws + WS_Z) + (size_t)m * ZP;
    const bool isP = m < MP; const int t = isP ? m : ((m - MP) & 7); const int s = isP ? 0 : ((m - MP) >> 3);
    const int ch1 = 64 + (lane & 31);
    const u32x4 La = R.La, Lb = R.Lb, Lvv = R.Lvv, Lq0 = R.Lq0, Lk0 = R.Lk0, Lq1 = R.Lq1, Lk1 = R.Lk1;
    if (lane < 48) {
        float av[8], bv[8], g[8]; unpack8(La, av); unpack8(Lb, bv);
#pragma unroll
        for (int i = 0; i < 8; ++i) g[i] = av[i] * sigmoidf_(bv[i]);
        *(u32x4*)((bf16_t*)(ws + WS_GLU) + (size_t)m * 384 + 8 * lane) = pack8(g);
        float* dst = nullptr;
        if (isP) { if (t >= TP - 30) dst = a->out + O_CONVP + ((size_t)l * 30 + (t - (TP - 30))) * 384 + 8 * lane; }
        else dst = a->out + O_CONVS + ((size_t)(l * 32 + s) * 30 + 22 + t) * 384 + 8 * lane;
        if (dst) { *(f32x4*)dst = (f32x4){g[0], g[1], g[2], g[3]}; *(f32x4*)(dst + 4) = (f32x4){g[4], g[5], g[6], g[7]}; }
        float* pd = nullptr;
        if (isP) { if (t >= TP - 15) pd = a->out + O_POOLP + ((size_t)l * 15 + (t - (TP - 15))) * 384 + 8 * lane; }
        else pd = a->out + O_POOLS + ((size_t)(l * 32 + s) * 15 + 7 + t) * 384 + 8 * lane;
        if (pd) { float zd[8]; unpack8(*(const u32x4*)(zr + ZD + 8 * lane), zd); *(f32x4*)pd = (f32x4){zd[0], zd[1], zd[2], zd[3]}; *(f32x4*)(pd + 4) = (f32x4){zd[4], zd[5], zd[6], zd[7]}; }
    }
    const float* qw = a->in[IN_QN] + l * HD; const float* kw = a->in[IN_KN] + l * HD;
#pragma unroll
    for (int it = 0; it < 2; ++it) {
        const int ch = lane + 64 * it; const bool act = ch < 96; const int chc = (it == 0) ? lane : ch1;
        const int h = chc >> 3, dc = (chc & 7) * 8, g = h >> 2, hs = h & 3;
        float q[8], k[8];
        unpack8(it == 0 ? Lq0 : Lq1, q); unpack8(it == 0 ? Lk0 : Lk1, k);
        float sq = 0.f, sk = 0.f;
#pragma unroll
        for (int i = 0; i < 8; ++i) { sq += q[i] * q[i]; sk += k[i] * k[i]; }
        sq += __shfl_xor(sq, 1); sq += __shfl_xor(sq, 2); sq += __shfl_xor(sq, 4);
        sk += __shfl_xor(sk, 1); sk += __shfl_xor(sk, 2); sk += __shfl_xor(sk, 4);
        const float rq = rsqrtf(sq * (1.0f / 64.0f) + EPS) * (0.125f * LOG2E), rk = rsqrtf(sk * (1.0f / 64.0f) + EPS);
        const f32x4 qw0 = *(const f32x4*)(qw + dc), qw1 = *(const f32x4*)(qw + dc + 4), kw0 = *(const f32x4*)(kw + dc), kw1 = *(const f32x4*)(kw + dc + 4);
#pragma unroll
        for (int i = 0; i < 4; ++i) { q[i] *= rq * qw0[i]; q[4 + i] *= rq * qw1[i]; k[i] *= rk * kw0[i]; k[4 + i] *= rk * kw1[i]; }
        if (act) {
            *(u32x4*)((bf16_t*)(ws + WS_QN) + (size_t)m * DQ + 8 * ch) = pack8(q);
            *(u32x4*)((bf16_t*)(ws + WS_KN) + (size_t)m * DQ + 8 * ch) = pack8(k);
            const int W = 128 << (2 * g);
            const int pos = isP ? t - (TP - W) : W - 8 + t;
            if (pos >= 0) {
                float* kvp = kv_out_ptr(a->out, g, isP, l, s, pos) + hs * 64 + dc;
                *(f32x4*)kvp = (f32x4){k[0], k[1], k[2], k[3]}; *(f32x4*)(kvp + 4) = (f32x4){k[4], k[5], k[6], k[7]};
                float v[8]; unpack8(*(const u32x4*)(zr + ZV + 8 * ch), v);
                *(f32x4*)(kvp + 256) = (f32x4){v[0], v[1], v[2], v[3]}; *(f32x4*)(kvp + 260) = (f32x4){v[4], v[5], v[6], v[7]};
            }
        }
    }
    {
        float x[8]; const bool act = lane < 48;
        unpack8(Lvv, x);
        float sm = 0.f;
#pragma unroll
        for (int i = 0; i < 8; ++i) sm += x[i];
        sm = wave_sum(act ? sm : 0.f);
        const float mean = sm * (1.0f / 384.0f);
        float sv = 0.f;
#pragma unroll
        for (int i = 0; i < 8; ++i) { x[i] -= mean; sv += x[i] * x[i]; }
        sv = wave_sum(act ? sv : 0.f);
        const float rstd = rsqrtf(sv * (1.0f / 384.0f) + LN_EPS);
        if (act) {
            const float* gg = a->in[IN_SLNG] + l * 384 + 8 * lane; const float* bb = a->in[IN_SLNB] + l * 384 + 8 * lane;
            const f32x4 g0 = *(const f32x4*)gg, g1 = *(const f32x4*)(gg + 4), b0 = *(const f32x4*)bb, b1 = *(const f32x4*)(bb + 4);
#pragma unroll
            for (int i = 0; i < 4; ++i) { x[i] = x[i] * rstd * g0[i] + b0[i]; x[4 + i] = x[4 + i] * rstd * g1[i] + b1[i]; }
            vvpk = pack8(x);
            if (!isP) *(u32x4*)((bf16_t*)(ws + WS_VLN) + (size_t)m * 384 + 8 * lane) = vvpk;
            if (!isP) { float* sp = a->out + O_SGUS + ((size_t)(l * 32 + s) * 8 + t) * 384 + 8 * lane; *(f32x4*)sp = (f32x4){x[0], x[1], x[2], x[3]}; *(f32x4*)(sp + 4) = (f32x4){x[4], x[5], x[6], x[7]}; }
        }
    }
    return vvpk;
}
__device__ __forceinline__ void postz_rows8(ArgsP a, int l, int m0, int lane) {
    u32x4 pk[8];
    PzRow cur = postz_load(a, m0, lane);
#pragma unroll
    for (int r = 0; r < 8; ++r) {
        PzRow nxt = cur;
        if (r < 7) nxt = postz_load(a, m0 + r + 1, lane);
        __builtin_amdgcn_sched_barrier(0);
        pk[r] = postz_row(a, l, m0 + r, lane, cur);
        cur = nxt;
    }
    if (lane < 48) {
        bf16_t* vt = (bf16_t*)(a->ws + WS_VLN) + ((size_t)(m0 >> 7) * 384 + 8 * lane) * 128 + (m0 & 127);
#define PZ_LO(w) ((w) & 0xffffu)
#define PZ_HI(w) ((w) >> 16)
#define PZ_ROW(sel, comp) (u32x4){ sel(pk[0].comp) | (sel(pk[1].comp) << 16), sel(pk[2].comp) | (sel(pk[3].comp) << 16), sel(pk[4].comp) | (sel(pk[5].comp) << 16), sel(pk[6].comp) | (sel(pk[7].comp) << 16) }
        *(u32x4*)(vt + 0 * 128) = PZ_ROW(PZ_LO, x); *(u32x4*)(vt + 1 * 128) = PZ_ROW(PZ_HI, x);
        *(u32x4*)(vt + 2 * 128) = PZ_ROW(PZ_LO, y); *(u32x4*)(vt + 3 * 128) = PZ_ROW(PZ_HI, y);
        *(u32x4*)(vt + 4 * 128) = PZ_ROW(PZ_LO, z); *(u32x4*)(vt + 5 * 128) = PZ_ROW(PZ_HI, z);
        *(u32x4*)(vt + 6 * 128) = PZ_ROW(PZ_LO, w); *(u32x4*)(vt + 7 * 128) = PZ_ROW(PZ_HI, w);
#undef PZ_LO
#undef PZ_HI
#undef PZ_ROW
    }
}

constexpr int TAB_OFF = 122880;
__device__ __forceinline__ void attn_sample_task(ArgsP a, int l, int m, int h, int lane, const LAS float* tab) {
    unsigned char* ws = a->ws;
    const bf16_t* qn = (const bf16_t*)(ws + WS_QN); const bf16_t* kn = (const bf16_t*)(ws + WS_KN); const bf16_t* z = (const bf16_t*)(ws + WS_Z);
    const int g = h >> 2, hs = h & 3, sh = 2 * g, W = 128 << sh;
    const int t = (m - MP) & 7, s = (m - MP) >> 3;
    const int ks = lane >> 3, c = lane & 7;
    float qf[8]; unpack8(*(const u32x4*)(qn + (size_t)m * DQ + h * 64 + 8 * c), qf);
    const float* cache = a->in[IN_C128 + g] + ((size_t)(l * 32 + s) * W) * 512 + hs * 64 + 8 * c;
    const LAS float* tb = tab + h * 132;
    float sc[17];
    const int tk0 = t - (ks << sh);
    const size_t nrow = (size_t)(MP + 8 * s + (tk0 < 0 ? 0 : tk0));
    const int prow0 = tk0 < 0 ? W + tk0 : W - 1;
    {
        float kf[8]; unpack8(*(const u32x4*)(kn + nrow * DQ + h * 64 + 8 * c), kf);
        const float* p = cache + (size_t)prow0 * 512; const f32x4 x0 = *(const f32x4*)p, x1 = *(const f32x4*)(p + 4);
        if (tk0 < 0) { kf[0] = x0[0]; kf[1] = x0[1]; kf[2] = x0[2]; kf[3] = x0[3]; kf[4] = x1[0]; kf[5] = x1[1]; kf[6] = x1[2]; kf[7] = x1[3]; }
        float d = 0.f;
#pragma unroll
        for (int i = 0; i < 8; ++i) d += qf[i] * kf[i];
        d += __shfl_xor(d, 1); d += __shfl_xor(d, 2); d += __shfl_xor(d, 4);
        sc[0] = d + tb[ks];
    }
#pragma unroll
    for (int hb = 0; hb < 2; ++hb) {
        f32x4 x0[8], x1[8];
#pragma unroll
        for (int q = 0; q < 8; ++q) { const int it = 1 + 8 * hb + q; const int j = it * 8 + ks; const int jj = j <= 128 ? j : 128; const float* p = cache + (size_t)(W + t - (jj << sh)) * 512; x0[q] = *(const f32x4*)p; x1[q] = *(const f32x4*)(p + 4); }
        __builtin_amdgcn_sched_barrier(0);
#pragma unroll
        for (int q = 0; q < 8; ++q) {
            const int it = 1 + 8 * hb + q; const int j = it * 8 + ks; const bool inr = j <= 128; const int jj = inr ? j : 128;
            const f32x4 a0 = x0[q], a1 = x1[q];
            float d = (qf[0] * a0[0] + qf[1] * a0[1]) + (qf[2] * a0[2] + qf[3] * a0[3]) + (qf[4] * a1[0] + qf[5] * a1[1]) + (qf[6] * a1[2] + qf[7] * a1[3]);
            d += __shfl_xor(d, 1); d += __shfl_xor(d, 2); d += __shfl_xor(d, 4);
            d += tb[jj];
            sc[it] = inr ? d : -1.0e30f;
        }
        __builtin_amdgcn_sched_barrier(0);
    }
    float mx = sc[0];
#pragma unroll
    for (int it = 1; it < 17; ++it) mx = fmaxf(mx, sc[it]);
    mx = fmaxf(mx, __shfl_xor(mx, 8)); mx = fmaxf(mx, __shfl_xor(mx, 16)); mx = fmaxf(mx, __shfl_xor(mx, 32));
    float sum = 0.f;
#pragma unroll
    for (int it = 0; it < 17; ++it) { sc[it] = __builtin_amdgcn_exp2f(sc[it] - mx); sum += sc[it]; }
    sum += __shfl_xor(sum, 8); sum += __shfl_xor(sum, 16); sum += __shfl_xor(sum, 32);
    float acc[8];
    {
        float vf[8]; unpack8(*(const u32x4*)(z + nrow * ZP + ZV + h * 64 + 8 * c), vf);
        const float* p = cache + (size_t)prow0 * 512 + 256; const f32x4 x0 = *(const f32x4*)p, x1 = *(const f32x4*)(p + 4);
        if (tk0 < 0) { vf[0] = x0[0]; vf[1] = x0[1]; vf[2] = x0[2]; vf[3] = x0[3]; vf[4] = x1[0]; vf[5] = x1[1]; vf[6] = x1[2]; vf[7] = x1[3]; }
#pragma unroll
        for (int i = 0; i < 8; ++i) acc[i] = sc[0] * vf[i];
    }
#pragma unroll
    for (int hb = 0; hb < 2; ++hb) {
        f32x4 x0[8], x1[8];
#pragma unroll
        for (int q = 0; q < 8; ++q) { const int it = 1 + 8 * hb + q; const int j = it * 8 + ks; const int jj = j <= 128 ? j : 128; const float* p = cache + (size_t)(W + t - (jj << sh)) * 512 + 256; x0[q] = *(const f32x4*)p; x1[q] = *(const f32x4*)(p + 4); }
        __builtin_amdgcn_sched_barrier(0);
#pragma unroll
        for (int q = 0; q < 8; ++q) {
            const float pw = sc[1 + 8 * hb + q]; const f32x4 a0 = x0[q], a1 = x1[q];
            acc[0] += pw * a0[0]; acc[1] += pw * a0[1]; acc[2] += pw * a0[2]; acc[3] += pw * a0[3]; acc[4] += pw * a1[0]; acc[5] += pw * a1[1]; acc[6] += pw * a1[2]; acc[7] += pw * a1[3];
        }
        __builtin_amdgcn_sched_barrier(0);
    }
    const float inv = 1.0f / sum;
#pragma unroll
    for (int i = 0; i < 8; ++i) { float v = acc[i]; v += __shfl_xor(v, 8); v += __shfl_xor(v, 16); v += __shfl_xor(v, 32); acc[i] = v * inv; }
    if (lane < 8) *(u32x4*)((bf16_t*)(ws + WS_OPART) + (size_t)m * DQ + h * 64 + 8 * c) = pack8(acc);
    if (lane == 0) ((float*)(ws + WS_LSE))[(size_t)m * 12 + h] = (mx + __builtin_amdgcn_logf(sum) + ATT_C2) * LN2;
}

constexpr int VSP = 72;
typedef short v4i16_t __attribute__((ext_vector_type(4)));
constexpr int NT_ATTP = 12 * (TP / 32);
__device__ __forceinline__ void attn_mfma_task(ArgsP a, LAS unsigned char* wlds, int l, int task, int lane, const LAS float* tab) {
    unsigned char* ws = a->ws;
    const bf16_t* qn = (const bf16_t*)(ws + WS_QN); const bf16_t* kn = (const bf16_t*)(ws + WS_KN); const bf16_t* z = (const bf16_t*)(ws + WS_Z);
    LAS bf16_t* Vs = (LAS bf16_t*)wlds;
    const int h = task / (TP / 32); const int rem = task - h * (TP / 32);
    const int sh = 2 * (h >> 2);
    const int nb = (TP / 32) >> sh;
    const int r = rem / nb, ib = rem - r * nb;
    const int c = lane & 31, hh = lane >> 5;
    const int tq = ((32 * ib + c) << sh) + r;
    bf16x8 qf[4];
#pragma unroll
    for (int s = 0; s < 4; ++s) qf[s] = *(const bf16x8*)(qn + (size_t)tq * DQ + h * 64 + 16 * s + 8 * hh);
    f32x16 o0, o1;
#pragma unroll
    for (int i = 0; i < 16; ++i) { o0[i] = 0.f; o1[i] = 0.f; }
    float lrun = 0.f;
    const int i0 = 32 * ib - 128;
    const LAS float* tb = tab + h * 132;
    bf16x8 kf[4]; u32x4 vr[4];
    {
        int ik = i0 + c; ik = ik < 0 ? 0 : ik; const size_t tk = ((size_t)ik << sh) + r;
#pragma unroll
        for (int s = 0; s < 4; ++s) kf[s] = *(const bf16x8*)(kn + tk * DQ + h * 64 + 16 * s + 8 * hh);
#pragma unroll
        for (int q = 0; q < 4; ++q) { int ikv = i0 + (lane >> 3) + 8 * q; ikv = ikv < 0 ? 0 : ikv; const size_t tv = ((size_t)ikv << sh) + r;
            vr[q] = *(const u32x4*)(z + tv * ZP + ZV + h * 64 + 8 * (lane & 7)); }
    }
#pragma unroll 1
    for (int kt = 0; kt < 5; ++kt) {
        const int ib0 = i0 + 32 * kt;
        bf16x8 kfn[4]; u32x4 vrn[4];
        { const int ibn = i0 + 32 * (kt < 4 ? kt + 1 : 4);
          int ik = ibn + c; ik = ik < 0 ? 0 : ik; const size_t tk = ((size_t)ik << sh) + r;
#pragma unroll
          for (int s = 0; s < 4; ++s) kfn[s] = *(const bf16x8*)(kn + tk * DQ + h * 64 + 16 * s + 8 * hh);
#pragma unroll
          for (int q = 0; q < 4; ++q) { int ikv = ibn + (lane >> 3) + 8 * q; ikv = ikv < 0 ? 0 : ikv; const size_t tv = ((size_t)ikv << sh) + r;
              vrn[q] = *(const u32x4*)(z + tv * ZP + ZV + h * 64 + 8 * (lane & 7)); }
        }
        const bool need_mask = (kt == 0) || (kt == 4) || (ib < 4);
        f32x16 sa;
        if (need_mask) {
#pragma unroll
            for (int reg = 0; reg < 16; ++reg) { const int kr = (reg & 3) + 8 * (reg >> 2) + 4 * hh; const int j = c + 128 - 32 * kt - kr; const int jj = j < 0 ? 0 : (j > 128 ? 128 : j); sa[reg] = tb[jj]; }
        } else {
            const LAS float* tbl = tb + (c + 128 - 32 * kt - 4 * hh);
#pragma unroll
            for (int reg = 0; reg < 16; ++reg) sa[reg] = tbl[-((reg & 3) + 8 * (reg >> 2))];
        }
#pragma unroll
        for (int s = 0; s < 4; ++s) sa = __builtin_amdgcn_mfma_f32_32x32x16_bf16(kf[s], qf[s], sa, 0, 0, 0);
        if (need_mask) {
#pragma unroll
            for (int reg = 0; reg < 16; ++reg) {
                const int kr = (reg & 3) + 8 * (reg >> 2) + 4 * hh;
                const int j = c + 128 - 32 * kt - kr;
                const bool valid = (j >= 0) && (j <= 128) && (ib0 + kr >= 0);
                sa[reg] = valid ? sa[reg] : -1.0e30f;
            }
        }
        float lsum = 0.f;
#pragma unroll
        for (int reg = 0; reg < 16; ++reg) { const float p = __builtin_amdgcn_exp2f(sa[reg]); sa[reg] = p; lsum += p; }
        lrun += lsum;
#pragma unroll
        for (int q = 0; q < 4; ++q) *(LAS u32x4*)(Vs + ((lane >> 3) + 8 * q) * VSP + 8 * (lane & 7)) = vr[q];
#pragma unroll
        for (int s = 0; s < 2; ++s) {
            u32x4 pw; pw.x = cvt_pk_bf16(sa[8 * s + 0], sa[8 * s + 1]); pw.y = cvt_pk_bf16(sa[8 * s + 2], sa[8 * s + 3]); pw.z = cvt_pk_bf16(sa[8 * s + 4], sa[8 * s + 5]); pw.w = cvt_pk_bf16(sa[8 * s + 6], sa[8 * s + 7]);
            const bf16x8 pf = __builtin_bit_cast(bf16x8, pw);
            const LAS bf16_t* vq = Vs + (16 * s + 4 * hh + ((lane & 15) >> 2)) * VSP + 16 * ((lane >> 4) & 1) + 4 * (lane & 3);
            {   const v4i16_t lo = __builtin_amdgcn_ds_read_tr16_b64_v4i16((LAS v4i16_t*)vq), hi = __builtin_amdgcn_ds_read_tr16_b64_v4i16((LAS v4i16_t*)(vq + 8 * VSP));
                const bf16x8 af = {lo[0], lo[1], lo[2], lo[3], hi[0], hi[1], hi[2], hi[3]};
                o0 = __builtin_amdgcn_mfma_f32_32x32x16_bf16(af, pf, o0, 0, 0, 0); }
            {   const v4i16_t lo = __builtin_amdgcn_ds_read_tr16_b64_v4i16((LAS v4i16_t*)(vq + 32)), hi = __builtin_amdgcn_ds_read_tr16_b64_v4i16((LAS v4i16_t*)(vq + 8 * VSP + 32));
                const bf16x8 af = {lo[0], lo[1], lo[2], lo[3], hi[0], hi[1], hi[2], hi[3]};
                o1 = __builtin_amdgcn_mfma_f32_32x32x16_bf16(af, pf, o1, 0, 0, 0); }
        }
#pragma unroll
        for (int s = 0; s < 4; ++s) { kf[s] = kfn[s]; vr[s] = vrn[s]; }
    }
    const float ltot = lrun + __shfl_xor(lrun, 32);
    const float inv = 1.0f / ltot;
    bf16_t* op = (bf16_t*)(ws + WS_OPART) + (size_t)tq * DQ + h * 64 + 4 * hh;
#pragma unroll
    for (int q4 = 0; q4 < 4; ++q4) {
        u32x2 w0; w0.x = cvt_pk_bf16(o0[4 * q4 + 0] * inv, o0[4 * q4 + 1] * inv); w0.y = cvt_pk_bf16(o0[4 * q4 + 2] * inv, o0[4 * q4 + 3] * inv);
        u32x2 w1; w1.x = cvt_pk_bf16(o1[4 * q4 + 0] * inv, o1[4 * q4 + 1] * inv); w1.y = cvt_pk_bf16(o1[4 * q4 + 2] * inv, o1[4 * q4 + 3] * inv);
        *(u32x2*)(op + 8 * q4) = w0; *(u32x2*)(op + 32 + 8 * q4) = w1;
    }
    if (hh == 0) ((float*)(ws + WS_LSE))[(size_t)tq * 12 + h] = (__builtin_amdgcn_logf(ltot) + ATT_C2) * LN2;
}

struct CbRow { float l0, l1, l2; u32x2 w0, w1, w2; };
__device__ __forceinline__ CbRow combine_load(ArgsP a, int m, int lane) {
    unsigned char* ws = a->ws;
    const int hs = lane >> 4, d4 = 4 * (lane & 15);
    const float* ls = (const float*)(ws + WS_LSE) + (size_t)m * 12 + hs;
    const bf16_t* op = (const bf16_t*)(ws + WS_OPART) + (size_t)m * DQ + hs * 64 + d4;
    CbRow R; R.l0 = ls[0]; R.l1 = ls[4]; R.l2 = ls[8]; R.w0 = *(const u32x2*)op; R.w1 = *(const u32x2*)(op + 256); R.w2 = *(const u32x2*)(op + 512);
    return R;
}
__device__ __forceinline__ void combine_row(ArgsP a, int m, int lane, const CbRow& R) {
    unsigned char* ws = a->ws;
    const int hs = lane >> 4, d4 = 4 * (lane & 15);
    const float l0 = R.l0, l1 = R.l1, l2 = R.l2;
    const float mx = fmaxf(l0, fmaxf(l1, l2));
    float e0 = __expf(l0 - mx), e1 = __expf(l1 - mx), e2 = __expf(l2 - mx);
    const float inv = 1.0f / (e0 + e1 + e2); e0 *= inv; e1 *= inv; e2 *= inv;
    const u32x2 w0 = R.w0, w1 = R.w1, w2 = R.w2;
    const float r0 = e0 * bf_lo(w0.x) + e1 * bf_lo(w1.x) + e2 * bf_lo(w2.x), r1 = e0 * bf_hi(w0.x) + e1 * bf_hi(w1.x) + e2 * bf_hi(w2.x);
    const float r2 = e0 * bf_lo(w0.y) + e1 * bf_lo(w1.y) + e2 * bf_lo(w2.y), r3 = e0 * bf_hi(w0.y) + e1 * bf_hi(w1.y) + e2 * bf_hi(w2.y);
    u32x2 o; o.x = cvt_pk_bf16(r0, r1); o.y = cvt_pk_bf16(r2, r3);
    *(u32x2*)((bf16_t*)(ws + WS_ACTB) + (size_t)m * 256 + hs * 64 + d4) = o;
}

constexpr int CT = 32;
template <bool EDGE>
__device__ __forceinline__ void convpool_unit(ArgsP a, LAS unsigned char* lds, int l, int mbase, int s, int t0, int nt, int tid, int lane, int wave) {
    unsigned char* ws = a->ws;
    LAS bf16_t* Gs = (LAS bf16_t*)lds;
    LAS float* CV = (LAS float*)lds;
    LAS bf16_t* Zs = (LAS bf16_t*)(lds + 49152);
    const bf16_t* glub = (const bf16_t*)(ws + WS_GLU) + (size_t)mbase * 384;
    const bf16_t* zd = (const bf16_t*)(ws + WS_Z) + (size_t)mbase * ZP + ZD;
    float w[31]; float cb = 0.f;
    if (tid < 384) {
        const float* cw = a->in[IN_CONVW] + (size_t)l * 31 * 384 + tid;
#pragma unroll
        for (int k = 0; k < 31; ++k) w[k] = cw[k * 384];
        cb = a->in[IN_CONVB][l * 384 + tid];
    }
    __builtin_amdgcn_sched_barrier(0);
    if constexpr (!EDGE) {
        constexpr int NCH = (62 + 47) * 48, NIT = (NCH + 511) / 512;
        u32x4 v[NIT];
#pragma unroll
        for (int k = 0; k < NIT; ++k) {
            int i = tid + 512 * k; i = i < NCH ? i : NCH - 1;
            const bool isg = i < 62 * 48; const int kk = isg ? i : i - 62 * 48; const int r = kk / 48, c8 = kk - r * 48;
            v[k] = isg ? *(const u32x4*)(glub + (size_t)(t0 - 30 + r) * 384 + 8 * c8) : *(const u32x4*)(zd + (size_t)(t0 - 15 + r) * ZP + 8 * c8);
        }
#pragma unroll
        for (int k = 0; k < NIT; ++k) {
            const int i = tid + 512 * k;
            if (i < NCH) { const bool isg = i < 62 * 48; const int kk = isg ? i : i - 62 * 48; const int r = kk / 48, c8 = kk - r * 48; *(LAS u32x4*)((isg ? Gs : Zs) + r * 384 + 8 * c8) = v[k]; }
        }
    } else {
        for (int i = tid; i < (62 + 47) * 48; i += 512) {
            const bool isg = i < 62 * 48; const int k = isg ? i : i - 62 * 48; const int r = k / 48, c8 = k - r * 48;
            const int tt = isg ? t0 - 30 + r : t0 - 15 + r;
            u32x4 v = {0u, 0u, 0u, 0u};
            if (tt >= 0) { if (tt < t0 + nt) v = isg ? *(const u32x4*)(glub + (size_t)tt * 384 + 8 * c8) : *(const u32x4*)(zd + (size_t)tt * ZP + 8 * c8); }
            else if (s >= 0) {
                const float* p = isg ? a->in[IN_SCONV] + ((size_t)(l * 32 + s) * 30 + 30 + tt) * 384 + 8 * c8 : a->in[IN_SPOOL] + ((size_t)(l * 32 + s) * 15 + 15 + tt) * 384 + 8 * c8;
                const f32x4 x0 = *(const f32x4*)p, x1 = *(const f32x4*)(p + 4);
                v.x = cvt_pk_bf16(x0[0], x0[1]); v.y = cvt_pk_bf16(x0[2], x0[3]); v.z = cvt_pk_bf16(x1[0], x1[1]); v.w = cvt_pk_bf16(x1[2], x1[3]);
            }
            *(LAS u32x4*)((isg ? Gs : Zs) + r * 384 + 8 * c8) = v;
        }
    }
    __syncthreads();
    if (tid < 384) {
        const int c = tid;
        float x[CT + 30];
#pragma unroll
        for (int r = 0; r < CT + 30; ++r) x[r] = bf1(Gs[r * 384 + c]);
        asm volatile("s_waitcnt lgkmcnt(0)" ::: "memory");
        __syncthreads();
#pragma unroll
        for (int q = 0; q < CT; ++q) {
            float acc = cb;
#pragma unroll
            for (int k = 0; k < 31; ++k) acc += w[k] * x[q + k];
            CV[q * 384 + c] = acc;
        }
    } else {
        __syncthreads();
        const int c0 = tid - 384;
#pragma unroll 1
        for (int q3 = 0; q3 < 3; ++q3) {
            const int c = c0 + 128 * q3, wg = c / 96;
            float x[CT + 15];
#pragma unroll
            for (int r = 0; r < CT + 15; ++r) x[r] = bf1(Zs[r * 384 + c]);
            float lv[CT + 15], res[CT];
#pragma unroll
            for (int i = 0; i < CT + 15; ++i) lv[i] = x[i];
#pragma unroll
            for (int i = CT + 14; i >= 1; --i) lv[i] += lv[i - 1];
#pragma unroll
            for (int q = 0; q < CT; ++q) res[q] = lv[15 + q];
#pragma unroll
            for (int i = CT + 14; i >= 2; --i) lv[i] += lv[i - 2];
#pragma unroll
            for (int q = 0; q < CT; ++q) res[q] = wg >= 1 ? lv[15 + q] : res[q];
#pragma unroll
            for (int i = CT + 14; i >= 4; --i) lv[i] += lv[i - 4];
#pragma unroll
            for (int q = 0; q < CT; ++q) res[q] = wg >= 2 ? lv[15 + q] : res[q];
#pragma unroll
            for (int i = CT + 14; i >= 8; --i) lv[i] += lv[i - 8];
#pragma unroll
            for (int q = 0; q < CT; ++q) res[q] = wg >= 3 ? lv[15 + q] : res[q];
            const int wlen = 2 << wg;
            bf16_t* op = (bf16_t*)(ws + WS_ACTD) + (size_t)(mbase + t0) * 384 + c;
#pragma unroll
            for (int q = 0; q < CT; ++q) {
                const int cnt = (s < 0) ? min(wlen, t0 + q + 1) : wlen;
                const float pv = res[q] / (float)cnt - x[15 + q];
                if (q < nt) op[(size_t)q * 384] = (bf16_t)(cvt_pk_bf16(pv, 0.f) & 0xffffu);
            }
        }
    }
    float lg[6], lb[6];
    { const float* gp = a->in[IN_CLNG] + l * 384 + lane; const float* bp = a->in[IN_CLNB] + l * 384 + lane;
#pragma unroll
      for (int i = 0; i < 6; ++i) { lg[i] = gp[64 * i]; lb[i] = bp[64 * i]; } }
    __syncthreads();
    for (int tt = wave; tt < nt; tt += 8) {
        float x[6]; float sm = 0.f;
#pragma unroll
        for (int i = 0; i < 6; ++i) { x[i] = CV[tt * 384 + lane + 64 * i]; sm += x[i]; }
        const float mean = wave_sum(sm) * (1.0f / 384.0f);
        float sv = 0.f;
#pragma unroll
        for (int i = 0; i < 6; ++i) { x[i] -= mean; sv += x[i] * x[i]; }
        const float rstd = rsqrtf(wave_sum(sv) * (1.0f / 384.0f) + LN_EPS);
        bf16_t* o = (bf16_t*)(ws + WS_ACTA) + (size_t)(mbase + t0 + tt) * 384;
#pragma unroll
        for (int i = 0; i < 6; ++i) { const int c = lane + 64 * i; const float y = x[i] * rstd * lg[i] + lb[i]; o[c] = (bf16_t)(cvt_pk_bf16(y * sigmoidf_(y), 0.f) & 0xffffu); }
    }
    __syncthreads();
}

__device__ __forceinline__ void sgu_unit(ArgsP a, LAS unsigned char* lds, int l, int m0, int L, int g, int tid) {
    unsigned char* ws = a->ws;
    LAS float* V = (LAS float*)lds;
    LAS float* Wt = (LAS float*)(lds + 128 * 96 * 4);
    const bf16_t* vln = (const bf16_t*)(ws + WS_VLN); const bf16_t* z = (const bf16_t*)(ws + WS_Z);
    for (int i = tid; i < L * 12; i += 512) {
        const int j = i / 12, c8 = i - j * 12; float v[8]; unpack8(*(const u32x4*)(vln + (size_t)(m0 + j) * 384 + g * 96 + 8 * c8), v);
        *(LAS f32x4*)(V + j * 96 + 8 * c8) = (f32x4){v[0], v[1], v[2], v[3]}; *(LAS f32x4*)(V + j * 96 + 8 * c8 + 4) = (f32x4){v[4], v[5], v[6], v[7]};
    }
    const float* sw = a->in[IN_SGUW] + ((size_t)(l * 4 + g) * 128) * 128;
    const int L4 = L / 4;
    for (int i = tid; i < L * L4; i += 512) { const int r = i / L4, j4 = i - r * L4; *(LAS f32x4*)(Wt + r * 128 + 4 * j4) = *(const f32x4*)(sw + (size_t)r * 128 + 4 * j4); }
    __syncthreads();
    if (tid < 384) {
        const int c = tid % 96, iq = tid / 96;
        for (int i = iq; i < L; i += 4) {
            float acc = a->in[IN_SGUB][(l * 4 + g) * 128 + i];
            for (int j = 0; j <= i; ++j) acc += Wt[i * 128 + j] * V[j * 96 + c];
            const float u = bf1(z[(size_t)(m0 + i) * ZP + ZU + g * 96 + c]);
            ((bf16_t*)(ws + WS_ACTC))[(size_t)(m0 + i) * 384 + g * 96 + c] = (bf16_t)(cvt_pk_bf16(u * acc, 0.f) & 0xffffu);
        }
    }
    __syncthreads();
}

template <int IT>
__device__ __forceinline__ void sgu_mfma_tile(ArgsP a, int l, int m0, int g, int ct, int lane) {
    unsigned char* ws = a->ws;
    const int c = lane & 31, hh = lane >> 5;
    const bf16_t* wsb = (const bf16_t*)(ws + WS_SGUW) + ((size_t)(l * 4 + g) * 128 + 32 * IT + c) * 128 + 8 * hh;
    const bf16_t* vp = (const bf16_t*)(ws + WS_VLN) + ((size_t)(m0 >> 7) * 384 + g * 96 + 32 * ct + c) * 128 + 8 * hh;
    f32x16 acc;
#pragma unroll
    for (int i = 0; i < 16; ++i) acc[i] = 0.f;
    constexpr int NST = 2 * (IT + 1);
    bf16x8 afr[NST], bfr[NST];
#pragma unroll
    for (int st = 0; st < NST; ++st) { bfr[st] = *(const bf16x8*)(wsb + 16 * st); afr[st] = *(const bf16x8*)(vp + 16 * st); }
#pragma unroll
    for (int st = 0; st < NST; ++st) acc = __builtin_amdgcn_mfma_f32_32x32x16_bf16(afr[st], bfr[st], acc, 0, 0, 0);
    const int tok = m0 + 32 * IT + c;
    const float bias = a->in[IN_SGUB][(l * 4 + g) * 128 + 32 * IT + c];
    const bf16_t* up = (const bf16_t*)(ws + WS_Z) + (size_t)tok * ZP + ZU + g * 96 + 32 * ct + 4 * hh;
    bf16_t* op = (bf16_t*)(ws + WS_ACTC) + (size_t)tok * 384 + g * 96 + 32 * ct + 4 * hh;
#pragma unroll
    for (int q4 = 0; q4 < 4; ++q4) {
        const u32x2 uw = *(const u32x2*)(up + 8 * q4);
        u32x2 o; o.x = cvt_pk_bf16(bf_lo(uw.x) * (acc[4 * q4 + 0] + bias), bf_hi(uw.x) * (acc[4 * q4 + 1] + bias)); o.y = cvt_pk_bf16(bf_lo(uw.y) * (acc[4 * q4 + 2] + bias), bf_hi(uw.y) * (acc[4 * q4 + 3] + bias));
        *(u32x2*)(op + 8 * q4) = o;
    }
}
__device__ __forceinline__ void sgu_mfma_unit(ArgsP a, int l, int m0, int g, int lane, int wave) {
    if (wave < 3) sgu_mfma_tile<3>(a, l, m0, g, wave, lane);
    else if (wave < 6) { sgu_mfma_tile<2>(a, l, m0, g, wave - 3, lane); sgu_mfma_tile<0>(a, l, m0, g, wave - 3, lane); }
    else if (wave == 6) { sgu_mfma_tile<1>(a, l, m0, g, 0, lane); sgu_mfma_tile<1>(a, l, m0, g, 1, lane); }
    else sgu_mfma_tile<1>(a, l, m0, g, 2, lane);
}

constexpr int NU_ATTP = NT_ATTP / 8;
constexpr int NU_ATTS = MS * 12 / 8;
constexpr int NU_ATT = NU_ATTP + NU_ATTS;
constexpr int NU_SGU = 128 * 4 + 32 * 4;
constexpr int NU_CONV = MP / CT + 32;
constexpr int NU_MIX = NU_ATT + NU_SGU + NU_CONV;
#ifndef MIX_EXTRA_LO
#define MIX_EXTRA_LO 0
#define MIX_EXTRA_HI 0
#endif

__device__ __forceinline__ void p3_mixer(ArgsP a, LAS unsigned char* lds, int l, int tid, int lane, int wave, int G, int bid) {
    LAS float* tab = (LAS float*)(lds + TAB_OFF);
    for (int i = tid; i < 12 * 132; i += 512) { const int h = i / 132, j = i - h * 132; tab[i] = (j <= 128) ? a->in[IN_RELB][(int)T5_BUCKET[h >> 2][j] * 12 + h] * LOG2E - ATT_C2 : 0.f; }
    __syncthreads();
    for (int u = bid; u < NU_MIX + (MIX_EXTRA_HI - MIX_EXTRA_LO); u += G) {
        int r = u < NU_MIX ? u : MIX_EXTRA_LO + (u - NU_MIX);
        if (r < NU_ATTP) { attn_mfma_task(a, lds + wave * 8192, l, r * 8 + wave, lane, tab); __syncthreads(); continue; } r -= NU_ATTP;
        if (r < NU_ATTS) { const int task = r * 8 + wave; attn_sample_task(a, l, MP + task / 12, task % 12, lane, tab); continue; } r -= NU_ATTS;
        if (r < NU_SGU) { if (r < 512) sgu_mfma_unit(a, l, (r >> 2) * 128, r & 3, lane, wave); else { r -= 512; sgu_unit(a, lds, l, MP + (r >> 2) * 8, 8, r & 3, tid); } continue; } r -= NU_SGU;
        if (r == 0) convpool_unit<true>(a, lds, l, 0, -1, 0, CT, tid, lane, wave); else if (r < MP / CT) convpool_unit<false>(a, lds, l, 0, -1, r * CT, CT, tid, lane, wave); else { r -= MP / CT; convpool_unit<true>(a, lds, l, MP + r * 8, r, 0, 8, tid, lane, wave); }
    }
}


__device__ __forceinline__ void small_gemm_tile(LAS unsigned char* lds, const pg8::Gemm& g, const pg8::Epi& e, int mt, int nt, int tid, int lane, int wave) {
    const int K = g.K, kw = K >> 3, nsteps = kw >> 4;
    const int c = lane & 31, hh = lane >> 5;
    const bf16_t* ap = g.A + (size_t)(MP + 32 * mt + c) * K + wave * kw + 8 * hh;
    const bf16_t* bp = g.Bt + (size_t)(32 * nt + c) * K + wave * kw + 8 * hh;
    f32x16 acc;
#pragma unroll
    for (int i = 0; i < 16; ++i) acc[i] = 0.f;
    for (int s0 = 0; s0 < nsteps; s0 += 8) {
        bf16x8 af[8], bf[8];
#pragma unroll
        for (int i = 0; i < 8; ++i) { const int st = (s0 + i < nsteps) ? s0 + i : nsteps - 1; af[i] = *(const bf16x8*)(ap + 16 * st); bf[i] = *(const bf16x8*)(bp + 16 * st); }
#pragma unroll
        for (int i = 0; i < 8; ++i) { const bf16x8 zz = {0, 0, 0, 0, 0, 0, 0, 0}; const bf16x8 aa = (s0 + i < nsteps) ? af[i] : zz; acc = __builtin_amdgcn_mfma_f32_32x32x16_bf16(bf[i], aa, acc, 0, 0, 0); }
    }
    LAS float* P = (LAS float*)lds;
#pragma unroll
    for (int i = 0; i < 16; ++i) P[(wave * 16 + i) * 64 + lane] = acc[i];
    __syncthreads();
    if (tid < 128) {
        const int m = tid & 31, q4 = tid >> 5;
        f32x4 v0 = {0.f, 0.f, 0.f, 0.f}, v1 = {0.f, 0.f, 0.f, 0.f};
#pragma unroll
        for (int w = 0; w < 8; ++w)
#pragma unroll
            for (int j = 0; j < 4; ++j) { v0[j] += P[(w * 16 + 4 * q4 + j) * 64 + m]; v1[j] += P[(w * 16 + 4 * q4 + j) * 64 + 32 + m]; }
        const int row = MP + 32 * mt + m, col = 32 * nt + 8 * q4;
        const float r = e.needs_rstd() ? e.row_rstd(row) : 1.0f;
        const float ss = e.epi8(row, col, v0, v1, r, e.res_base(row));
        if ((e.mode == pg8::EP_RES || e.mode == pg8::EP_PLE) && e.rs_out) unsafeAtomicAdd(e.rs_out + row, ss);
    }
    __syncthreads();
}

enum { SUB_Z = 0, SUB_POSTZ = 1, SUB_MIX = 2, SUB_COMB = 3, SUB_BR = 4, SUB_WO = 5, SUB_GU = 6, SUB_DN = 7, SUB_PLE = 8, NSUB = 9 };
constexpr int N_PHASES = 1 + 2 * NSUB;
__device__ __forceinline__ int n_passes(int sub) { return sub == SUB_BR ? 4 : (sub == SUB_PLE ? 2 : 1); }
__device__ __forceinline__ void make_pass(ArgsP a, int l, int sub, int p, pg8::Gemm& g, pg8::Epi& e) {
    unsigned char* ws = a->ws; unsigned char* wl = ws + WS_W + (size_t)l * WL;
    float* rs = (float*)(ws + WS_CTL);
    bf16_t* xb = (bf16_t*)(ws + WS_XB); bf16_t* xb2 = (bf16_t*)(ws + WS_XB2); float* xres = (float*)(ws + WS_XRES); bf16_t* z = (bf16_t*)(ws + WS_Z);
    e.mode = 0; e.rowss = nullptr; e.ob = nullptr; e.ldb = 0; e.of = nullptr; e.rin_p = nullptr; e.rin_s = nullptr; e.rin_b = nullptr; e.rs_out = nullptr; e.gate8 = nullptr; e.pl = nullptr; e.mg = nullptr;
    g.M = (sub == SUB_Z || sub == SUB_GU) ? M : MP;
    if (sub == SUB_Z) {
        g.A = xb; g.Bt = (const bf16_t*)(wl + W_IN); g.N = NZ; g.K = D;
        e.mode = pg8::EP_Z; e.rowss = rs + (l == 0 ? RS_MIX0 : RS_MIX1) * RS_STRIDE; e.ob = z; e.ldb = ZP; e.gate8 = ws + WS_ZG8;
    } else if (sub == SUB_BR) {
        g.N = D;
        if (p == 0) { g.A = (const bf16_t*)(ws + WS_ACTA); g.Bt = (const bf16_t*)(wl + W_A); g.K = 384; e.mode = pg8::EP_BR_FIRST; }
        else if (p == 1) { g.A = (const bf16_t*)(ws + WS_ACTB); g.Bt = (const bf16_t*)(wl + W_B); g.K = 256; e.mode = pg8::EP_BR_MID; }
        else if (p == 2) { g.A = (const bf16_t*)(ws + WS_ACTC); g.Bt = (const bf16_t*)(wl + W_C); g.K = 384; e.mode = pg8::EP_BR_MID; }
        else { g.A = (const bf16_t*)(ws + WS_ACTD); g.Bt = (const bf16_t*)(wl + W_D); g.K = 384; e.mode = pg8::EP_BR_LAST; }
        e.gate8 = ws + WS_ZG8 + p * 1024; e.mg = (float*)(ws + WS_MG); e.ob = (bf16_t*)(ws + WS_MGB); e.ldb = D;
    } else if (sub == SUB_WO) {
        g.A = (const bf16_t*)(ws + WS_MGB); g.Bt = (const bf16_t*)(wl + W_O); g.N = D; g.K = D;
        e.mode = pg8::EP_RES; e.ob = xb2; e.ldb = D; e.rs_out = rs + (l == 0 ? RS_FFN0 : RS_FFN1) * RS_STRIDE;
        if (l == 0) { e.rin_p = a->in[IN_XP]; e.rin_s = a->in[IN_XS]; } else e.rin_b = xb;
    } else if (sub == SUB_GU) {
        g.A = xb2; g.Bt = (const bf16_t*)(wl + W_GU); g.N = 2 * DFF; g.K = D;
        e.mode = pg8::EP_GLU; e.rowss = rs + (l == 0 ? RS_FFN0 : RS_FFN1) * RS_STRIDE; e.ob = (bf16_t*)(ws + WS_HFF); e.ldb = DFF;
    } else if (sub == SUB_DN) {
        g.A = (const bf16_t*)(ws + WS_HFF); g.Bt = (const bf16_t*)(wl + W_DN); g.N = D; g.K = DFF;
        e.mode = pg8::EP_RES; e.ob = xb2; e.ldb = D; e.rs_out = rs + (l == 0 ? RS_PLE0 : RS_PLE1) * RS_STRIDE;
        e.rin_b = xb2;
    } else {
        g.N = D;
        if (p == 0) { g.A = (const bf16_t*)(ws + WS_PEB) + (size_t)l * M * DPLE; g.Bt = (const bf16_t*)(wl + W_PLE); g.K = DPLE; e.mode = pg8::EP_PL; e.ob = (bf16_t*)(ws + WS_PL); e.ldb = D; }
        else {
            g.A = xb2; g.Bt = (const bf16_t*)(wl + W_PG); g.K = D;
            e.mode = pg8::EP_PLE; e.rowss = rs + (l == 0 ? RS_PLE0 : RS_PLE1) * RS_STRIDE; e.pl = (const bf16_t*)(ws + WS_PL);
            e.rin_b = xb2;
            if (l == 0) { e.ob = xb; e.ldb = D; e.rs_out = rs + RS_MIX1 * RS_STRIDE; }
            else { e.of = a->out + O_YP; e.ob = nullptr; e.ldb = D; e.rs_out = nullptr; }
        }
    }
}


#ifndef MK_XCD_BARRIER
#define MK_XCD_BARRIER 1
#endif
constexpr int CW_BAR = 131072;
constexpr int LDS_BARST_OFF = LDS_BYTES - 64;
static_assert((CW_BAR + 3456) * 4 <= (int)CTL_ZERO_BYTES, "barrier words inside the memset region");
#define XB_TMO      128
#define XB_XCNT(j)  (256  + 64 * (j))
#define XB_XSUB(j)  (1280 + 64 * (j))
#define XB_XGEN(j)  (2304 + 64 * (j))
#define XB_TOP      3328
#define XB_TOPGEN   3392
#define XCD_BAR_WORDS 3456
#define XB_SPIN_CAP (1u << 18)

__device__ __forceinline__ unsigned xb_ld(unsigned* p)              { return __hip_atomic_load(p, __ATOMIC_RELAXED, __HIP_MEMORY_SCOPE_AGENT); }
__device__ __forceinline__ unsigned xb_add(unsigned* p, unsigned v) { return __hip_atomic_fetch_add(p, v, __ATOMIC_RELAXED, __HIP_MEMORY_SCOPE_AGENT); }
__device__ __forceinline__ unsigned xb_xcc_id() { return (unsigned)__builtin_amdgcn_s_getreg((3 << 11) | 20) & 0xFu; }
#define XB_SPIN(cond, bar) do { unsigned _sp = 0; while (cond) { __builtin_amdgcn_s_sleep(1); \
    if ((++_sp & 255u) == 0u) { if (xb_ld(&(bar)[XB_TMO])) break; if (_sp > XB_SPIN_CAP) { atomicAdd(&(bar)[XB_TMO], 1u); break; } } } } while (0)

struct XcdBarrier {
    unsigned* bar; unsigned x;
    volatile LAS unsigned* st;
};

__device__ __forceinline__ XcdBarrier xcd_barrier_post(unsigned* bar, volatile LAS unsigned* st) {
    XcdBarrier b; b.bar = bar; b.x = xb_xcc_id(); b.st = st;
    if (threadIdx.x == 0) (void)xb_add(&bar[XB_XCNT(b.x)], 1u);
    return b;
}
__device__ __forceinline__ void xcd_barrier_complete(unsigned* bar, unsigned x, unsigned& nloc, unsigned& nx) {
    const unsigned G = gridDim.x * gridDim.y * gridDim.z;
    unsigned sum, cnt, mine, sp = 0u;
    for (;;) {
        sum = 0u; cnt = 0u; mine = 0u;
#pragma unroll
        for (unsigned j = 0; j < 16; ++j) { const unsigned c = xb_ld(&bar[XB_XCNT(j)]); sum += c; cnt += (c > 0u) ? 1u : 0u; mine = (j == x) ? c : mine; }
        if (sum == G) break;
        __builtin_amdgcn_s_sleep(1);
        if ((++sp & 255u) == 0u) { if (xb_ld(&bar[XB_TMO])) break; if (sp > XB_SPIN_CAP) { atomicAdd(&bar[XB_TMO], 1u); break; } }
    }
    nloc = mine > 0u ? mine : 1u; nx = cnt > 0u ? cnt : 1u;
}

__device__ __forceinline__ void xcd_barrier(const XcdBarrier& b) {
    asm volatile("s_waitcnt vmcnt(0)" ::: "memory");
    __syncthreads();
    if (threadIdx.x == 0) {
        unsigned* bar = b.bar;
        __builtin_amdgcn_s_waitcnt(0);
        unsigned nloc = b.st[0], nx = b.st[1];
        if (nloc == 0u) { xcd_barrier_complete(bar, b.x, nloc, nx); b.st[0] = nloc; b.st[1] = nx; }
        const unsigned old = xb_add(&bar[XB_XSUB(b.x)], 1u);
        const unsigned gen = old / nloc;
        if (old + 1u == (gen + 1u) * nloc) {
            __builtin_amdgcn_fence(__ATOMIC_RELEASE, "agent");
            asm volatile("s_waitcnt vmcnt(0)" ::: "memory");
            const unsigned og = xb_add(&bar[XB_TOP], 1u);
            const unsigned tg = og / nx;
            if (og + 1u == (tg + 1u) * nx) xb_add(&bar[XB_TOPGEN], 1u);
            else XB_SPIN(xb_ld(&bar[XB_TOPGEN]) == tg, bar);
            __builtin_amdgcn_fence(__ATOMIC_ACQUIRE, "agent");
            xb_add(&bar[XB_XGEN(b.x)], 1u);
            asm volatile("s_waitcnt vmcnt(0)" ::: "memory");
        } else {
            XB_SPIN(xb_ld(&bar[XB_XGEN(b.x)]) == gen, bar);
            __builtin_amdgcn_fence(__ATOMIC_ACQUIRE, "agent");
            asm volatile("s_waitcnt vmcnt(0)" ::: "memory");
        }
    }
    __syncthreads();
}


constexpr int Z0_SPLIT_ROUNDS = 8;
#ifndef WGM_WIDE
#define WGM_WIDE 2
#define WGM_NARROW 8
#endif
__device__ __forceinline__ int phase_reps(int ph, int sub) {
    return ph == 0 ? REP_P0 : sub == SUB_Z ? REP_Z : sub == SUB_POSTZ ? REP_POSTZ : sub == SUB_MIX ? REP_MIX : sub == SUB_COMB ? REP_COMB : sub == SUB_BR ? REP_BR : sub == SUB_GU ? REP_GU : 1;
}
__global__ void __launch_bounds__(512, 2) mega_fwd(Args a) {
    extern __shared__ __attribute__((aligned(16))) unsigned char lds_raw[];
    LAS unsigned char* lds = (LAS unsigned char*)lds_raw;
    const int G = gridDim.x, bid = blockIdx.x;
    const int ph_lo = a.ph_lo, ph_hi = a.ph_hi;
#if MK_XCD_BARRIER
    if (threadIdx.x < 2) ((volatile LAS unsigned*)(lds + LDS_BARST_OFF))[threadIdx.x] = 0u;
    __syncthreads();
    (void)xcd_barrier_post((unsigned*)(((ArgsP)__builtin_amdgcn_kernarg_segment_ptr())->ws + WS_CTL) + CW_BAR, (volatile LAS unsigned*)(lds + LDS_BARST_OFF));
#else
    cg::grid_group grid = cg::this_grid();
#endif
    for (int ph = ph_lo; ph < ph_hi; ++ph) {
#if MK_XCD_BARRIER
        if (ph > ph_lo) {
            XcdBarrier xb; xb.bar = (unsigned*)(((ArgsP)__builtin_amdgcn_kernarg_segment_ptr())->ws + WS_CTL) + CW_BAR; xb.x = xb_xcc_id(); xb.st = (volatile LAS unsigned*)(lds + LDS_BARST_OFF);
            xcd_barrier(xb);
        }
#else
        if (ph > ph_lo) grid.sync();
#endif
        ArgsP ap = (ArgsP)__builtin_amdgcn_kernarg_segment_ptr(); asm volatile("" : "+s"(ap));
        int tid = threadIdx.x; asm volatile("" : "+v"(tid));
        const int lane = tid & 63, wave = __builtin_amdgcn_readfirstlane(tid >> 6);
        if (ph == 0 || (ph == 1 && G == 256 && bid >= 128)) {
            p0_prologue(ap, lds, tid, lane, wave, ph == 0 ? G : 128, ph == 0 ? bid : bid - 128, ph == 0 ? (G == 256 ? 0 : 2) : 1, ph == 1);
            if (ph == 0) continue;
            __syncthreads();
        }
        const int l = (ph - 1) / NSUB, sub = (ph - 1) - l * NSUB;
        if (sub == SUB_POSTZ) {
            for (int rep = 0; rep < REP_POSTZ; ++rep) {
                for (int t8 = bid * 8 + wave; t8 < MP / 8; t8 += G * 8) postz_rows8(ap, l, t8 * 8, lane);
                for (int m = MP + bid * 8 + wave; m < M; m += G * 8) { const PzRow R = postz_load(ap, m, lane); __builtin_amdgcn_sched_barrier(0); (void)postz_row(ap, l, m, lane, R); }
            }
            continue;
        }
        if (sub == SUB_MIX) { p3_mixer(ap, lds, l, tid, lane, wave, G, bid); __syncthreads(); continue; }
        if (sub == SUB_COMB) { for (int rep = 0; rep < REP_COMB; ++rep) {
                int m = bid * 8 + wave; if (m >= M) continue;
                CbRow cur = combine_load(ap, m, lane);
                for (; m < M; m += G * 8) { const int mn = m + G * 8; CbRow nxt = cur; if (mn < M) nxt = combine_load(ap, mn, lane); __builtin_amdgcn_sched_barrier(0); combine_row(ap, m, lane, cur); cur = nxt; }
            } continue; }
        const int np = n_passes(sub);
        const int nrep = phase_reps(ph, sub) + ((DRY_SUB >= 0 && sub == DRY_SUB) ? 1 : 0);
        const int nmain = (sub == SUB_BR ? 1 : np) * nrep;
        for (int pp = 0; pp < nmain; ++pp) {
            const int p = (sub == SUB_BR) ? 0 : pp % np;
            pg8::Gemm g; pg8::Epi e; pg8::SegSched S;
            make_pass(ap, l, sub, p, g, e);
#if DRY_SUB >= 0
            if (sub == DRY_SUB && pp < np) {
                if (e.ob) e.ob = (bf16_t*)(ap->ws + WS_XRES); if (e.of) e.of = (float*)(ap->ws + WS_MG); if (e.rs_out) e.rs_out = (float*)(ap->ws + WS_CTL) + 6 * RS_STRIDE;
            }
#endif
            S.nseg = 1; S.A0 = g.A; S.B0 = g.Bt; S.K0 = g.K; S.ws = ap->ws; S.wl = ap->ws + WS_W + (size_t)l * WL;
            if (sub == SUB_BR) { S.nseg = 4; e.mode = pg8::EP_BRC; }
            S.so.init(g.M, g.N, G, bid, (g.N > D) ? WGM_WIDE : WGM_NARROW);
            S.split_rounds = 0;
            if (G == 256 && sub == SUB_Z && l == 0 && pp == 0) {
                S.split_rounds = Z0_SPLIT_ROUNDS;
            }
            if (G == 256 && (sub == SUB_Z || sub == SUB_GU) && pp == 0 && !(sub == SUB_Z && l == 0)) {
                const int nwg = (g.M / 256) * (g.N / 256), rem = nwg - (nwg / G) * G;
                if (bid >= rem) {
                    const int k = bid - rem, Q = (sub == SUB_Z) ? STAG_Q_Z : STAG_Q_GU;
                    const int base = ((sub == SUB_GU) ? STAG_TOT_Z : 0) + l * (STAG_TOT_Z + STAG_TOT_GU);
                    const int lo = base + Q * (k * (k - 1) / 2);
                    cache_copy_range(ap, lo, lo + Q * k, tid, 512);
                }
            }
            const bool has_small = (sub != SUB_BR && g.M == MP);
            const bool small_first = has_small && ((bid >> 3) & 1);
#pragma unroll 1
            for (int step = 0; step < 2; ++step) {
                if ((step == 0) != small_first) pg8::gemm_phase<pg8::Epi, pg8::SegSched, true>(lds, S, e, tid);
                else if (has_small) { for (int tile = bid; tile < 256; tile += G) small_gemm_tile(lds, g, e, tile >> 5, tile & 31, tid, lane, wave); }
            }
        }
        if (sub == SUB_BR) {
            for (int pp = 0; pp < 4 * nrep; ++pp) {
                pg8::Gemm g; pg8::Epi e; make_pass(ap, l, sub, pp & 3, g, e);
                for (int tile = bid; tile < 256; tile += G) small_gemm_tile(lds, g, e, tile >> 5, tile & 31, tid, lane, wave);
            }
        }
    }
}

extern "C" void kernel_launch(void* const* d_in, const int* in_sizes, int n_in, void* d_out, int out_size, void* d_ws, size_t ws_size, hipStream_t stream) {
    static int grid = 0;
    if (grid == 0) {
        if (n_in != 36 || (size_t)out_size != O_END || ws_size < WS_END) { fprintf(stderr, "kernel_launch: unexpected shapes: n_in %d out %d ws %zu (need %zu)\n", n_in, out_size, ws_size, (size_t)WS_END); grid = -1; return; }
        int dev = 0, cus = 0, per_cu = 0;
        if (hipGetDevice(&dev) != hipSuccess || hipDeviceGetAttribute(&cus, hipDeviceAttributeMultiprocessorCount, dev) != hipSuccess) { grid = -1; return; }
        if (hipFuncSetAttribute((const void*)mega_fwd, hipFuncAttributeMaxDynamicSharedMemorySize, LDS_BYTES) != hipSuccess) { fprintf(stderr, "kernel_launch: hipFuncSetAttribute failed\n"); grid = -1; return; }
        if (hipOccupancyMaxActiveBlocksPerMultiprocessor(&per_cu, (const void*)mega_fwd, 512, LDS_BYTES) != hipSuccess || per_cu < 1) { fprintf(stderr, "kernel_launch: occupancy query says %d blocks per CU\n", per_cu); per_cu = 1; }
        (void)hipGetLastError();
        grid = cus;
    }
    if (grid < 0) return;
    (void)hipMemsetAsync((char*)d_ws + WS_CTL, 0, CTL_ZERO_BYTES, stream);
    Args a{};
    for (int i = 0; i < 36; ++i) a.in[i] = (const float*)d_in[i];
    a.out = (float*)d_out; a.ws = (unsigned char*)d_ws;
#if MK_ONE_LAUNCH
    a.ph_lo = 0; a.ph_hi = N_PHASES;
    void* args[] = {&a};
    hipError_t e = hipLaunchCooperativeKernel((const void*)mega_fwd, dim3(grid), dim3(512), args, LDS_BYTES, stream);
    if (e != hipSuccess) fprintf(stderr, "cooperative launch failed: %s (grid %d)\n", hipGetErrorString(e), grid);
#else
    for (int ph = 0; ph < N_PHASES; ++ph) {
        a.ph_lo = ph; a.ph_hi = ph + 1;
        hipLaunchKernelGGL(mega_fwd, dim3(grid), dim3(512), LDS_BYTES, stream, a);
    }
#endif
}
```

```cpp
#include <hip/hip_runtime.h>
#include <hip/hip_cooperative_groups.h>
#include <cstdio>
#include <cstdint>
namespace cg = cooperative_groups;

#ifndef MK_ONE_LAUNCH
#define MK_ONE_LAUNCH 1
#endif

#ifndef REP_P0
#define REP_P0 1
#endif
#ifndef DRY_SUB
#define DRY_SUB -1
#endif
#ifndef P0R_T
#define P0R_T 1
#define P0R_X 1
#define P0R_C 1
#endif
#ifndef REP_Z
#define REP_Z 1
#endif
#ifndef REP_POSTZ
#define REP_POSTZ 1
#endif
#ifndef REP_MIX
#define REP_MIX 1
#endif
#ifndef REP_COMB
#define REP_COMB 1
#endif
#ifndef REP_BR
#define REP_BR 1
#endif
#ifndef REP_GU
#define REP_GU 1
#endif
constexpr int D = 1024, TP = 16384, NSEQ = 32, TS = 8, MP = TP, MS = NSEQ * TS, M = MP + MS;
constexpr int DC = 384, NH = 12, HD = 64, DQ = NH * HD, DFF = 2816, DPLE = 256, DIN = 8320, NZ = 8448, ZP = 4352;
constexpr int ZA = 0, ZB = 384, ZQ = 768, ZK = 1536, ZV = 2304, ZU = 3072, ZVV = 3456, ZD = 3840, ZG = 4224;
constexpr float EPS = 1e-6f, LN_EPS = 1e-5f;
constexpr float LOG2E = 1.4426950408889634f, LN2 = 0.6931471805599453f, ATT_C2 = 12.0f;

constexpr size_t O_YP = 0, O_YS = O_YP + (size_t)MP * D, O_KVP0 = O_YS + (size_t)MS * D,
    O_KVP1 = O_KVP0 + 2ull * 128 * 512, O_KVP2 = O_KVP1 + 2ull * 512 * 512, O_CONVP = O_KVP2 + 2ull * 2048 * 512,
    O_POOLP = O_CONVP + 2ull * 30 * 384, O_KVS0 = O_POOLP + 2ull * 15 * 384, O_KVS1 = O_KVS0 + 2ull * 32 * 128 * 512,
    O_KVS2 = O_KVS1 + 2ull * 32 * 512 * 512, O_CONVS = O_KVS2 + 2ull * 32 * 2048 * 512, O_POOLS = O_CONVS + 2ull * 32 * 30 * 384,
    O_SGUS = O_POOLS + 2ull * 32 * 15 * 384, O_END = O_SGUS + 2ull * 32 * 8 * 384;
static_assert(O_END == 109209344ull, "output size");

constexpr size_t MiB = 1u << 20;
constexpr size_t WS_CTL = 0, CTL_ZERO_BYTES = 1 * MiB;
constexpr size_t WS_W = 2 * MiB, WL = 44 * MiB;
constexpr size_t W_IN = 0, W_A = 17 * MiB, W_B = 18 * MiB, W_C = 19 * MiB, W_D = 20 * MiB, W_O = 21 * MiB, W_GU = 23 * MiB, W_DN = 34 * MiB, W_PG = 40 * MiB, W_PLE = 42 * MiB;
constexpr size_t WS_XB = 90 * MiB;
constexpr size_t WS_XRES = 123 * MiB;
constexpr size_t WS_Z = 188 * MiB;
constexpr size_t WS_ZG8 = 340 * MiB;
static_assert(WS_Z + (size_t)M * ZP * 2 <= WS_ZG8 && WS_ZG8 + (size_t)M * 4096 <= 457 * MiB, "ws map z");
constexpr size_t WS_PEB = 457 * MiB;
constexpr size_t WS_GLU = 474 * MiB;
constexpr size_t WS_QN = 487 * MiB;
constexpr size_t WS_KN = 512 * MiB;
constexpr size_t WS_VLN = 537 * MiB;
constexpr size_t WS_ACTA = 550 * MiB, WS_ACTB = 563 * MiB, WS_ACTC = 572 * MiB, WS_ACTD = 585 * MiB;
constexpr size_t WS_MG = 598 * MiB;
constexpr size_t WS_MGB = 663 * MiB;
constexpr size_t WS_HFF = 696 * MiB;
constexpr size_t WS_PL = 786 * MiB;
constexpr size_t WS_OPART = 852 * MiB;
constexpr size_t WS_LSE = 877 * MiB;
constexpr size_t WS_XB2 = 879 * MiB;
constexpr size_t WS_SGUW = 912 * MiB;
constexpr size_t WS_END = 913 * MiB;
static_assert(WS_XB2 + (size_t)M * D * 2 <= WS_SGUW && WS_SGUW + 2ull * 4 * 128 * 128 * 2 <= WS_END, "ws map 6");
static_assert(WS_OPART + (size_t)M * DQ * 2 <= WS_LSE && WS_LSE + (size_t)M * 12 * 4 <= WS_XB2, "ws map 5");
static_assert(W_IN + (size_t)NZ * D * 2 <= W_A && W_GU + 2ull * DFF * D * 2 <= W_DN && W_DN + (size_t)D * DFF * 2 <= W_PG && W_PLE + (size_t)D * DPLE * 2 <= WL, "weight map");
static_assert(WS_W + 2 * WL <= WS_XB && WS_XB + (size_t)M * D * 2 <= WS_XRES && WS_XRES + (size_t)M * D * 4 <= WS_Z && WS_Z + (size_t)M * ZP * 2 <= WS_PEB, "ws map 1");
static_assert(WS_PEB + 2ull * M * DPLE * 2 <= WS_GLU && WS_GLU + (size_t)M * 384 * 2 <= WS_QN && WS_QN + (size_t)M * DQ * 2 <= WS_KN && WS_KN + (size_t)M * DQ * 2 <= WS_VLN, "ws map 2");
static_assert(WS_VLN + (size_t)M * 384 * 2 <= WS_ACTA && WS_ACTA + (size_t)M * 384 * 2 <= WS_ACTB && WS_ACTB + (size_t)M * 256 * 2 <= WS_ACTC && WS_ACTC + (size_t)M * 384 * 2 <= WS_ACTD, "ws map 3");
static_assert(WS_ACTD + (size_t)M * 384 * 2 <= WS_MG && WS_MG + (size_t)M * D * 4 <= WS_MGB && WS_MGB + (size_t)M * D * 2 <= WS_HFF && WS_HFF + (size_t)M * DFF * 2 <= WS_PL && WS_PL + (size_t)M * D * 4 <= WS_OPART, "ws map 4");
constexpr int RS_STRIDE = 16896;
constexpr int RS_MIX0 = 0, RS_FFN0 = 1, RS_PLE0 = 2, RS_MIX1 = 3, RS_FFN1 = 4, RS_PLE1 = 5;
static_assert(6ull * RS_STRIDE * 4 <= CTL_ZERO_BYTES, "ctl");

constexpr int RING_BYTES = 131072, LDS_BYTES = 147456;

#define LAS __attribute__((address_space(3)))
typedef unsigned short bf16_t;
typedef short bf16x8 __attribute__((ext_vector_type(8)));
typedef float f32x4 __attribute__((ext_vector_type(4)));
typedef float f32x16 __attribute__((ext_vector_type(16)));
typedef float f32x2 __attribute__((ext_vector_type(2)));
typedef unsigned u32x4 __attribute__((ext_vector_type(4)));
typedef unsigned u32x2 __attribute__((ext_vector_type(2)));

__device__ __forceinline__ unsigned cvt_pk_bf16(float lo, float hi) { unsigned r; asm("v_cvt_pk_bf16_f32 %0, %1, %2" : "=v"(r) : "v"(lo), "v"(hi)); return r; }
__device__ __forceinline__ float bf_lo(unsigned w) { return __uint_as_float(w << 16); }
__device__ __forceinline__ float bf_hi(unsigned w) { return __uint_as_float(w & 0xffff0000u); }
__device__ __forceinline__ void unpack8(const u32x4 w, float (&f)[8]) { f[0] = bf_lo(w.x); f[1] = bf_hi(w.x); f[2] = bf_lo(w.y); f[3] = bf_hi(w.y); f[4] = bf_lo(w.z); f[5] = bf_hi(w.z); f[6] = bf_lo(w.w); f[7] = bf_hi(w.w); }
__device__ __forceinline__ u32x4 pack8(const float (&f)[8]) { u32x4 w; w.x = cvt_pk_bf16(f[0], f[1]); w.y = cvt_pk_bf16(f[2], f[3]); w.z = cvt_pk_bf16(f[4], f[5]); w.w = cvt_pk_bf16(f[6], f[7]); return w; }
__device__ __forceinline__ float bf1(bf16_t b) { return __uint_as_float((unsigned)b << 16); }
__device__ __forceinline__ float sigmoidf_(float x) { return __builtin_amdgcn_rcpf(1.0f + __expf(-x)); }
__device__ __forceinline__ float wave_sum(float v) {
#pragma unroll
    for (int o = 1; o < 64; o <<= 1) v += __shfl_xor(v, o);
    return v;
}

namespace pg8 {
#define PG8_LAS __attribute__((address_space(3)))
typedef unsigned short bf16_t;
typedef short bf16x8 __attribute__((ext_vector_type(8)));
typedef float f32x4 __attribute__((ext_vector_type(4)));
typedef unsigned u32x4 __attribute__((ext_vector_type(4)));
constexpr int BM = 256, BK = 64, HALF = 128, HTB = HALF * BK * 2  , STAGE_BYTES = 8 * HTB, NXCD = 8, WGM = 8;

__host__ __device__ __forceinline__ int lds_byte(int r, int c) { const int st = (r >> 4) * 2 + (c >> 5), rr = r & 15, cc = c & 31, ob = rr * 64 + cc * 2; return st * 1024 + (ob ^ (((ob >> 9) & 1) << 5)); }
__host__ __device__ __forceinline__ void stage_rc(int b, int& R, int& C) { const int st = b / 1024, sb = b % 1024, swz = sb ^ (((sb >> 9) & 1) << 5); R = (st >> 1) * 16 + swz / 64; C = (st & 1) * 32 + (swz % 64) / 2; }
__host__ __device__ __forceinline__ int perm32(int rho) { const int n = rho >> 4, i = rho & 15; return 8 * (i >> 2) + 4 * n + (i & 3); }

struct Unit { int pm, pn; };
struct Gemm { const bf16_t* A; const bf16_t* Bt; int M, N, K; };

struct StaticOrder {
    int nM, nN, nwg, G, c, wgm;
    __host__ __device__ __forceinline__ void init(int M, int N, int G_, int c_, int wgm_) { nM = M / BM; nN = N / BM; nwg = nM * nN; G = G_; c = c_; wgm = wgm_; }
    __host__ __device__ __forceinline__ bool next(int i, Unit& u) const { return next_at((long)i * G + c, u); }
    __host__ __device__ __forceinline__ bool next_at(long L, Unit& u) const {
        if (L >= nwg) return false;
        int wgid = (int)L; { const int q = nwg / NXCD, r = nwg % NXCD, xcd = wgid % NXCD, off = wgid / NXCD; wgid = (xcd < r ? xcd * (q + 1) : r * (q + 1) + (xcd - r) * q) + off; }
        const int nig = wgm * nN, gid = wgid / nig, fm = gid * wgm, gsz = (nM - fm) < wgm ? (nM - fm) : wgm;
        u.pm = fm + ((wgid % nig) % gsz); u.pn = (wgid % nig) / gsz; return true;
    }
    __device__ __forceinline__ void a_ready(const Unit&) const {}
    __device__ __forceinline__ void done(const Unit&) const {}
};


enum EpiMode { EP_Z = 0, EP_BR_FIRST = 1, EP_BR_MID = 2, EP_BR_LAST = 3, EP_RES = 4, EP_GLU = 5, EP_PL = 6, EP_PLE = 7, EP_BRC = 8 };
struct UnitX;
__device__ __forceinline__ void unpackg8(const u32x2 w, float (&g)[8]) {
#pragma unroll
    for (int j = 0; j < 4; ++j) { g[j] = (float)((w.x >> (8 * j)) & 0xffu) + 0.5f; g[4 + j] = (float)((w.y >> (8 * j)) & 0xffu) + 0.5f; }
}
struct Epi {
    static constexpr bool PERM = true, AFTER_DRAIN = false;
    int mode;
    const float* rowss;
    bf16_t* ob; int ldb;
    float* of;
    const float* rin_p; const float* rin_s;
    const bf16_t* rin_b;
    float* rs_out;
    unsigned char* gate8;
    const bf16_t* pl;
    float* mg;
    __device__ __forceinline__ bool needs_rstd() const { return mode == EP_Z || mode == EP_PLE || mode == EP_GLU; }
    __device__ __forceinline__ float row_rstd(int row) const { return rsqrtf(rowss[row] * (1.0f / 1024.0f) + EPS); }
    __device__ __forceinline__ const float* res_base(int row) const { return (row < MP) ? rin_p : (rin_s - (size_t)MP * 1024); }
    __device__ __forceinline__ float epi8(int row, int col, f32x4 v0, f32x4 v1, float r, const float* rbase) const {
        float ss = 0.f;
        if (mode == EP_Z) {
            v0 *= r; v1 *= r;
            if (col < ZG) {
                u32x4 w; w.x = cvt_pk_bf16(v0[0], v0[1]); w.y = cvt_pk_bf16(v0[2], v0[3]); w.z = cvt_pk_bf16(v1[0], v1[1]); w.w = cvt_pk_bf16(v1[2], v1[3]);
                *(u32x4*)(ob + (size_t)row * ldb + col) = w;
            } else if (col < DIN) {
                unsigned q[8];
#pragma unroll
                for (int j = 0; j < 4; ++j) { q[j] = (unsigned)(sigmoidf_(v0[j]) * 256.0f); q[4 + j] = (unsigned)(sigmoidf_(v1[j]) * 256.0f); }
#pragma unroll
                for (int j = 0; j < 8; ++j) q[j] = q[j] > 255u ? 255u : q[j];
                u32x2 w; w.x = q[0] | (q[1] << 8) | (q[2] << 16) | (q[3] << 24); w.y = q[4] | (q[5] << 8) | (q[6] << 16) | (q[7] << 24);
                *(u32x2*)(gate8 + (size_t)row * 4096 + (col - ZG)) = w;
            }
        } else if (mode == EP_BR_FIRST || mode == EP_BR_MID || mode == EP_BR_LAST) {
            float g[8]; unpackg8(*(const u32x2*)(gate8 + (size_t)row * 4096 + col), g);
#pragma unroll
            for (int j = 0; j < 8; ++j) g[j] *= (1.0f / 256.0f);
            v0[0] *= g[0]; v0[1] *= g[1]; v0[2] *= g[2]; v0[3] *= g[3];
            v1[0] *= g[4]; v1[1] *= g[5]; v1[2] *= g[6]; v1[3] *= g[7];
            float* mp = mg + (size_t)row * 1024 + col;
            if (mode != EP_BR_FIRST) { v0 += *(const f32x4*)mp; v1 += *(const f32x4*)(mp + 4); }
            if (mode != EP_BR_LAST) { *(f32x4*)mp = v0; *(f32x4*)(mp + 4) = v1; }
            else {
                u32x4 w; w.x = cvt_pk_bf16(v0[0], v0[1]); w.y = cvt_pk_bf16(v0[2], v0[3]); w.z = cvt_pk_bf16(v1[0], v1[1]); w.w = cvt_pk_bf16(v1[2], v1[3]);
                *(u32x4*)(ob + (size_t)row * ldb + col) = w;
            }
        } else if (mode == EP_RES || mode == EP_PLE) {
            f32x4 x0, x1;
            if (rin_b) { float xr[8]; unpack8(*(const u32x4*)(rin_b + (size_t)row * 1024 + col), xr); x0 = (f32x4){xr[0], xr[1], xr[2], xr[3]}; x1 = (f32x4){xr[4], xr[5], xr[6], xr[7]}; }
            else { const float* rp = rbase + (size_t)row * 1024 + col; x0 = *(const f32x4*)rp; x1 = *(const f32x4*)(rp + 4); }
            if (mode == EP_PLE) {
                float p[8]; unpack8(*(const u32x4*)(pl + (size_t)row * 1024 + col), p);
                v0[0] = p[0] * sigmoidf_(v0[0] * r); v0[1] = p[1] * sigmoidf_(v0[1] * r); v0[2] = p[2] * sigmoidf_(v0[2] * r); v0[3] = p[3] * sigmoidf_(v0[3] * r);
                v1[0] = p[4] * sigmoidf_(v1[0] * r); v1[1] = p[5] * sigmoidf_(v1[1] * r); v1[2] = p[6] * sigmoidf_(v1[2] * r); v1[3] = p[7] * sigmoidf_(v1[3] * r);
            }
            x0 += v0; x1 += v1;
            if (of) { float* op = of + (size_t)row * 1024 + col; *(f32x4*)op = x0; *(f32x4*)(op + 4) = x1; }
            if (ob) {
                u32x4 w; w.x = cvt_pk_bf16(x0[0], x0[1]); w.y = cvt_pk_bf16(x0[2], x0[3]); w.z = cvt_pk_bf16(x1[0], x1[1]); w.w = cvt_pk_bf16(x1[2], x1[3]);
                *(u32x4*)(ob + (size_t)row * ldb + col) = w;
            }
            ss = (x0[0] * x0[0] + x0[1] * x0[1]) + (x0[2] * x0[2] + x0[3] * x0[3]) + (x1[0] * x1[0] + x1[1] * x1[1]) + (x1[2] * x1[2] + x1[3] * x1[3]);
        } else {
            u32x4 w; w.x = cvt_pk_bf16(v0[0], v0[1]); w.y = cvt_pk_bf16(v0[2], v0[3]); w.z = cvt_pk_bf16(v1[0], v1[1]); w.w = cvt_pk_bf16(v1[2], v1[3]);
            *(u32x4*)(ob + (size_t)row * ldb + col) = w;
        }
        return ss;
    }
    template <class U>
    __device__ __forceinline__ void rescale(f32x4 (&acc)[2][2][4][2], const U& u, int wr, int wc, int fr, int fq) const {
        const int rowb = u.pm * BM + wr * 64 + fr;
        const int colb = u.pn * BM + wc * 32 + 8 * fq;
        const bool zero = u.zero_after;
        const unsigned char* gb = gate8 + u.seg * 1024;
#pragma unroll
        for (int ai = 0; ai < 2; ++ai)
#pragma unroll
            for (int m = 0; m < 4; ++m) {
                const int row = rowb + ai * HALF + m * 16;
#pragma unroll
                for (int bj = 0; bj < 2; ++bj) {
                    f32x4 r0 = {0.f, 0.f, 0.f, 0.f}, r1 = {0.f, 0.f, 0.f, 0.f};
                    if (!zero) {
                        const unsigned char* gp = gb + (size_t)row * 4096 + colb + bj * HALF;
                        float g0[8], g1[8]; unpackg8(*(const u32x2*)gp, g0); unpackg8(*(const u32x2*)(gp + 1024), g1);
#pragma unroll
                        for (int j = 0; j < 4; ++j) { r0[j] = g0[j] * __builtin_amdgcn_rcpf(g1[j]); r1[j] = g0[4 + j] * __builtin_amdgcn_rcpf(g1[4 + j]); }
                    }
                    acc[ai][bj][m][0] = acc[ai][bj][m][0] * r0; acc[ai][bj][m][1] = acc[ai][bj][m][1] * r1;
                }
            }
    }
    __device__ __forceinline__ void brc_store(const f32x4 (&acc)[2][2][4][2], int seg, int rowb, int colb) const {
        const unsigned char* gb = gate8 + seg * 1024 + colb;
        u32x2 cg[2];
#define BRS_LOAD(I, G) do { const unsigned char* _gp = gb + (size_t)(rowb + ((I) >> 2) * HALF + ((I) & 3) * 16) * 4096; (G)[0] = *(const u32x2*)_gp; (G)[1] = *(const u32x2*)(_gp + HALF); } while (0)
        BRS_LOAD(0, cg);
#pragma unroll
        for (int i = 0; i < 8; ++i) {
            u32x2 ng[2];
            if (i < 7) BRS_LOAD(i + 1, ng);
            const int ai = i >> 2, m = i & 3;
            const int row = rowb + ai * HALF + m * 16;
#pragma unroll
            for (int bj = 0; bj < 2; ++bj) {
                float g0[8]; unpackg8(cg[bj], g0);
#pragma unroll
                for (int j = 0; j < 8; ++j) g0[j] *= (1.0f / 256.0f);
                const f32x4 v0 = acc[ai][bj][m][0], v1 = acc[ai][bj][m][1];
                u32x4 w; w.x = cvt_pk_bf16(v0[0] * g0[0], v0[1] * g0[1]); w.y = cvt_pk_bf16(v0[2] * g0[2], v0[3] * g0[3]); w.z = cvt_pk_bf16(v1[0] * g0[4], v1[1] * g0[5]); w.w = cvt_pk_bf16(v1[2] * g0[6], v1[3] * g0[7]);
                *(u32x4*)(ob + (size_t)row * ldb + colb + bj * HALF) = w;
            }
            if (i < 7) { cg[0] = ng[0]; cg[1] = ng[1]; }
            asm volatile("" ::: "memory");
        }
#undef BRS_LOAD
    }
    template <bool BFRES, bool PLE>
    __device__ __forceinline__ void res_loop(const f32x4 (&acc)[2][2][4][2], int rowb, int colb, int fq, const float (&rs8)[8]) const {
        const float* rbase = res_base(rowb);
        const bool ssq = rs_out != nullptr;
        u32x4 cb[2], cp[2]; f32x4 cf[2][2];
#define RES_LOAD(I, B, F, P) do { const int _row = rowb + ((I) >> 2) * HALF + ((I) & 3) * 16; _Pragma("unroll") for (int _bj = 0; _bj < 2; ++_bj) { const size_t _o = (size_t)_row * 1024 + colb + _bj * HALF; \
            if constexpr (BFRES) (B)[_bj] = *(const u32x4*)(rin_b + _o); else { (F)[_bj][0] = *(const f32x4*)(rbase + _o); (F)[_bj][1] = *(const f32x4*)(rbase + _o + 4); } \
            if constexpr (PLE) (P)[_bj] = *(const u32x4*)(pl + _o); } } while (0)
        RES_LOAD(0, cb, cf, cp);
#pragma unroll
        for (int i = 0; i < 8; ++i) {
            u32x4 nb[2], np[2]; f32x4 nf[2][2];
            if (i < 7) RES_LOAD(i + 1, nb, nf, np);
            const int ai = i >> 2, m = i & 3;
            const int row = rowb + ai * HALF + m * 16;
            const float r = rs8[i];
            float ss = 0.f;
#pragma unroll
            for (int bj = 0; bj < 2; ++bj) {
                const int col = colb + bj * HALF;
                f32x4 x0, x1;
                if constexpr (BFRES) { float xr[8]; unpack8(cb[bj], xr); x0 = (f32x4){xr[0], xr[1], xr[2], xr[3]}; x1 = (f32x4){xr[4], xr[5], xr[6], xr[7]}; }
                else { x0 = cf[bj][0]; x1 = cf[bj][1]; }
                f32x4 v0 = acc[ai][bj][m][0], v1 = acc[ai][bj][m][1];
                if constexpr (PLE) {
                    float p[8]; unpack8(cp[bj], p);
                    v0[0] = p[0] * sigmoidf_(v0[0] * r); v0[1] = p[1] * sigmoidf_(v0[1] * r); v0[2] = p[2] * sigmoidf_(v0[2] * r); v0[3] = p[3] * sigmoidf_(v0[3] * r);
                    v1[0] = p[4] * sigmoidf_(v1[0] * r); v1[1] = p[5] * sigmoidf_(v1[1] * r); v1[2] = p[6] * sigmoidf_(v1[2] * r); v1[3] = p[7] * sigmoidf_(v1[3] * r);
                }
                x0 += v0; x1 += v1;
                if (of) { float* op = of + (size_t)row * 1024 + col; *(f32x4*)op = x0; *(f32x4*)(op + 4) = x1; }
                if (ob) {
                    u32x4 w; w.x = cvt_pk_bf16(x0[0], x0[1]); w.y = cvt_pk_bf16(x0[2], x0[3]); w.z = cvt_pk_bf16(x1[0], x1[1]); w.w = cvt_pk_bf16(x1[2], x1[3]);
                    *(u32x4*)(ob + (size_t)row * ldb + col) = w;
                }
                ss += (x0[0] * x0[0] + x0[1] * x0[1]) + (x0[2] * x0[2] + x0[3] * x0[3]) + (x1[0] * x1[0] + x1[1] * x1[1]) + (x1[2] * x1[2] + x1[3] * x1[3]);
            }
            if (ssq) { ss += __shfl_xor(ss, 16); ss += __shfl_xor(ss, 32); if (fq == 0) unsafeAtomicAdd(rs_out + row, ss); }
            if (i < 7) {
#pragma unroll
                for (int bj = 0; bj < 2; ++bj) { cb[bj] = nb[bj]; cp[bj] = np[bj]; cf[bj][0] = nf[bj][0]; cf[bj][1] = nf[bj][1]; }
            }
            asm volatile("" ::: "memory");
        }
#undef RES_LOAD
    }
    template <class U>
    __device__ __forceinline__ void operator()(const f32x4 (&acc)[2][2][4][2], const U& u, int wr, int wc, int fr, int fq) const {
        const int rowb = u.pm * BM + wr * 64 + fr;
        const int colb = u.pn * BM + wc * 32 + 8 * fq;
        if (mode == EP_BRC) { brc_store(acc, u.seg, rowb, colb); return; }
        float rs8[8];
        if (needs_rstd()) {
#pragma unroll
            for (int i = 0; i < 8; ++i) rs8[i] = rowss[rowb + (i >> 2) * HALF + (i & 3) * 16];
            __builtin_amdgcn_sched_barrier(0);
#pragma unroll
            for (int i = 0; i < 8; ++i) rs8[i] = rsqrtf(rs8[i] * (1.0f / 1024.0f) + EPS);
        } else {
#pragma unroll
            for (int i = 0; i < 8; ++i) rs8[i] = 1.0f;
        }
        if (mode == EP_GLU) {
            const int colh = u.pn * HALF + wc * 32 + 8 * fq;
#pragma unroll
            for (int ai = 0; ai < 2; ++ai)
#pragma unroll
                for (int m = 0; m < 4; ++m) {
                    const int row = rowb + ai * HALF + m * 16;
                    const float r = rs8[ai * 4 + m];
                    float h[8];
#pragma unroll
                    for (int n = 0; n < 2; ++n)
#pragma unroll
                        for (int j = 0; j < 4; ++j) { const float g = acc[ai][0][m][n][j] * r, uu = acc[ai][1][m][n][j] * r; h[4 * n + j] = g * sigmoidf_(g) * uu; }
                    *(u32x4*)(ob + (size_t)row * ldb + colh) = pack8(h);
                }
            return;
        }
        if (mode == EP_RES) { if (rin_b) res_loop<true, false>(acc, rowb, colb, fq, rs8); else res_loop<false, false>(acc, rowb, colb, fq, rs8); return; }
        if (mode == EP_PLE) { res_loop<true, true>(acc, rowb, colb, fq, rs8); return; }
#pragma unroll
        for (int ai = 0; ai < 2; ++ai)
#pragma unroll
            for (int m = 0; m < 4; ++m) {
                const int row = rowb + ai * HALF + m * 16;
#pragma unroll
                for (int bj = 0; bj < 2; ++bj) (void)epi8(row, colb + bj * HALF, acc[ai][bj][m][0], acc[ai][bj][m][1], rs8[ai * 4 + m], nullptr);
            }
    }
};


struct UnitX { int pm, pn; const bf16_t* A; const bf16_t* Bt; int K; int seg; bool zero_after; };
template <class Epi, class Sched, bool ALIGN_EPI = false>
__device__ __forceinline__ void gemm_phase(PG8_LAS unsigned char* lds, const Sched& S, const Epi& E, const int tid) {
    const int wid = __builtin_amdgcn_readfirstlane(tid >> 6), lane = tid & 63, wr = wid >> 2, wc = wid & 3, fr = lane & 15, fq = lane >> 4;
    const size_t kstep = (size_t)(BK * 2);
    const unsigned ldsw = (unsigned)wid * 1024u;
    const int aoff = lds_byte(wr * 64 + fr, fq * 8), boff = lds_byte(wc * 32 + fr, fq * 8);
#define PG8_SA(b, h) (((b) * 2 + (h)) * HTB)
#define PG8_SB(b, h) ((4 + (b) * 2 + (h)) * HTB)
#define PG8_STAGE(bufoff, gbase, voff) do { _Pragma("unroll") for (int _i = 0; _i < 2; ++_i) \
        __builtin_amdgcn_global_load_lds((const unsigned*)((const char*)(gbase) + (voff)[_i]), (PG8_LAS unsigned*)(lds + (bufoff) + ldsw + _i * 8192), 16, 0, 0); } while (0)
#define PG8_VOFF(KK, vA, vB) do { int _t = tid; asm volatile("" : "+v"(_t)); _Pragma("unroll") for (int _i = 0; _i < 2; ++_i) { int _R, _C; stage_rc(_t * 16 + _i * 8192, _R, _C); \
        const int _Rb = Epi::PERM ? ((_R & ~31) + perm32(_R & 31)) : _R; (vA)[_i] = (unsigned)(_R * (KK) + _C) * 2u; (vB)[_i] = (unsigned)(_Rb * (KK) + _C) * 2u; } } while (0)
#define PG8_LDA(dst, b, h) do { _Pragma("unroll") for (int m = 0; m < 4; ++m) _Pragma("unroll") for (int k = 0; k < 2; ++k) dst[m][k] = *(const PG8_LAS bf16x8*)(lds + PG8_SA(b, h) + aoff + m * 2048 + k * 1024); } while (0)
#define PG8_LDB(dst, b, h) do { _Pragma("unroll") for (int n = 0; n < 2; ++n) _Pragma("unroll") for (int k = 0; k < 2; ++k) dst[n][k] = *(const PG8_LAS bf16x8*)(lds + PG8_SB(b, h) + boff + n * 2048 + k * 1024); } while (0)
#define PG8_MMA(ai, bj, At, Bt) do { __builtin_amdgcn_s_setprio(1); _Pragma("unroll") for (int m = 0; m < 4; ++m) _Pragma("unroll") for (int n = 0; n < 2; ++n) _Pragma("unroll") for (int k = 0; k < 2; ++k) \
        acc[ai][bj][m][n] = __builtin_amdgcn_mfma_f32_16x16x32_bf16(Bt[n][k], At[m][k], acc[ai][bj][m][n], 0, 0, 0); __builtin_amdgcn_s_setprio(0); } while (0)
#define PG8_WAIT_V(n) asm volatile("s_waitcnt vmcnt(" #n ")" ::: "memory")
#define PG8_WAIT_L(n) asm volatile("s_waitcnt lgkmcnt(" #n ")" ::: "memory")
#define PG8_BAR __builtin_amdgcn_s_barrier()
#define PG8_SCHED __builtin_amdgcn_sched_barrier(0)
#define PG8_SETUNIT(u, pA, pB, hs) do { (hs) = (size_t)HALF * (u).K * 2; (pA) = (const char*)(u).A + (size_t)(u).pm * 2 * (hs); (pB) = (const char*)(u).Bt + (size_t)(u).pn * 2 * (hs); } while (0)
    UnitX cur, nxt; int ui = 0;
    if (!S.next(0, cur)) return;
    f32x4 acc[2][2][4][2];
#pragma unroll
    for (int a = 0; a < 2; ++a)
#pragma unroll
        for (int b = 0; b < 2; ++b)
#pragma unroll
            for (int m = 0; m < 4; ++m)
#pragma unroll
                for (int n = 0; n < 2; ++n) acc[a][b][m][n] = (f32x4){0.f, 0.f, 0.f, 0.f};
    bf16x8 At[4][2], B0[2][2], B1[2][2];
    const char* cA; const char* cB; size_t hstep;
    PG8_SETUNIT(cur, cA, cB, hstep);
    int cK = cur.K;
    unsigned voffA[2], voffB[2];
    PG8_VOFF(cK, voffA, voffB);
    PG8_STAGE(PG8_SB(0, 0), cB, voffB); PG8_STAGE(PG8_SB(0, 1), cB + hstep, voffB); PG8_STAGE(PG8_SA(0, 0), cA, voffA); PG8_STAGE(PG8_SA(0, 1), cA + hstep, voffA);
    if (wr == 1) PG8_BAR;
    PG8_WAIT_V(2); PG8_BAR;
    PG8_STAGE(PG8_SB(1, 0), cB + kstep, voffB); PG8_STAGE(PG8_SA(1, 0), cA + kstep, voffA); PG8_STAGE(PG8_SB(1, 1), cB + hstep + kstep, voffB);
    PG8_WAIT_V(6); PG8_BAR;
    for (;;) {
        const bool has_next = S.next(ui + 1, nxt);
        const char* nA = cA; const char* nB = cB; size_t nhstep = hstep; int nK = cK;
        if (has_next) { PG8_SETUNIT(nxt, nA, nB, nhstep); nK = nxt.K; }
        const int nt = cK / BK;
        for (int t = 0; t < nt; t += 2) {
            const bool last = (t == nt - 2);
            const char* a1 = cA + (size_t)(t + 1) * kstep;
            const char* a2 = last ? nA : cA + (size_t)(t + 2) * kstep; const char* b2 = last ? nB : cB + (size_t)(t + 2) * kstep;
            const char* a3 = a2 + kstep; const char* b3 = b2 + kstep;
            PG8_LDB(B0, 0, 0); PG8_LDB(B1, 0, 1); PG8_SCHED; PG8_LDA(At, 0, 0); PG8_STAGE(PG8_SA(1, 1), a1 + hstep, voffA);
            if (last) { PG8_VOFF(nK, voffA, voffB); hstep = nhstep; }
            PG8_WAIT_V(8); PG8_WAIT_L(0); PG8_BAR; PG8_MMA(0, 0, At, B0); PG8_MMA(0, 1, At, B1); PG8_BAR; PG8_SCHED;
            PG8_LDA(At, 0, 1); PG8_STAGE(PG8_SB(0, 0), b2, voffB); PG8_STAGE(PG8_SB(0, 1), b2 + hstep, voffB); PG8_STAGE(PG8_SA(0, 0), a2, voffA);
            PG8_WAIT_V(8); PG8_WAIT_L(0); PG8_BAR; PG8_MMA(1, 0, At, B0); PG8_MMA(1, 1, At, B1); PG8_BAR; PG8_SCHED;
            PG8_LDB(B0, 1, 0); PG8_LDB(B1, 1, 1); PG8_SCHED; PG8_LDA(At, 1, 0); PG8_STAGE(PG8_SA(0, 1), a2 + hstep, voffA);
            PG8_WAIT_V(8); PG8_WAIT_L(0); PG8_BAR; PG8_MMA(0, 0, At, B0); PG8_MMA(0, 1, At, B1); PG8_BAR; PG8_SCHED;
            PG8_LDA(At, 1, 1); PG8_STAGE(PG8_SB(1, 0), b3, voffB); PG8_STAGE(PG8_SB(1, 1), b3 + hstep, voffB); PG8_STAGE(PG8_SA(1, 0), a3, voffA);
            PG8_WAIT_V(8); PG8_WAIT_L(0); PG8_BAR; PG8_MMA(1, 0, At, B0); PG8_MMA(1, 1, At, B1); PG8_BAR; PG8_SCHED;
        }
        if constexpr (ALIGN_EPI) { if (wr == 0) PG8_BAR; }
        if (cur.zero_after) E(acc, cur, wr, wc, fr, fq);
        if (!has_next) break;
        E.rescale(acc, cur, wr, wc, fr, fq);
        cur = nxt; cA = nA; cB = nB; cK = nK;
        ++ui;
        if constexpr (ALIGN_EPI) { if (wr == 1) PG8_BAR; }
    }
    PG8_WAIT_V(0);
    if constexpr (!ALIGN_EPI) { if (wr == 0) PG8_BAR; }
    PG8_BAR;
#undef PG8_SA
#undef PG8_SB
#undef PG8_STAGE
#undef PG8_VOFF
#undef PG8_LDA
#undef PG8_LDB
#undef PG8_MMA
#undef PG8_WAIT_V
#undef PG8_WAIT_L
#undef PG8_BAR
#undef PG8_SCHED
#undef PG8_SETUNIT
}

struct SegSched {
    StaticOrder so; int nseg;
    int split_rounds;
    const bf16_t* A0; const bf16_t* B0; int K0;
    const unsigned char* ws; const unsigned char* wl;
    __device__ __forceinline__ bool next(int i, UnitX& u) const {
        const int q = (nseg == 1) ? i : (i >> 2), sg = (nseg == 1) ? 0 : (i & 3);
        Unit b;
        if (split_rounds > 0) {
            const int c = so.c; long L;
            if (c < 128) L = (q < split_rounds) ? (long)c + 128 * q : (long)128 * split_rounds + c + 256 * (q - split_rounds);
            else L = (long)128 * split_rounds + c + 256 * q;
            if (!so.next_at(L, b)) return false;
        } else if (!so.next(q, b)) return false;
        u.pm = b.pm; u.pn = b.pn; u.seg = sg; u.zero_after = (sg == nseg - 1);
        if (nseg == 1) { u.A = A0; u.Bt = B0; u.K = K0; }
        else {
            const size_t ao = sg == 0 ? WS_ACTA : (sg == 1 ? WS_ACTB : (sg == 2 ? WS_ACTC : WS_ACTD));
            const size_t bo = sg == 0 ? W_A : (sg == 1 ? W_B : (sg == 2 ? W_C : W_D));
            u.A = (const bf16_t*)(ws + ao); u.Bt = (const bf16_t*)(wl + bo); u.K = (sg == 1) ? 256 : 384;
        }
        return true;
    }
};
}


__device__ const unsigned char T5_BUCKET[3][132] = {
 {0,1,2,3,4,5,6,7,8,9,10,11,12,13,14,15,16,16,16,16,16,16,17,17,17,17,17,17,17,17,18,18,18,18,18,18,18,18,18,18,19,19,19,19,19,19,19,19,19,19,19,19,19,19,20,20,20,20,20,20,20,20,20,20,20,20,20,20,20,20,20,20,20,21,21,21,21,21,21,21,21,21,21,21,21,21,21,21,21,21,21,21,21,21,21,21,21,21,21,22,22,22,22,22,22,22,22,22,22,22,22,22,22,22,22,22,22,22,22,22,22,22,22,22,22,22,22,22,22,0,0,0},
 {0,4,8,12,16,16,17,17,18,18,19,19,19,19,20,20,20,20,20,21,21,21,21,21,21,22,22,22,22,22,22,22,22,22,23,23,23,23,23,23,23,23,23,23,23,23,24,24,24,24,24,24,24,24,24,24,24,24,24,24,24,24,25,25,25,25,25,25,25,25,25,25,25,25,25,25,25,25,25,25,25,25,25,26,26,26,26,26,26,26,26,26,26,26,26,26,26,26,26,26,26,26,26,26,26,26,26,26,26,26,26,26,26,27,27,27,27,27,27,27,27,27,27,27,27,27,27,27,27,0,0,0},
 {0,16,18,19,20,21,21,22,22,23,23,23,24,24,24,24,25,25,25,25,25,26,26,26,26,26,26,26,26,27,27,27,27,27,27,27,27,27,27,28,28,28,28,28,28,28,28,28,28,28,28,28,29,29,29,29,29,29,29,29,29,29,29,29,29,29,29,29,29,29,30,30,30,30,30,30,30,30,30,30,30,30,30,30,30,30,30,30,30,30,30,30,30,30,30,31,31,31,31,31,31,31,31,31,31,31,31,31,31,31,31,31,31,31,31,31,31,31,31,31,31,31,31,31,31,31,31,31,31,0,0,0}};

struct Args { const float* in[36]; float* out; unsigned char* ws; int ph_lo, ph_hi; };
typedef const __attribute__((address_space(4))) Args* ArgsP;


enum { IN_XP = 0, IN_XS, IN_C128, IN_C512, IN_C2048, IN_SCONV, IN_SPOOL, IN_PP, IN_PS, IN_RELB, IN_NMIX, IN_WIN, IN_CONVW, IN_CONVB, IN_CLNG, IN_CLNB, IN_WA,
       IN_QN, IN_KN, IN_WB, IN_SLNG, IN_SLNB, IN_SGUW, IN_SGUB, IN_WC, IN_POOLW, IN_POOLS, IN_WD, IN_WO, IN_NFFN, IN_WGATE, IN_WUP, IN_WDOWN, IN_NPLE, IN_WPG, IN_WPLE };

#define LDS_WAIT() asm volatile("s_waitcnt lgkmcnt(0)" ::: "memory")

__device__ __forceinline__ void transpose_item(const float* W, int K, int N, bf16_t* WT, const float* gain, int mode, LAS float* scr, int item, int lane) {
    const int nblk = N / 64, kb = item / nblk, nb = item % nblk, k0 = 64 * kb, n0 = 64 * nb;
    {
        const int kk = lane >> 4, n4 = (lane & 15) * 4;
        f32x4 v[16];
#pragma unroll
        for (int i = 0; i < 16; ++i) v[i] = *(const f32x4*)(W + (size_t)(k0 + kk + 4 * i) * N + n0 + n4);
#pragma unroll
        for (int i = 0; i < 16; ++i) { LAS float* d = scr + (kk + 4 * i) * 65 + n4; d[0] = v[i][0]; d[1] = v[i][1]; d[2] = v[i][2]; d[3] = v[i][3]; }
    }
    LDS_WAIT(); asm volatile("" ::: "memory");
    const int c = lane & 7;
    f32x4 g0 = {1.f, 1.f, 1.f, 1.f}, g1 = {1.f, 1.f, 1.f, 1.f};
    if (gain) { g0 = *(const f32x4*)(gain + k0 + 8 * c); g1 = *(const f32x4*)(gain + k0 + 8 * c + 4); }
#pragma unroll
    for (int j = 0; j < 8; ++j) {
        const int n = (lane >> 3) + 8 * j; const LAS float* s = scr + (8 * c) * 65 + n;
        u32x4 o; o.x = cvt_pk_bf16(s[0 * 65] * g0[0], s[1 * 65] * g0[1]); o.y = cvt_pk_bf16(s[2 * 65] * g0[2], s[3 * 65] * g0[3]); o.z = cvt_pk_bf16(s[4 * 65] * g1[0], s[5 * 65] * g1[1]); o.w = cvt_pk_bf16(s[6 * 65] * g1[2], s[7 * 65] * g1[3]);
        const int nn = n0 + n;
        const int row = (mode == 0) ? nn : ((nn >> 7) * 256 + (nn & 127) + (mode == 2 ? 128 : 0));
        *(u32x4*)(WT + (size_t)row * K + k0 + 8 * c) = o;
    }
    LDS_WAIT(); asm volatile("" ::: "memory");
}

__device__ __forceinline__ void poolfold_item(const float* pw, const float* psc, const float* wd, bf16_t* WT, int item, int lane) {
    const int nb = item / 48, cb = item - nb * 48, c0 = 8 * cb, g = c0 / 96, cl0 = c0 - 96 * g, n = 64 * nb + lane;
    float acc[8];
#pragma unroll
    for (int i = 0; i < 8; ++i) acc[i] = 0.f;
    const float* pwg = pw + (size_t)(g * 96 + cl0) * 96;
    const float* wdg = wd + (size_t)(g * 96) * D + n;
    const float* scg = psc + g * 96;
#pragma unroll 32
    for (int cp = 0; cp < 96; ++cp) {
        const float x = wdg[(size_t)cp * D] * scg[cp];
#pragma unroll
        for (int i = 0; i < 8; ++i) acc[i] += pwg[i * 96 + cp] * x;
    }
    *(u32x4*)(WT + (size_t)n * 384 + c0) = pack8(acc);
}

constexpr int STAG_Q_Z = 224, STAG_Q_GU = 320;
constexpr int STAG_TOT_Z = STAG_Q_Z * (159 * 158 / 2), STAG_TOT_GU = STAG_Q_GU * (106 * 105 / 2), STAG_TOT = 2 * (STAG_TOT_Z + STAG_TOT_GU);
static_assert(2145 - 8 * 256 == 97 && 1430 - 5 * 256 == 150, "stagger geometry");
constexpr int CP_N0 = 64 * (128 - 8) * 128, CP_N1 = 64 * (512 - 8) * 128, CP_N2 = 64 * (2048 - 8) * 128, CP_TOT = CP_N0 + CP_N1 + CP_N2;
__device__ __forceinline__ void cache_copy_addr(ArgsP a, int i, const f32x4*& src, f32x4*& dst) {
    if (i < CP_N0) { constexpr int n4 = 120 * 128; const int ls = i / n4, off = i - ls * n4; src = (const f32x4*)a->in[IN_C128] + (size_t)ls * 128 * 128 + 1024 + off; dst = (f32x4*)(a->out + O_KVS0) + (size_t)ls * 128 * 128 + off; }
    else if (i < CP_N0 + CP_N1) { constexpr int n4 = 504 * 128; const int k = i - CP_N0, ls = k / n4, off = k - ls * n4; src = (const f32x4*)a->in[IN_C512] + (size_t)ls * 512 * 128 + 1024 + off; dst = (f32x4*)(a->out + O_KVS1) + (size_t)ls * 512 * 128 + off; }
    else { constexpr int n4 = 2040 * 128; const int k = i - CP_N0 - CP_N1, ls = k / n4, off = k - ls * n4; src = (const f32x4*)a->in[IN_C2048] + (size_t)ls * 2048 * 128 + 1024 + off; dst = (f32x4*)(a->out + O_KVS2) + (size_t)ls * 2048 * 128 + off; }
}
__device__ __forceinline__ void cache_copy_range(ArgsP a, int lo, int hi, int ith, int nth) {
    constexpr int U = 16;
    for (int i0 = lo + ith; i0 < hi; i0 += U * nth) {
        f32x4 v[U];
#pragma unroll
        for (int k = 0; k < U; ++k) { int i = i0 + k * nth; i = i < hi ? i : hi - 1; const f32x4* src; f32x4* dst; cache_copy_addr(a, i, src, dst); v[k] = __builtin_nontemporal_load(src); }
#pragma unroll
        for (int k = 0; k < U; ++k) { const int i = i0 + k * nth; if (i < hi) { const f32x4* src; f32x4* dst; cache_copy_addr(a, i, src, dst); __builtin_nontemporal_store(v[k], dst); } }
    }
}

__device__ __forceinline__ void p0_prologue(ArgsP a, LAS unsigned char* lds, int tid, int lane, int wave, int NCU, int cu, int part, bool stag_z0_here) {
    const int G = NCU, bid = cu;
    const bool do0 = part != 1, do1 = part != 0;
    unsigned char* ws = a->ws;
    LAS float* scr = (LAS float*)(lds + wave * 16640);
    const int gw = bid * 8 + wave, NGW = G * 8;
    const int gtid = bid * 512 + tid, NT = G * 512;
    constexpr int I_IN = 16 * 130, I_A = 6 * 16, I_B = 4 * 16, I_O = 16 * 16, I_G = 16 * 44, I_DN = 44 * 16, I_PLE = 4 * 16, I_PF = 16 * 48;
    constexpr int I_LAYER = I_IN + 2 * I_A + I_PF + I_B + 2 * I_O + 2 * I_G + I_DN + I_PLE;
    for (int it0 = gw; it0 < 2 * I_LAYER * P0R_T; it0 += NGW) {
        const int it = it0 % (2 * I_LAYER);
        const int l = it / I_LAYER; int r = it - l * I_LAYER;
        const bool crit = (l == 0 && r < I_IN);
        if (crit ? !do0 : !do1) continue;
        unsigned char* wl = ws + WS_W + (size_t)l * WL;
        if (r < I_IN) { transpose_item(a->in[IN_WIN] + (size_t)l * D * DIN, D, DIN, (bf16_t*)(wl + W_IN), a->in[IN_NMIX] + l * D, 0, scr, r, lane); continue; } r -= I_IN;
        if (r < I_A) { transpose_item(a->in[IN_WA] + (size_t)l * 384 * D, 384, D, (bf16_t*)(wl + W_A), nullptr, 0, scr, r, lane); continue; } r -= I_A;
        if (r < I_B) { transpose_item(a->in[IN_WB] + (size_t)l * 256 * D, 256, D, (bf16_t*)(wl + W_B), nullptr, 0, scr, r, lane); continue; } r -= I_B;
        if (r < I_A) { transpose_item(a->in[IN_WC] + (size_t)l * 384 * D, 384, D, (bf16_t*)(wl + W_C), nullptr, 0, scr, r, lane); continue; } r -= I_A;
        if (r < I_PF) { poolfold_item(a->in[IN_POOLW] + (size_t)l * 4 * 96 * 96, a->in[IN_POOLS] + l * 384, a->in[IN_WD] + (size_t)l * 384 * D, (bf16_t*)(wl + W_D), r, lane); continue; } r -= I_PF;
        if (r < I_O) { transpose_item(a->in[IN_WO] + (size_t)l * D * D, D, D, (bf16_t*)(wl + W_O), nullptr, 0, scr, r, lane); continue; } r -= I_O;
        if (r < I_G) { transpose_item(a->in[IN_WGATE] + (size_t)l * D * DFF, D, DFF, (bf16_t*)(wl + W_GU), a->in[IN_NFFN] + l * D, 1, scr, r, lane); continue; } r -= I_G;
        if (r < I_G) { transpose_item(a->in[IN_WUP] + (size_t)l * D * DFF, D, DFF, (bf16_t*)(wl + W_GU), a->in[IN_NFFN] + l * D, 2, scr, r, lane); continue; } r -= I_G;
        if (r < I_DN) { transpose_item(a->in[IN_WDOWN] + (size_t)l * DFF * D, DFF, D, (bf16_t*)(wl + W_DN), nullptr, 0, scr, r, lane); continue; } r -= I_DN;
        if (r < I_O) { transpose_item(a->in[IN_WPG] + (size_t)l * D * D, D, D, (bf16_t*)(wl + W_PG), a->in[IN_NPLE] + l * D, 0, scr, r, lane); continue; } r -= I_O;
        transpose_item(a->in[IN_WPLE] + (size_t)l * DPLE * D, DPLE, D, (bf16_t*)(wl + W_PLE), nullptr, 0, scr, r, lane);
    }
    for (int i = gtid; i < 2 * (NZ - DIN) * D / 8; i += NT) { const int l = i / ((NZ - DIN) * D / 8), o = i - l * ((NZ - DIN) * D / 8);
        if (l == 0 ? !do0 : !do1) continue;
        u32x4 z4 = {0u, 0u, 0u, 0u}; asm volatile("" : "+v"(z4));
        *(u32x4*)(ws + WS_W + (size_t)l * WL + W_IN + ((size_t)DIN * D + (size_t)o * 8) * 2) = z4; }
    float* rs0 = (float*)(ws + WS_CTL) + RS_MIX0 * RS_STRIDE;
    bf16_t* xb = (bf16_t*)(ws + WS_XB);
    if (do0) for (int m0 = gw; m0 < M * P0R_X; m0 += NGW) {
        const int m = m0 % M;
        const float* xr = (m < MP) ? a->in[IN_XP] + (size_t)m * D : a->in[IN_XS] + (size_t)(m - MP) * D;
        f32x4 v[4]; float s = 0.f;
#pragma unroll
        for (int j = 0; j < 4; ++j) { v[j] = ((const f32x4*)xr)[lane + 64 * j]; s += (v[j][0] * v[j][0] + v[j][1] * v[j][1]) + (v[j][2] * v[j][2] + v[j][3] * v[j][3]); }
        s = wave_sum(s);
        if (lane == 0) rs0[m] = s;
#pragma unroll
        for (int j = 0; j < 4; ++j) { u32x2 w; w.x = cvt_pk_bf16(v[j][0], v[j][1]); w.y = cvt_pk_bf16(v[j][2], v[j][3]); ((u32x2*)(xb + (size_t)m * D))[lane + 64 * j] = w; }
    }
    if (!do1) return;
    bf16_t* peb = (bf16_t*)(ws + WS_PEB);
    for (int i = gtid; i < 2 * M * 32; i += NT) {
        const int l = i / (M * 32), rem = i - l * (M * 32), m = rem >> 5, c8 = rem & 31;
        const float* src = (m < MP) ? a->in[IN_PP] + ((size_t)l * MP + m) * DPLE + c8 * 8 : a->in[IN_PS] + ((size_t)l * MS + (m - MP)) * DPLE + c8 * 8;
        const f32x4 p0 = *(const f32x4*)src, p1 = *(const f32x4*)(src + 4);
        u32x4 w; w.x = cvt_pk_bf16(p0[0], p0[1]); w.y = cvt_pk_bf16(p0[2], p0[3]); w.z = cvt_pk_bf16(p1[0], p1[1]); w.w = cvt_pk_bf16(p1[2], p1[3]);
        *(u32x4*)(peb + ((size_t)l * M + m) * DPLE + c8 * 8) = w;
    }
    cache_copy_range(a, STAG_TOT, CP_TOT, gtid, NT);
    if (stag_z0_here) cache_copy_range(a, 0, STAG_TOT_Z, gtid, NT);
    if (!stag_z0_here && part == 2) cache_copy_range(a, 0, STAG_TOT, gtid, NT);
    for (int i = gtid; i < 2 * 4 * 128 * 16; i += NT) {
        const int row = i >> 4, j8 = (i & 15) * 8, ii = row & 127;
        const float* src = a->in[IN_SGUW] + (size_t)row * 128 + j8; const f32x4 p0 = *(const f32x4*)src, p1 = *(const f32x4*)(src + 4);
        float v[8] = {p0[0], p0[1], p0[2], p0[3], p1[0], p1[1], p1[2], p1[3]};
#pragma unroll
        for (int k = 0; k < 8; ++k) v[k] = (j8 + k <= ii) ? v[k] : 0.f;
        *(u32x4*)((bf16_t*)(ws + WS_SGUW) + (size_t)row * 128 + j8) = pack8(v);
    }
    for (int i = gtid; i < 64 * 22 * 96; i += NT) { const int ls = i / (22 * 96), off = i - ls * (22 * 96);
        ((f32x4*)(a->out + O_CONVS))[(size_t)ls * 30 * 96 + off] = ((const f32x4*)a->in[IN_SCONV])[(size_t)ls * 30 * 96 + 8 * 96 + off]; }
    for (int i = gtid; i < 64 * 7 * 96; i += NT) { const int ls = i / (7 * 96), off = i - ls * (7 * 96);
        ((f32x4*)(a->out + O_POOLS))[(size_t)ls * 15 * 96 + off] = ((const f32x4*)a->in[IN_SPOOL])[(size_t)ls * 15 * 96 + 8 * 96 + off]; }
}

__device__ __forceinline__ float* kv_out_ptr(float* out, int g, bool isP, int l, int s, int pos) {
    const int W = 128 << (2 * g);
    const size_t base = isP ? (g == 0 ? O_KVP0 : (g == 1 ? O_KVP1 : O_KVP2)) : (g == 0 ? O_KVS0 : (g == 1 ? O_KVS1 : O_KVS2));
    const size_t seq = isP ? (size_t)l : (size_t)(l * 32 + s);
    return out + base + (seq * W + pos) * 512;
}

struct PzRow { u32x4 La, Lb, Lvv, Lq0, Lk0, Lq1, Lk1; };
__device__ __forceinline__ PzRow postz_load(ArgsP a, int m, int lane) {
    const bf16_t* zr = (const bf16_t*)(a->ws + WS_Z) + (size_t)m * ZP;
    const int lc48 = lane < 48 ? lane : 47, ch1 = 64 + (lane & 31);
    PzRow R;
    R.La = *(const u32x4*)(zr + ZA + 8 * lc48); R.Lb = *(const u32x4*)(zr + ZB + 8 * lc48); R.Lvv = *(const u32x4*)(zr + ZVV + 8 * lc48);
    R.Lq0 = *(const u32x4*)(zr + ZQ + 8 * lane); R.Lk0 = *(const u32x4*)(zr + ZK + 8 * lane); R.Lq1 = *(const u32x4*)(zr + ZQ + 8 * ch1); R.Lk1 = *(const u32x4*)(zr + ZK + 8 * ch1);
    return R;
}
__device__ __forceinline__ u32x4 postz_row(ArgsP a, int l, int m, int lane, const PzRow& R) {
    u32x4 vvpk = {0u, 0u, 0u, 0u};
    unsigned char* ws = a->ws;
    const bf16_t* zr = (const bf16_t*)(ws + WS_Z) + (size_t)m * ZP;
    const bool isP = m < MP; const int t = isP ? m : ((m - MP) & 7); const int s = isP ? 0 : ((m - MP) >> 3);
    const int ch1 = 64 + (lane & 31);
    const u32x4 La = R.La, Lb = R.Lb, Lvv = R.Lvv, Lq0 = R.Lq0, Lk0 = R.Lk0, Lq1 = R.Lq1, Lk1 = R.Lk1;
    if (lane < 48) {
        float av[8], bv[8], g[8]; unpack8(La, av); unpack8(Lb, bv);
#pragma unroll
        for (int i = 0; i < 8; ++i) g[i] = av[i] * sigmoidf_(bv[i]);
        *(u32x4*)((bf16_t*)(ws + WS_GLU) + (size_t)m * 384 + 8 * lane) = pack8(g);
        float* dst = nullptr;
        if (isP) { if (t >= TP - 30) dst = a->out + O_CONVP + ((size_t)l * 30 + (t - (TP - 30))) * 384 + 8 * lane; }
        else dst = a->out + O_CONVS + ((size_t)(l * 32 + s) * 30 + 22 + t) * 384 + 8 * lane;
        if (dst) { *(f32x4*)dst = (f32x4){g[0], g[1], g[2], g[3]}; *(f32x4*)(dst + 4) = (f32x4){g[4], g[5], g[6], g[7]}; }
        float* pd = nullptr;
        if (isP) { if (t >= TP - 15) pd = a->out + O_POOLP + ((size_t)l * 15 + (t - (TP - 15))) * 384 + 8 * lane; }
        else pd = a->out + O_POOLS + ((size_t)(l * 32 + s) * 15 + 7 + t) * 384 + 8 * lane;
        if (pd) { float zd[8]; unpack8(*(const u32x4*)(zr + ZD + 8 * lane), zd); *(f32x4*)pd = (f32x4){zd[0], zd[1], zd[2], zd[3]}; *(f32x4*)(pd + 4) = (f32x4){zd[4], zd[5], zd[6], zd[7]}; }
    }
    const float* qw = a->in[IN_QN] + l * HD; const float* kw = a->in[IN_KN] + l * HD;
#pragma unroll
    for (int it = 0; it < 2; ++it) {
        const int ch = lane + 64 * it; const bool act = ch < 96; const int chc = (it == 0) ? lane : ch1;
        const int h = chc >> 3, dc = (chc & 7) * 8, g = h >> 2, hs = h & 3;
        float q[8], k[8];
        unpack8(it == 0 ? Lq0 : Lq1, q); unpack8(it == 0 ? Lk0 : Lk1, k);
        float sq = 0.f, sk = 0.f;
#pragma unroll
        for (int i = 0; i < 8; ++i) { sq += q[i] * q[i]; sk += k[i] * k[i]; }
        sq += __shfl_xor(sq, 1); sq += __shfl_xor(sq, 2); sq += __shfl_xor(sq, 4);
        sk += __shfl_xor(sk, 1); sk += __shfl_xor(sk, 2); sk += __shfl_xor(sk, 4);
        const float rq = rsqrtf(sq * (1.0f / 64.0f) + EPS) * (0.125f * LOG2E), rk = rsqrtf(sk * (1.0f / 64.0f) + EPS);
        const f32x4 qw0 = *(const f32x4*)(qw + dc), qw1 = *(const f32x4*)(qw + dc + 4), kw0 = *(const f32x4*)(kw + dc), kw1 = *(const f32x4*)(kw + dc + 4);
#pragma unroll
        for (int i = 0; i < 4; ++i) { q[i] *= rq * qw0[i]; q[4 + i] *= rq * qw1[i]; k[i] *= rk * kw0[i]; k[4 + i] *= rk * kw1[i]; }
        if (act) {
            *(u32x4*)((bf16_t*)(ws + WS_QN) + (size_t)m * DQ + 8 * ch) = pack8(q);
            *(u32x4*)((bf16_t*)(ws + WS_KN) + (size_t)m * DQ + 8 * ch) = pack8(k);
            const int W = 128 << (2 * g);
            const int pos = isP ? t - (TP - W) : W - 8 + t;
            if (pos >= 0) {
                float* kvp = kv_out_ptr(a->out, g, isP, l, s, pos) + hs * 64 + dc;
                *(f32x4*)kvp = (f32x4){k[0], k[1], k[2], k[3]}; *(f32x4*)(kvp + 4) = (f32x4){k[4], k[5], k[6], k[7]};
                float v[8]; unpack8(*(const u32x4*)(zr + ZV + 8 * ch), v);
                *(f32x4*)(kvp + 256) = (f32x4){v[0], v[1], v[2], v[3]}; *(f32x4*)(kvp + 260) = (f32x4){v[4], v[5], v[6], v[7]};
            }
        }
    }
    {
        float x[8]; const bool act = lane < 48;
        unpack8(Lvv, x);
        float sm = 0.f;
#pragma unroll
        for (int i = 0; i < 8; ++i) sm += x[i];
        sm = wave_sum(act ? sm : 0.f);
        const float mean = sm * (1.0f / 384.0f);
        float sv = 0.f;
#pragma unroll
        for (int i = 0; i < 8; ++i) { x[i] -= mean; sv += x[i] * x[i]; }
        sv = wave_sum(act ? sv : 0.f);
        const float rstd = rsqrtf(sv * (1.0f / 384.0f) + LN_EPS);
        if (act) {
            const float* gg = a->in[IN_SLNG] + l * 384 + 8 * lane; const float* bb = a->in[IN_SLNB] + l * 384 + 8 * lane;
            const f32x4 g0 = *(const f32x4*)gg, g1 = *(const f32x4*)(gg + 4), b0 = *(const f32x4*)bb, b1 = *(const f32x4*)(bb + 4);
#pragma unroll
            for (int i = 0; i < 4; ++i) { x[i] = x[i] * rstd * g0[i] + b0[i]; x[4 + i] = x[4 + i] * rstd * g1[i] + b1[i]; }
            vvpk = pack8(x);
            if (!isP) *(u32x4*)((bf16_t*)(ws + WS_VLN) + (size_t)m * 384 + 8 * lane) = vvpk;
            if (!isP) { float* sp = a->out + O_SGUS + ((size_t)(l * 32 + s) * 8 + t) * 384 + 8 * lane; *(f32x4*)sp = (f32x4){x[0], x[1], x[2], x[3]}; *(f32x4*)(sp + 4) = (f32x4){x[4], x[5], x[6], x[7]}; }
        }
    }
    return vvpk;
}
__device__ __forceinline__ void postz_rows8(ArgsP a, int l, int m0, int lane) {
    u32x4 pk[8];
    PzRow cur = postz_load(a, m0, lane);
#pragma unroll
    for (int r = 0; r < 8; ++r) {
        PzRow nxt = cur;
        if (r < 7) nxt = postz_load(a, m0 + r + 1, lane);
        __builtin_amdgcn_sched_barrier(0);
        pk[r] = postz_row(a, l, m0 + r, lane, cur);
        cur = nxt;
    }
    if (lane < 48) {
        bf16_t* vt = (bf16_t*)(a->ws + WS_VLN) + ((size_t)(m0 >> 7) * 384 + 8 * lane) * 128 + (m0 & 127);
#define PZ_LO(w) ((w) & 0xffffu)
#define PZ_HI(w) ((w) >> 16)
#define PZ_ROW(sel, comp) (u32x4){ sel(pk[0].comp) | (sel(pk[1].comp) << 16), sel(pk[2].comp) | (sel(pk[3].comp) << 16), sel(pk[4].comp) | (sel(pk[5].comp) << 16), sel(pk[6].comp) | (sel(pk[7].comp) << 16) }
        *(u32x4*)(vt + 0 * 128) = PZ_ROW(PZ_LO, x); *(u32x4*)(vt + 1 * 128) = PZ_ROW(PZ_HI, x);
        *(u32x4*)(vt + 2 * 128) = PZ_ROW(PZ_LO, y); *(u32x4*)(vt + 3 * 128) = PZ_ROW(PZ_HI, y);
        *(u32x4*)(vt + 4 * 128) = PZ_ROW(PZ_LO, z); *(u32x4*)(vt + 5 * 128) = PZ_ROW(PZ_HI, z);
        *(u32x4*)(vt + 6 * 128) = PZ_ROW(PZ_LO, w); *(u32x4*)(vt + 7 * 128) = PZ_ROW(PZ_HI, w);
#undef PZ_LO
#undef PZ_HI
#undef PZ_ROW
    }
}

constexpr int TAB_OFF = 122880;
__device__ __forceinline__ void attn_sample_task(ArgsP a, int l, int m, int h, int lane, const LAS float* tab) {
    unsigned char* ws = a->ws;
    const bf16_t* qn = (const bf16_t*)(ws + WS_QN); const bf16_t* kn = (const bf16_t*)(ws + WS_KN); const bf16_t* z = (const bf16_t*)(ws + WS_Z);
    const int g = h >> 2, hs = h & 3, sh = 2 * g, W = 128 << sh;
    const int t = (m - MP) & 7, s = (m - MP) >> 3;
    const int ks = lane >> 3, c = lane & 7;
    float qf[8]; unpack8(*(const u32x4*)(qn + (size_t)m * DQ + h * 64 + 8 * c), qf);
    const float* cache = a->in[IN_C128 + g] + ((size_t)(l * 32 + s) * W) * 512 + hs * 64 + 8 * c;
    const LAS float* tb = tab + h * 132;
    float sc[17];
    const int tk0 = t - (ks << sh);
    const size_t nrow = (size_t)(MP + 8 * s + (tk0 < 0 ? 0 : tk0));
    const int prow0 = tk0 < 0 ? W + tk0 : W - 1;
    {
        float kf[8]; unpack8(*(const u32x4*)(kn + nrow * DQ + h * 64 + 8 * c), kf);
        const float* p = cache + (size_t)prow0 * 512; const f32x4 x0 = *(const f32x4*)p, x1 = *(const f32x4*)(p + 4);
        if (tk0 < 0) { kf[0] = x0[0]; kf[1] = x0[1]; kf[2] = x0[2]; kf[3] = x0[3]; kf[4] = x1[0]; kf[5] = x1[1]; kf[6] = x1[2]; kf[7] = x1[3]; }
        float d = 0.f;
#pragma unroll
        for (int i = 0; i < 8; ++i) d += qf[i] * kf[i];
        d += __shfl_xor(d, 1); d += __shfl_xor(d, 2); d += __shfl_xor(d, 4);
        sc[0] = d + tb[ks];
    }
#pragma unroll
    for (int hb = 0; hb < 2; ++hb) {
        f32x4 x0[8], x1[8];
#pragma unroll
        for (int q = 0; q < 8; ++q) { const int it = 1 + 8 * hb + q; const int j = it * 8 + ks; const int jj = j <= 128 ? j : 128; const float* p = cache + (size_t)(W + t - (jj << sh)) * 512; x0[q] = *(const f32x4*)p; x1[q] = *(const f32x4*)(p + 4); }
        __builtin_amdgcn_sched_barrier(0);
#pragma unroll
        for (int q = 0; q < 8; ++q) {
            const int it = 1 + 8 * hb + q; const int j = it * 8 + ks; const bool inr = j <= 128; const int jj = inr ? j : 128;
            const f32x4 a0 = x0[q], a1 = x1[q];
            float d = (qf[0] * a0[0] + qf[1] * a0[1]) + (qf[2] * a0[2] + qf[3] * a0[3]) + (qf[4] * a1[0] + qf[5] * a1[1]) + (qf[6] * a1[2] + qf[7] * a1[3]);
            d += __shfl_xor(d, 1); d += __shfl_xor(d, 2); d += __shfl_xor(d, 4);
            d += tb[jj];
            sc[it] = inr ? d : -1.0e30f;
        }
        __builtin_amdgcn_sched_barrier(0);
    }
    float mx = sc[0];
#pragma unroll
    for (int it = 1; it < 17; ++it) mx = fmaxf(mx, sc[it]);
    mx = fmaxf(mx, __shfl_xor(mx, 8)); mx = fmaxf(mx, __shfl_xor(mx, 16)); mx = fmaxf(mx, __shfl_xor(mx, 32));
    float sum = 0.f;
#pragma unroll
    for (int it = 0; it < 17; ++it) { sc[it] = __builtin_amdgcn_exp2f(sc[it] - mx); sum += sc[it]; }
    sum += __shfl_xor(sum, 8); sum += __shfl_xor(sum, 16); sum += __shfl_xor(sum, 32);
    float acc[8];
    {
        float vf[8]; unpack8(*(const u32x4*)(z + nrow * ZP + ZV + h * 64 + 8 * c), vf);
        const float* p = cache + (size_t)prow0 * 512 + 256; const f32x4 x0 = *(const f32x4*)p, x1 = *(const f32x4*)(p + 4);
        if (tk0 < 0) { vf[0] = x0[0]; vf[1] = x0[1]; vf[2] = x0[2]; vf[3] = x0[3]; vf[4] = x1[0]; vf[5] = x1[1]; vf[6] = x1[2]; vf[7] = x1[3]; }
#pragma unroll
        for (int i = 0; i < 8; ++i) acc[i] = sc[0] * vf[i];
    }
#pragma unroll
    for (int hb = 0; hb < 2; ++hb) {
        f32x4 x0[8], x1[8];
#pragma unroll
        for (int q = 0; q < 8; ++q) { const int it = 1 + 8 * hb + q; const int j = it * 8 + ks; const int jj = j <= 128 ? j : 128; const float* p = cache + (size_t)(W + t - (jj << sh)) * 512 + 256; x0[q] = *(const f32x4*)p; x1[q] = *(const f32x4*)(p + 4); }
        __builtin_amdgcn_sched_barrier(0);
#pragma unroll
        for (int q = 0; q < 8; ++q) {
            const float pw = sc[1 + 8 * hb + q]; const f32x4 a0 = x0[q], a1 = x1[q];
            acc[0] += pw * a0[0]; acc[1] += pw * a0[1]; acc[2] += pw * a0[2]; acc[3] += pw * a0[3]; acc[4] += pw * a1[0]; acc[5] += pw * a1[1]; acc[6] += pw * a1[2]; acc[7] += pw * a1[3];
        }
        __builtin_amdgcn_sched_barrier(0);
    }
    const float inv = 1.0f / sum;
#pragma unroll
    for (int i = 0; i < 8; ++i) { float v = acc[i]; v += __shfl_xor(v, 8); v += __shfl_xor(v, 16); v += __shfl_xor(v, 32); acc[i] = v * inv; }
    if (lane < 8) *(u32x4*)((bf16_t*)(ws + WS_OPART) + (size_t)m * DQ + h * 64 + 8 * c) = pack8(acc);
    if (lane == 0) ((float*)(ws + WS_LSE))[(size_t)m * 12 + h] = (mx + __builtin_amdgcn_logf(sum) + ATT_C2) * LN2;
}

constexpr int VSP = 72;
typedef short v4i16_t __attribute__((ext_vector_type(4)));
constexpr int NT_ATTP = 12 * (TP / 32);
__device__ __forceinline__ void attn_mfma_task(ArgsP a, LAS unsigned char* wlds, int l, int task, int lane, const LAS float* tab) {
    unsigned char* ws = a->ws;
    const bf16_t* qn = (const bf16_t*)(ws + WS_QN); const bf16_t* kn = (const bf16_t*)(ws + WS_KN); const bf16_t* z = (const bf16_t*)(ws + WS_Z);
    LAS bf16_t* Vs = (LAS bf16_t*)wlds;
    const int h = task / (TP / 32); const int rem = task - h * (TP / 32);
    const int sh = 2 * (h >> 2);
    const int nb = (TP / 32) >> sh;
    const int r = rem / nb, ib = rem - r * nb;
    const int c = lane & 31, hh = lane >> 5;
    const int tq = ((32 * ib + c) << sh) + r;
    bf16x8 qf[4];
#pragma unroll
    for (int s = 0; s < 4; ++s) qf[s] = *(const bf16x8*)(qn + (size_t)tq * DQ + h * 64 + 16 * s + 8 * hh);
    f32x16 o0, o1;
#pragma unroll
    for (int i = 0; i < 16; ++i) { o0[i] = 0.f; o1[i] = 0.f; }
    float lrun = 0.f;
    const int i0 = 32 * ib - 128;
    const LAS float* tb = tab + h * 132;
    bf16x8 kf[4]; u32x4 vr[4];
    {
        int ik = i0 + c; ik = ik < 0 ? 0 : ik; const size_t tk = ((size_t)ik << sh) + r;
#pragma unroll
        for (int s = 0; s < 4; ++s) kf[s] = *(const bf16x8*)(kn + tk * DQ + h * 64 + 16 * s + 8 * hh);
#pragma unroll
        for (int q = 0; q < 4; ++q) { int ikv = i0 + (lane >> 3) + 8 * q; ikv = ikv < 0 ? 0 : ikv; const size_t tv = ((size_t)ikv << sh) + r;
            vr[q] = *(const u32x4*)(z + tv * ZP + ZV + h * 64 + 8 * (lane & 7)); }
    }
#pragma unroll 1
    for (int kt = 0; kt < 5; ++kt) {
        const int ib0 = i0 + 32 * kt;
        bf16x8 kfn[4]; u32x4 vrn[4];
        { const int ibn = i0 + 32 * (kt < 4 ? kt + 1 : 4);
          int ik = ibn + c; ik = ik < 0 ? 0 : ik; const size_t tk = ((size_t)ik << sh) + r;
#pragma unroll
          for (int s = 0; s < 4; ++s) kfn[s] = *(const bf16x8*)(kn + tk * DQ + h * 64 + 16 * s + 8 * hh);
#pragma unroll
          for (int q = 0; q < 4; ++q) { int ikv = ibn + (lane >> 3) + 8 * q; ikv = ikv < 0 ? 0 : ikv; const size_t tv = ((size_t)ikv << sh) + r;
              vrn[q] = *(const u32x4*)(z + tv * ZP + ZV + h * 64 + 8 * (lane & 7)); }
        }
        const bool need_mask = (kt == 0) || (kt == 4) || (ib < 4);
        f32x16 sa;
        if (need_mask) {
#pragma unroll
            for (int reg = 0; reg < 16; ++reg) { const int kr = (reg & 3) + 8 * (reg >> 2) + 4 * hh; const int j = c + 128 - 32 * kt - kr; const int jj = j < 0 ? 0 : (j > 128 ? 128 : j); sa[reg] = tb[jj]; }
        } else {
            const LAS float* tbl = tb + (c + 128 - 32 * kt - 4 * hh);
#pragma unroll
            for (int reg = 0; reg < 16; ++reg) sa[reg] = tbl[-((reg & 3) + 8 * (reg >> 2))];
        }
#pragma unroll
        for (int s = 0; s < 4; ++s) sa = __builtin_amdgcn_mfma_f32_32x32x16_bf16(kf[s], qf[s], sa, 0, 0, 0);
        if (need_mask) {
#pragma unroll
            for (int reg = 0; reg < 16; ++reg) {
                const int kr = (reg & 3) + 8 * (reg >> 2) + 4 * hh;
                const int j = c + 128 - 32 * kt - kr;
                const bool valid = (j >= 0) && (j <= 128) && (ib0 + kr >= 0);
                sa[reg] = valid ? sa[reg] : -1.0e30f;
            }
        }
        float lsum = 0.f;
#pragma unroll
        for (int reg = 0; reg < 16; ++reg) { const float p = __builtin_amdgcn_exp2f(sa[reg]); sa[reg] = p; lsum += p; }
        lrun += lsum;
#pragma unroll
        for (int q = 0; q < 4; ++q) *(LAS u32x4*)(Vs + ((lane >> 3) + 8 * q) * VSP + 8 * (lane & 7)) = vr[q];
#pragma unroll
        for (int s = 0; s < 2; ++s) {
            u32x4 pw; pw.x = cvt_pk_bf16(sa[8 * s + 0], sa[8 * s + 1]); pw.y = cvt_pk_bf16(sa[8 * s + 2], sa[8 * s + 3]); pw.z = cvt_pk_bf16(sa[8 * s + 4], sa[8 * s + 5]); pw.w = cvt_pk_bf16(sa[8 * s + 6], sa[8 * s + 7]);
            const bf16x8 pf = __builtin_bit_cast(bf16x8, pw);
            const LAS bf16_t* vq = Vs + (16 * s + 4 * hh + ((lane & 15) >> 2)) * VSP + 16 * ((lane >> 4) & 1) + 4 * (lane & 3);
            {   const v4i16_t lo = __builtin_amdgcn_ds_read_tr16_b64_v4i16((LAS v4i16_t*)vq), hi = __builtin_amdgcn_ds_read_tr16_b64_v4i16((LAS v4i16_t*)(vq + 8 * VSP));
                const bf16x8 af = {lo[0], lo[1], lo[2], lo[3], hi[0], hi[1], hi[2], hi[3]};
                o0 = __builtin_amdgcn_mfma_f32_32x32x16_bf16(af, pf, o0, 0, 0, 0); }
            {   const v4i16_t lo = __builtin_amdgcn_ds_read_tr16_b64_v4i16((LAS v4i16_t*)(vq + 32)), hi = __builtin_amdgcn_ds_read_tr16_b64_v4i16((LAS v4i16_t*)(vq + 8 * VSP + 32));
                const bf16x8 af = {lo[0], lo[1], lo[2], lo[3], hi[0], hi[1], hi[2], hi[3]};
                o1 = __builtin_amdgcn_mfma_f32_32x32x16_bf16(af, pf, o1, 0, 0, 0); }
        }
#pragma unroll
        for (int s = 0; s < 4; ++s) { kf[s] = kfn[s]; vr[s] = vrn[s]; }
    }
    const float ltot = lrun + __shfl_xor(lrun, 32);
    const float inv = 1.0f / ltot;
    bf16_t* op = (bf16_t*)(ws + WS_OPART) + (size_t)tq * DQ + h * 64 + 4 * hh;
#pragma unroll
    for (int q4 = 0; q4 < 4; ++q4) {
        u32x2 w0; w0.x = cvt_pk_bf16(o0[4 * q4 + 0] * inv, o0[4 * q4 + 1] * inv); w0.y = cvt_pk_bf16(o0[4 * q4 + 2] * inv, o0[4 * q4 + 3] * inv);
        u32x2 w1; w1.x = cvt_pk_bf16(o1[4 * q4 + 0] * inv, o1[4 * q4 + 1] * inv); w1.y = cvt_pk_bf16(o1[4 * q4 + 2] * inv, o1[4 * q4 + 3] * inv);
        *(u32x2*)(op + 8 * q4) = w0; *(u32x2*)(op + 32 + 8 * q4) = w1;
    }
    if (hh == 0) ((float*)(ws + WS_LSE))[(size_t)tq * 12 + h] = (__builtin_amdgcn_logf(ltot) + ATT_C2) * LN2;
}

struct CbRow { float l0, l1, l2; u32x2 w0, w1, w2; };
__device__ __forceinline__ CbRow combine_load(ArgsP a, int m, int lane) {
    unsigned char* ws = a->ws;
    const int hs = lane >> 4, d4 = 4 * (lane & 15);
    const float* ls = (const float*)(ws + WS_LSE) + (size_t)m * 12 + hs;
    const bf16_t* op = (const bf16_t*)(ws + WS_OPART) + (size_t)m * DQ + hs * 64 + d4;
    CbRow R; R.l0 = ls[0]; R.l1 = ls[4]; R.l2 = ls[8]; R.w0 = *(const u32x2*)op; R.w1 = *(const u32x2*)(op + 256); R.w2 = *(const u32x2*)(op + 512);
    return R;
}
__device__ __forceinline__ void combine_row(ArgsP a, int m, int lane, const CbRow& R) {
    unsigned char* ws = a->ws;
    const int hs = lane >> 4, d4 = 4 * (lane & 15);
    const float l0 = R.l0, l1 = R.l1, l2 = R.l2;
    const float mx = fmaxf(l0, fmaxf(l1, l2));
    float e0 = __expf(l0 - mx), e1 = __expf(l1 - mx), e2 = __expf(l2 - mx);
    const float inv = 1.0f / (e0 + e1 + e2); e0 *= inv; e1 *= inv; e2 *= inv;
    const u32x2 w0 = R.w0, w1 = R.w1, w2 = R.w2;
    const float r0 = e0 * bf_lo(w0.x) + e1 * bf_lo(w1.x) + e2 * bf_lo(w2.x), r1 = e0 * bf_hi(w0.x) + e1 * bf_hi(w1.x) + e2 * bf_hi(w2.x);
    const float r2 = e0 * bf_lo(w0.y) + e1 * bf_lo(w1.y) + e2 * bf_lo(w2.y), r3 = e0 * bf_hi(w0.y) + e1 * bf_hi(w1.y) + e2 * bf_hi(w2.y);
    u32x2 o; o.x = cvt_pk_bf16(r0, r1); o.y = cvt_pk_bf16(r2, r3);
    *(u32x2*)((bf16_t*)(ws + WS_ACTB) + (size_t)m * 256 + hs * 64 + d4) = o;
}

constexpr int CT = 32;
template <bool EDGE>
__device__ __forceinline__ void convpool_unit(ArgsP a, LAS unsigned char* lds, int l, int mbase, int s, int t0, int nt, int tid, int lane, int wave) {
    unsigned char* ws = a->ws;
    LAS bf16_t* Gs = (LAS bf16_t*)lds;
    LAS float* CV = (LAS float*)lds;
    LAS bf16_t* Zs = (LAS bf16_t*)(lds + 49152);
    const bf16_t* glub = (const bf16_t*)(ws + WS_GLU) + (size_t)mbase * 384;
    const bf16_t* zd = (const bf16_t*)(ws + WS_Z) + (size_t)mbase * ZP + ZD;
    float w[31]; float cb = 0.f;
    if (tid < 384) {
        const float* cw = a->in[IN_CONVW] + (size_t)l * 31 * 384 + tid;
#pragma unroll
        for (int k = 0; k < 31; ++k) w[k] = cw[k * 384];
        cb = a->in[IN_CONVB][l * 384 + tid];
    }
    __builtin_amdgcn_sched_barrier(0);
    if constexpr (!EDGE) {
        constexpr int NCH = (62 + 47) * 48, NIT = (NCH + 511) / 512;
        u32x4 v[NIT];
#pragma unroll
        for (int k = 0; k < NIT; ++k) {
            int i = tid + 512 * k; i = i < NCH ? i : NCH - 1;
            const bool isg = i < 62 * 48; const int kk = isg ? i : i - 62 * 48; const int r = kk / 48, c8 = kk - r * 48;
            v[k] = isg ? *(const u32x4*)(glub + (size_t)(t0 - 30 + r) * 384 + 8 * c8) : *(const u32x4*)(zd + (size_t)(t0 - 15 + r) * ZP + 8 * c8);
        }
#pragma unroll
        for (int k = 0; k < NIT; ++k) {
            const int i = tid + 512 * k;
            if (i < NCH) { const bool isg = i < 62 * 48; const int kk = isg ? i : i - 62 * 48; const int r = kk / 48, c8 = kk - r * 48; *(LAS u32x4*)((isg ? Gs : Zs) + r * 384 + 8 * c8) = v[k]; }
        }
    } else {
        for (int i = tid; i < (62 + 47) * 48; i += 512) {
            const bool isg = i < 62 * 48; const int k = isg ? i : i - 62 * 48; const int r = k / 48, c8 = k - r * 48;
            const int tt = isg ? t0 - 30 + r : t0 - 15 + r;
            u32x4 v = {0u, 0u, 0u, 0u};
            if (tt >= 0) { if (tt < t0 + nt) v = isg ? *(const u32x4*)(glub + (size_t)tt * 384 + 8 * c8) : *(const u32x4*)(zd + (size_t)tt * ZP + 8 * c8); }
            else if (s >= 0) {
                const float* p = isg ? a->in[IN_SCONV] + ((size_t)(l * 32 + s) * 30 + 30 + tt) * 384 + 8 * c8 : a->in[IN_SPOOL] + ((size_t)(l * 32 + s) * 15 + 15 + tt) * 384 + 8 * c8;
                const f32x4 x0 = *(const f32x4*)p, x1 = *(const f32x4*)(p + 4);
                v.x = cvt_pk_bf16(x0[0], x0[1]); v.y = cvt_pk_bf16(x0[2], x0[3]); v.z = cvt_pk_bf16(x1[0], x1[1]); v.w = cvt_pk_bf16(x1[2], x1[3]);
            }
            *(LAS u32x4*)((isg ? Gs : Zs) + r * 384 + 8 * c8) = v;
        }
    }
    __syncthreads();
    if (tid < 384) {
        const int c = tid;
        float x[CT + 30];
#pragma unroll
        for (int r = 0; r < CT + 30; ++r) x[r] = bf1(Gs[r * 384 + c]);
        asm volatile("s_waitcnt lgkmcnt(0)" ::: "memory");
        __syncthreads();
#pragma unroll
        for (int q = 0; q < CT; ++q) {
            float acc = cb;
#pragma unroll
            for (int k = 0; k < 31; ++k) acc += w[k] * x[q + k];
            CV[q * 384 + c] = acc;
        }
    } else {
        __syncthreads();
        const int c0 = tid - 384;
#pragma unroll 1
        for (int q3 = 0; q3 < 3; ++q3) {
            const int c = c0 + 128 * q3, wg = c / 96;
            float x[CT + 15];
#pragma unroll
            for (int r = 0; r < CT + 15; ++r) x[r] = bf1(Zs[r * 384 + c]);
            float lv[CT + 15], res[CT];
#pragma unroll
            for (int i = 0; i < CT + 15; ++i) lv[i] = x[i];
#pragma unroll
            for (int i = CT + 14; i >= 1; --i) lv[i] += lv[i - 1];
#pragma unroll
            for (int q = 0; q < CT; ++q) res[q] = lv[15 + q];
#pragma unroll
            for (int i = CT + 14; i >= 2; --i) lv[i] += lv[i - 2];
#pragma unroll
            for (int q = 0; q < CT; ++q) res[q] = wg >= 1 ? lv[15 + q] : res[q];
#pragma unroll
            for (int i = CT + 14; i >= 4; --i) lv[i] += lv[i - 4];
#pragma unroll
            for (int q = 0; q < CT; ++q) res[q] = wg >= 2 ? lv[15 + q] : res[q];
#pragma unroll
            for (int i = CT + 14; i >= 8; --i) lv[i] += lv[i - 8];
#pragma unroll
            for (int q = 0; q < CT; ++q) res[q] = wg >= 3 ? lv[15 + q] : res[q];
            const int wlen = 2 << wg;
            bf16_t* op = (bf16_t*)(ws + WS_ACTD) + (size_t)(mbase + t0) * 384 + c;
#pragma unroll
            for (int q = 0; q < CT; ++q) {
                const int cnt = (s < 0) ? min(wlen, t0 + q + 1) : wlen;
                const float pv = res[q] / (float)cnt - x[15 + q];
                if (q < nt) op[(size_t)q * 384] = (bf16_t)(cvt_pk_bf16(pv, 0.f) & 0xffffu);
            }
        }
    }
    float lg[6], lb[6];
    { const float* gp = a->in[IN_CLNG] + l * 384 + lane; const float* bp = a->in[IN_CLNB] + l * 384 + lane;
#pragma unroll
      for (int i = 0; i < 6; ++i) { lg[i] = gp[64 * i]; lb[i] = bp[64 * i]; } }
    __syncthreads();
    for (int tt = wave; tt < nt; tt += 8) {
        float x[6]; float sm = 0.f;
#pragma unroll
        for (int i = 0; i < 6; ++i) { x[i] = CV[tt * 384 + lane + 64 * i]; sm += x[i]; }
        const float mean = wave_sum(sm) * (1.0f / 384.0f);
        float sv = 0.f;
#pragma unroll
        for (int i = 0; i < 6; ++i) { x[i] -= mean; sv += x[i] * x[i]; }
        const float rstd = rsqrtf(wave_sum(sv) * (1.0f / 384.0f) + LN_EPS);
        bf16_t* o = (bf16_t*)(ws + WS_ACTA) + (size_t)(mbase + t0 + tt) * 384;
#pragma unroll
        for (int i = 0; i < 6; ++i) { const int c = lane + 64 * i; const float y = x[i] * rstd * lg[i] + lb[i]; o[c] = (bf16_t)(cvt_pk_bf16(y * sigmoidf_(y), 0.f) & 0xffffu); }
    }
    __syncthreads();
}

__device__ __forceinline__ void sgu_unit(ArgsP a, LAS unsigned char* lds, int l, int m0, int L, int g, int tid) {
    unsigned char* ws = a->ws;
    LAS float* V = (LAS float*)lds;
    LAS float* Wt = (LAS float*)(lds + 128 * 96 * 4);
    const bf16_t* vln = (const bf16_t*)(ws + WS_VLN); const bf16_t* z = (const bf16_t*)(ws + WS_Z);
    for (int i = tid; i < L * 12; i += 512) {
        const int j = i / 12, c8 = i - j * 12; float v[8]; unpack8(*(const u32x4*)(vln + (size_t)(m0 + j) * 384 + g * 96 + 8 * c8), v);
        *(LAS f32x4*)(V + j * 96 + 8 * c8) = (f32x4){v[0], v[1], v[2], v[3]}; *(LAS f32x4*)(V + j * 96 + 8 * c8 + 4) = (f32x4){v[4], v[5], v[6], v[7]};
    }
    const float* sw = a->in[IN_SGUW] + ((size_t)(l * 4 + g) * 128) * 128;
    const int L4 = L / 4;
    for (int i = tid; i < L * L4; i += 512) { const int r = i / L4, j4 = i - r * L4; *(LAS f32x4*)(Wt + r * 128 + 4 * j4) = *(const f32x4*)(sw + (size_t)r * 128 + 4 * j4); }
    __syncthreads();
    if (tid < 384) {
        const int c = tid % 96, iq = tid / 96;
        for (int i = iq; i < L; i += 4) {
            float acc = a->in[IN_SGUB][(l * 4 + g) * 128 + i];
            for (int j = 0; j <= i; ++j) acc += Wt[i * 128 + j] * V[j * 96 + c];
            const float u = bf1(z[(size_t)(m0 + i) * ZP + ZU + g * 96 + c]);
            ((bf16_t*)(ws + WS_ACTC))[(size_t)(m0 + i) * 384 + g * 96 + c] = (bf16_t)(cvt_pk_bf16(u * acc, 0.f) & 0xffffu);
        }
    }
    __syncthreads();
}

template <int IT>
__device__ __forceinline__ void sgu_mfma_tile(ArgsP a, int l, int m0, int g, int ct, int lane) {
    unsigned char* ws = a->ws;
    const int c = lane & 31, hh = lane >> 5;
    const bf16_t* wsb = (const bf16_t*)(ws + WS_SGUW) + ((size_t)(l * 4 + g) * 128 + 32 * IT + c) * 128 + 8 * hh;
    const bf16_t* vp = (const bf16_t*)(ws + WS_VLN) + ((size_t)(m0 >> 7) * 384 + g * 96 + 32 * ct + c) * 128 + 8 * hh;
    f32x16 acc;
#pragma unroll
    for (int i = 0; i < 16; ++i) acc[i] = 0.f;
    constexpr int NST = 2 * (IT + 1);
    bf16x8 afr[NST], bfr[NST];
#pragma unroll
    for (int st = 0; st < NST; ++st) { bfr[st] = *(const bf16x8*)(wsb + 16 * st); afr[st] = *(const bf16x8*)(vp + 16 * st); }
#pragma unroll
    for (int st = 0; st < NST; ++st) acc = __builtin_amdgcn_mfma_f32_32x32x16_bf16(afr[st], bfr[st], acc, 0, 0, 0);
    const int tok = m0 + 32 * IT + c;
    const float bias = a->in[IN_SGUB][(l * 4 + g) * 128 + 32 * IT + c];
    const bf16_t* up = (const bf16_t*)(ws + WS_Z) + (size_t)tok * ZP + ZU + g * 96 + 32 * ct + 4 * hh;
    bf16_t* op = (bf16_t*)(ws + WS_ACTC) + (size_t)tok * 384 + g * 96 + 32 * ct + 4 * hh;
#pragma unroll
    for (int q4 = 0; q4 < 4; ++q4) {
        const u32x2 uw = *(const u32x2*)(up + 8 * q4);
        u32x2 o; o.x = cvt_pk_bf16(bf_lo(uw.x) * (acc[4 * q4 + 0] + bias), bf_hi(uw.x) * (acc[4 * q4 + 1] + bias)); o.y = cvt_pk_bf16(bf_lo(uw.y) * (acc[4 * q4 + 2] + bias), bf_hi(uw.y) * (acc[4 * q4 + 3] + bias));
        *(u32x2*)(op + 8 * q4) = o;
    }
}
__device__ __forceinline__ void sgu_mfma_unit(ArgsP a, int l, int m0, int g, int lane, int wave) {
    if (wave < 3) sgu_mfma_tile<3>(a, l, m0, g, wave, lane);
    else if (wave < 6) { sgu_mfma_tile<2>(a, l, m0, g, wave - 3, lane); sgu_mfma_tile<0>(a, l, m0, g, wave - 3, lane); }
    else if (wave == 6) { sgu_mfma_tile<1>(a, l, m0, g, 0, lane); sgu_mfma_tile<1>(a, l, m0, g, 1, lane); }
    else sgu_mfma_tile<1>(a, l, m0, g, 2, lane);
}

constexpr int NU_ATTP = NT_ATTP / 8;
constexpr int NU_ATTS = MS * 12 / 8;
constexpr int NU_ATT = NU_ATTP + NU_ATTS;
constexpr int NU_SGU = 128 * 4 + 32 * 4;
constexpr int NU_CONV = MP / CT + 32;
constexpr int NU_MIX = NU_ATT + NU_SGU + NU_CONV;
#ifndef MIX_EXTRA_LO
#define MIX_EXTRA_LO 0
#define MIX_EXTRA_HI 0
#endif

__device__ __forceinline__ void p3_mixer(ArgsP a, LAS unsigned char* lds, int l, int tid, int lane, int wave, int G, int bid) {
    LAS float* tab = (LAS float*)(lds + TAB_OFF);
    for (int i = tid; i < 12 * 132; i += 512) { const int h = i / 132, j = i - h * 132; tab[i] = (j <= 128) ? a->in[IN_RELB][(int)T5_BUCKET[h >> 2][j] * 12 + h] * LOG2E - ATT_C2 : 0.f; }
    __syncthreads();
    const int vcu = (G % 8 == 0) ? (bid % 8) * (G / 8) + bid / 8 : bid;
    for (int u = vcu; u < NU_MIX + (MIX_EXTRA_HI - MIX_EXTRA_LO); u += G) {
        int r = u < NU_MIX ? u : MIX_EXTRA_LO + (u - NU_MIX);
        if (r < NU_ATTP) { attn_mfma_task(a, lds + wave * 8192, l, r * 8 + wave, lane, tab); __syncthreads(); continue; } r -= NU_ATTP;
        if (r < NU_ATTS) { const int task = r * 8 + wave; attn_sample_task(a, l, MP + task / 12, task % 12, lane, tab); continue; } r -= NU_ATTS;
        if (r < NU_SGU) { if (r < 512) sgu_mfma_unit(a, l, (r >> 2) * 128, r & 3, lane, wave); else { r -= 512; sgu_unit(a, lds, l, MP + (r >> 2) * 8, 8, r & 3, tid); } continue; } r -= NU_SGU;
        if (r == 0) convpool_unit<true>(a, lds, l, 0, -1, 0, CT, tid, lane, wave); else if (r < MP / CT) convpool_unit<false>(a, lds, l, 0, -1, r * CT, CT, tid, lane, wave); else { r -= MP / CT; convpool_unit<true>(a, lds, l, MP + r * 8, r, 0, 8, tid, lane, wave); }
    }
}


__device__ __forceinline__ void small_gemm_tile(LAS unsigned char* lds, const pg8::Gemm& g, const pg8::Epi& e, int mt, int nt, int tid, int lane, int wave) {
    const int K = g.K, kw = K >> 3, nsteps = kw >> 4;
    const int c = lane & 31, hh = lane >> 5;
    const bf16_t* ap = g.A + (size_t)(MP + 32 * mt + c) * K + wave * kw + 8 * hh;
    const bf16_t* bp = g.Bt + (size_t)(32 * nt + c) * K + wave * kw + 8 * hh;
    f32x16 acc;
#pragma unroll
    for (int i = 0; i < 16; ++i) acc[i] = 0.f;
    for (int s0 = 0; s0 < nsteps; s0 += 8) {
        bf16x8 af[8], bf[8];
#pragma unroll
        for (int i = 0; i < 8; ++i) { const int st = (s0 + i < nsteps) ? s0 + i : nsteps - 1; af[i] = *(const bf16x8*)(ap + 16 * st); bf[i] = *(const bf16x8*)(bp + 16 * st); }
#pragma unroll
        for (int i = 0; i < 8; ++i) { const bf16x8 zz = {0, 0, 0, 0, 0, 0, 0, 0}; const bf16x8 aa = (s0 + i < nsteps) ? af[i] : zz; acc = __builtin_amdgcn_mfma_f32_32x32x16_bf16(bf[i], aa, acc, 0, 0, 0); }
    }
    LAS float* P = (LAS float*)lds;
#pragma unroll
    for (int i = 0; i < 16; ++i) P[(wave * 16 + i) * 64 + lane] = acc[i];
    __syncthreads();
    if (tid < 128) {
        const int m = tid & 31, q4 = tid >> 5;
        f32x4 v0 = {0.f, 0.f, 0.f, 0.f}, v1 = {0.f, 0.f, 0.f, 0.f};
#pragma unroll
        for (int w = 0; w < 8; ++w)
#pragma unroll
            for (int j = 0; j < 4; ++j) { v0[j] += P[(w * 16 + 4 * q4 + j) * 64 + m]; v1[j] += P[(w * 16 + 4 * q4 + j) * 64 + 32 + m]; }
        const int row = MP + 32 * mt + m, col = 32 * nt + 8 * q4;
        const float r = e.needs_rstd() ? e.row_rstd(row) : 1.0f;
        const float ss = e.epi8(row, col, v0, v1, r, e.res_base(row));
        if ((e.mode == pg8::EP_RES || e.mode == pg8::EP_PLE) && e.rs_out) unsafeAtomicAdd(e.rs_out + row, ss);
    }
    __syncthreads();
}

enum { SUB_Z = 0, SUB_POSTZ = 1, SUB_MIX = 2, SUB_COMB = 3, SUB_BR = 4, SUB_WO = 5, SUB_GU = 6, SUB_DN = 7, SUB_PLE = 8, NSUB = 9 };
constexpr int N_PHASES = 1 + 2 * NSUB;
__device__ __forceinline__ int n_passes(int sub) { return sub == SUB_BR ? 4 : (sub == SUB_PLE ? 2 : 1); }
__device__ __forceinline__ void make_pass(ArgsP a, int l, int sub, int p, pg8::Gemm& g, pg8::Epi& e) {
    unsigned char* ws = a->ws; unsigned char* wl = ws + WS_W + (size_t)l * WL;
    float* rs = (float*)(ws + WS_CTL);
    bf16_t* xb = (bf16_t*)(ws + WS_XB); bf16_t* xb2 = (bf16_t*)(ws + WS_XB2); float* xres = (float*)(ws + WS_XRES); bf16_t* z = (bf16_t*)(ws + WS_Z);
    e.mode = 0; e.rowss = nullptr; e.ob = nullptr; e.ldb = 0; e.of = nullptr; e.rin_p = nullptr; e.rin_s = nullptr; e.rin_b = nullptr; e.rs_out = nullptr; e.gate8 = nullptr; e.pl = nullptr; e.mg = nullptr;
    g.M = (sub == SUB_Z || sub == SUB_GU) ? M : MP;
    if (sub == SUB_Z) {
        g.A = xb; g.Bt = (const bf16_t*)(wl + W_IN); g.N = NZ; g.K = D;
        e.mode = pg8::EP_Z; e.rowss = rs + (l == 0 ? RS_MIX0 : RS_MIX1) * RS_STRIDE; e.ob = z; e.ldb = ZP; e.gate8 = ws + WS_ZG8;
    } else if (sub == SUB_BR) {
        g.N = D;
        if (p == 0) { g.A = (const bf16_t*)(ws + WS_ACTA); g.Bt = (const bf16_t*)(wl + W_A); g.K = 384; e.mode = pg8::EP_BR_FIRST; }
        else if (p == 1) { g.A = (const bf16_t*)(ws + WS_ACTB); g.Bt = (const bf16_t*)(wl + W_B); g.K = 256; e.mode = pg8::EP_BR_MID; }
        else if (p == 2) { g.A = (const bf16_t*)(ws + WS_ACTC); g.Bt = (const bf16_t*)(wl + W_C); g.K = 384; e.mode = pg8::EP_BR_MID; }
        else { g.A = (const bf16_t*)(ws + WS_ACTD); g.Bt = (const bf16_t*)(wl + W_D); g.K = 384; e.mode = pg8::EP_BR_LAST; }
        e.gate8 = ws + WS_ZG8 + p * 1024; e.mg = (float*)(ws + WS_MG); e.ob = (bf16_t*)(ws + WS_MGB); e.ldb = D;
    } else if (sub == SUB_WO) {
        g.A = (const bf16_t*)(ws + WS_MGB); g.Bt = (const bf16_t*)(wl + W_O); g.N = D; g.K = D;
        e.mode = pg8::EP_RES; e.ob = xb2; e.ldb = D; e.rs_out = rs + (l == 0 ? RS_FFN0 : RS_FFN1) * RS_STRIDE;
        if (l == 0) { e.rin_p = a->in[IN_XP]; e.rin_s = a->in[IN_XS]; } else e.rin_b = xb;
    } else if (sub == SUB_GU) {
        g.A = xb2; g.Bt = (const bf16_t*)(wl + W_GU); g.N = 2 * DFF; g.K = D;
        e.mode = pg8::EP_GLU; e.rowss = rs + (l == 0 ? RS_FFN0 : RS_FFN1) * RS_STRIDE; e.ob = (bf16_t*)(ws + WS_HFF); e.ldb = DFF;
    } else if (sub == SUB_DN) {
        g.A = (const bf16_t*)(ws + WS_HFF); g.Bt = (const bf16_t*)(wl + W_DN); g.N = D; g.K = DFF;
        e.mode = pg8::EP_RES; e.ob = xb2; e.ldb = D; e.rs_out = rs + (l == 0 ? RS_PLE0 : RS_PLE1) * RS_STRIDE;
        e.rin_b = xb2;
    } else {
        g.N = D;
        if (p == 0) { g.A = (const bf16_t*)(ws + WS_PEB) + (size_t)l * M * DPLE; g.Bt = (const bf16_t*)(wl + W_PLE); g.K = DPLE; e.mode = pg8::EP_PL; e.ob = (bf16_t*)(ws + WS_PL); e.ldb = D; }
        else {
            g.A = xb2; g.Bt = (const bf16_t*)(wl + W_PG); g.K = D;
            e.mode = pg8::EP_PLE; e.rowss = rs + (l == 0 ? RS_PLE0 : RS_PLE1) * RS_STRIDE; e.pl = (const bf16_t*)(ws + WS_PL);
            e.rin_b = xb2;
            if (l == 0) { e.ob = xb; e.ldb = D; e.rs_out = rs + RS_MIX1 * RS_STRIDE; }
            else { e.of = a->out + O_YP; e.ob = nullptr; e.ldb = D; e.rs_out = nullptr; }
        }
    }
}


#ifndef MK_XCD_BARRIER
#define MK_XCD_BARRIER 1
#endif
constexpr int CW_BAR = 131072;
constexpr int LDS_BARST_OFF = LDS_BYTES - 64;
static_assert((CW_BAR + 3456) * 4 <= (int)CTL_ZERO_BYTES, "barrier words inside the memset region");
#define XB_TMO      128
#define XB_XCNT(j)  (256  + 64 * (j))
#define XB_XSUB(j)  (1280 + 64 * (j))
#define XB_XGEN(j)  (2304 + 64 * (j))
#define XB_TOP      3328
#define XB_TOPGEN   3392
#define XCD_BAR_WORDS 3456
#define XB_SPIN_CAP (1u << 18)

__device__ __forceinline__ unsigned xb_ld(unsigned* p)              { return __hip_atomic_load(p, __ATOMIC_RELAXED, __HIP_MEMORY_SCOPE_AGENT); }
__device__ __forceinline__ unsigned xb_add(unsigned* p, unsigned v) { return __hip_atomic_fetch_add(p, v, __ATOMIC_RELAXED, __HIP_MEMORY_SCOPE_AGENT); }
__device__ __forceinline__ unsigned xb_xcc_id() { return (unsigned)__builtin_amdgcn_s_getreg((3 << 11) | 20) & 0xFu; }
#define XB_SPIN(cond, bar) do { unsigned _sp = 0; while (cond) { __builtin_amdgcn_s_sleep(1); \
    if ((++_sp & 255u) == 0u) { if (xb_ld(&(bar)[XB_TMO])) break; if (_sp > XB_SPIN_CAP) { atomicAdd(&(bar)[XB_TMO], 1u); break; } } } } while (0)

struct XcdBarrier {
    unsigned* bar; unsigned x;
    volatile LAS unsigned* st;
};

__device__ __forceinline__ XcdBarrier xcd_barrier_post(unsigned* bar, volatile LAS unsigned* st) {
    XcdBarrier b; b.bar = bar; b.x = xb_xcc_id(); b.st = st;
    if (threadIdx.x == 0) (void)xb_add(&bar[XB_XCNT(b.x)], 1u);
    return b;
}
__device__ __forceinline__ void xcd_barrier_complete(unsigned* bar, unsigned x, unsigned& nloc, unsigned& nx) {
    const unsigned G = gridDim.x * gridDim.y * gridDim.z;
    unsigned sum, cnt, mine, sp = 0u;
    for (;;) {
        sum = 0u; cnt = 0u; mine = 0u;
#pragma unroll
        for (unsigned j = 0; j < 16; ++j) { const unsigned c = xb_ld(&bar[XB_XCNT(j)]); sum += c; cnt += (c > 0u) ? 1u : 0u; mine = (j == x) ? c : mine; }
        if (sum == G) break;
        __builtin_amdgcn_s_sleep(1);
        if ((++sp & 255u) == 0u) { if (xb_ld(&bar[XB_TMO])) break; if (sp > XB_SPIN_CAP) { atomicAdd(&bar[XB_TMO], 1u); break; } }
    }
    nloc = mine > 0u ? mine : 1u; nx = cnt > 0u ? cnt : 1u;
}

__device__ __forceinline__ void xcd_barrier(const XcdBarrier& b) {
    asm volatile("s_waitcnt vmcnt(0)" ::: "memory");
    __syncthreads();
    if (threadIdx.x == 0) {
        unsigned* bar = b.bar;
        __builtin_amdgcn_s_waitcnt(0);
        unsigned nloc = b.st[0], nx = b.st[1];
        if (nloc == 0u) { xcd_barrier_complete(bar, b.x, nloc, nx); b.st[0] = nloc; b.st[1] = nx; }
        const unsigned old = xb_add(&bar[XB_XSUB(b.x)], 1u);
        const unsigned gen = old / nloc;
        if (old + 1u == (gen + 1u) * nloc) {
            __builtin_amdgcn_fence(__ATOMIC_RELEASE, "agent");
            asm volatile("s_waitcnt vmcnt(0)" ::: "memory");
            const unsigned og = xb_add(&bar[XB_TOP], 1u);
            const unsigned tg = og / nx;
            if (og + 1u == (tg + 1u) * nx) xb_add(&bar[XB_TOPGEN], 1u);
            else XB_SPIN(xb_ld(&bar[XB_TOPGEN]) == tg, bar);
            __builtin_amdgcn_fence(__ATOMIC_ACQUIRE, "agent");
            xb_add(&bar[XB_XGEN(b.x)], 1u);
            asm volatile("s_waitcnt vmcnt(0)" ::: "memory");
        } else {
            XB_SPIN(xb_ld(&bar[XB_XGEN(b.x)]) == gen, bar);
            __builtin_amdgcn_fence(__ATOMIC_ACQUIRE, "agent");
            asm volatile("s_waitcnt vmcnt(0)" ::: "memory");
        }
    }
    __syncthreads();
}


constexpr int Z0_SPLIT_ROUNDS = 8;
#ifndef WGM_WIDE
#define WGM_WIDE 2
#define WGM_NARROW 8
#endif
__device__ __forceinline__ int phase_reps(int ph, int sub) {
    return ph == 0 ? REP_P0 : sub == SUB_Z ? REP_Z : sub == SUB_POSTZ ? REP_POSTZ : sub == SUB_MIX ? REP_MIX : sub == SUB_COMB ? REP_COMB : sub == SUB_BR ? REP_BR : sub == SUB_GU ? REP_GU : 1;
}
__global__ void __launch_bounds__(512, 2) mega_fwd(Args a) {
    extern __shared__ __attribute__((aligned(16))) unsigned char lds_raw[];
    LAS unsigned char* lds = (LAS unsigned char*)lds_raw;
    const int G = gridDim.x, bid = blockIdx.x;
    const int ph_lo = a.ph_lo, ph_hi = a.ph_hi;
#if MK_XCD_BARRIER
    if (threadIdx.x < 2) ((volatile LAS unsigned*)(lds + LDS_BARST_OFF))[threadIdx.x] = 0u;
    __syncthreads();
    (void)xcd_barrier_post((unsigned*)(((ArgsP)__builtin_amdgcn_kernarg_segment_ptr())->ws + WS_CTL) + CW_BAR, (volatile LAS unsigned*)(lds + LDS_BARST_OFF));
#else
    cg::grid_group grid = cg::this_grid();
#endif
    for (int ph = ph_lo; ph < ph_hi; ++ph) {
#if MK_XCD_BARRIER
        if (ph > ph_lo) {
            XcdBarrier xb; xb.bar = (unsigned*)(((ArgsP)__builtin_amdgcn_kernarg_segment_ptr())->ws + WS_CTL) + CW_BAR; xb.x = xb_xcc_id(); xb.st = (volatile LAS unsigned*)(lds + LDS_BARST_OFF);
            xcd_barrier(xb);
        }
#else
        if (ph > ph_lo) grid.sync();
#endif
        ArgsP ap = (ArgsP)__builtin_amdgcn_kernarg_segment_ptr(); asm volatile("" : "+s"(ap));
        int tid = threadIdx.x; asm volatile("" : "+v"(tid));
        const int lane = tid & 63, wave = __builtin_amdgcn_readfirstlane(tid >> 6);
        if (ph == 0 || (ph == 1 && G == 256 && bid >= 128)) {
            p0_prologue(ap, lds, tid, lane, wave, ph == 0 ? G : 128, ph == 0 ? bid : bid - 128, ph == 0 ? (G == 256 ? 0 : 2) : 1, ph == 1);
            if (ph == 0) continue;
            __syncthreads();
        }
        const int l = (ph - 1) / NSUB, sub = (ph - 1) - l * NSUB;
        if (sub == SUB_POSTZ) {
            for (int rep = 0; rep < REP_POSTZ; ++rep) {
                for (int t8 = bid * 8 + wave; t8 < MP / 8; t8 += G * 8) postz_rows8(ap, l, t8 * 8, lane);
                for (int m = MP + bid * 8 + wave; m < M; m += G * 8) { const PzRow R = postz_load(ap, m, lane); __builtin_amdgcn_sched_barrier(0); (void)postz_row(ap, l, m, lane, R); }
            }
            continue;
        }
        if (sub == SUB_MIX) { p3_mixer(ap, lds, l, tid, lane, wave, G, bid); __syncthreads(); continue; }
        if (sub == SUB_COMB) { for (int rep = 0; rep < REP_COMB; ++rep) {
                int m = bid * 8 + wave; if (m >= M) continue;
                CbRow cur = combine_load(ap, m, lane);
                for (; m < M; m += G * 8) { const int mn = m + G * 8; CbRow nxt = cur; if (mn < M) nxt = combine_load(ap, mn, lane); __builtin_amdgcn_sched_barrier(0); combine_row(ap, m, lane, cur); cur = nxt; }
            } continue; }
        const int np = n_passes(sub);
        const int nrep = phase_reps(ph, sub) + ((DRY_SUB >= 0 && sub == DRY_SUB) ? 1 : 0);
        const int nmain = (sub == SUB_BR ? 1 : np) * nrep;
        for (int pp = 0; pp < nmain; ++pp) {
            const int p = (sub == SUB_BR) ? 0 : pp % np;
            pg8::Gemm g; pg8::Epi e; pg8::SegSched S;
            make_pass(ap, l, sub, p, g, e);
#if DRY_SUB >= 0
            if (sub == DRY_SUB && pp < np) {
                if (e.ob) e.ob = (bf16_t*)(ap->ws + WS_XRES); if (e.of) e.of = (float*)(ap->ws + WS_MG); if (e.rs_out) e.rs_out = (float*)(ap->ws + WS_CTL) + 6 * RS_STRIDE;
            }
#endif
            S.nseg = 1; S.A0 = g.A; S.B0 = g.Bt; S.K0 = g.K; S.ws = ap->ws; S.wl = ap->ws + WS_W + (size_t)l * WL;
            if (sub == SUB_BR) { S.nseg = 4; e.mode = pg8::EP_BRC; }
            S.so.init(g.M, g.N, G, bid, (g.N > D) ? WGM_WIDE : WGM_NARROW);
            S.split_rounds = 0;
            if (G == 256 && sub == SUB_Z && l == 0 && pp == 0) {
                S.split_rounds = Z0_SPLIT_ROUNDS;
            }
            if (G == 256 && (sub == SUB_Z || sub == SUB_GU) && pp == 0 && !(sub == SUB_Z && l == 0)) {
                const int nwg = (g.M / 256) * (g.N / 256), rem = nwg - (nwg / G) * G;
                if (bid >= rem) {
                    const int k = bid - rem, Q = (sub == SUB_Z) ? STAG_Q_Z : STAG_Q_GU;
                    const int base = ((sub == SUB_GU) ? STAG_TOT_Z : 0) + l * (STAG_TOT_Z + STAG_TOT_GU);
                    const int lo = base + Q * (k * (k - 1) / 2);
                    cache_copy_range(ap, lo, lo + Q * k, tid, 512);
                }
            }
            const bool has_small = (sub != SUB_BR && g.M == MP);
            const bool small_first = has_small && ((bid >> 3) & 1);
#pragma unroll 1
            for (int step = 0; step < 2; ++step) {
                if ((step == 0) != small_first) pg8::gemm_phase<pg8::Epi, pg8::SegSched, true>(lds, S, e, tid);
                else if (has_small) { for (int tile = bid; tile < 256; tile += G) small_gemm_tile(lds, g, e, tile >> 5, tile & 31, tid, lane, wave); }
            }
        }
        if (sub == SUB_BR) {
            for (int pp = 0; pp < 4 * nrep; ++pp) {
                pg8::Gemm g; pg8::Epi e; make_pass(ap, l, sub, pp & 3, g, e);
                for (int tile = bid; tile < 256; tile += G) small_gemm_tile(lds, g, e, tile >> 5, tile & 31, tid, lane, wave);
            }
        }
    }
}

extern "C" void kernel_launch(void* const* d_in, const int* in_sizes, int n_in, void* d_out, int out_size, void* d_ws, size_t ws_size, hipStream_t stream) {
    static int grid = 0;
    if (grid == 0) {
        if (n_in != 36 || (size_t)out_size != O_END || ws_size < WS_END) { fprintf(stderr, "kernel_launch: unexpected shapes: n_in %d out %d ws %zu (need %zu)\n", n_in, out_size, ws_size, (size_t)WS_END); grid = -1; return; }
        int dev = 0, cus = 0, per_cu = 0;
        if (hipGetDevice(&dev) != hipSuccess || hipDeviceGetAttribute(&cus, hipDeviceAttributeMultiprocessorCount, dev) != hipSuccess) { grid = -1; return; }
        if (hipFuncSetAttribute((const void*)mega_fwd, hipFuncAttributeMaxDynamicSharedMemorySize, LDS_BYTES) != hipSuccess) { fprintf(stderr, "kernel_launch: hipFuncSetAttribute failed\n"); grid = -1; return; }
        if (hipOccupancyMaxActiveBlocksPerMultiprocessor(&per_cu, (const void*)mega_fwd, 512, LDS_BYTES) != hipSuccess || per_cu < 1) { fprintf(stderr, "kernel_launch: occupancy query says %d blocks per CU\n", per_cu); per_cu = 1; }
        (void)hipGetLastError();
        grid = cus;
    }
    if (grid < 0) return;
    (void)hipMemsetAsync((char*)d_ws + WS_CTL, 0, CTL_ZERO_BYTES, stream);
    Args a{};
    for (int i = 0; i < 36; ++i) a.in[i] = (const float*)d_in[i];
    a.out = (float*)d_out; a.ws = (unsigned char*)d_ws;
#if MK_ONE_LAUNCH
    a.ph_lo = 0; a.ph_hi = N_PHASES;
    void* args[] = {&a};
    hipError_t e = hipLaunchCooperativeKernel((const void*)mega_fwd, dim3(grid), dim3(512), args, LDS_BYTES, stream);
    if (e != hipSuccess) fprintf(stderr, "cooperative launch failed: %s (grid %d)\n", hipGetErrorString(e), grid);
#else
    for (int ph = 0; ph < N_PHASES; ++ph) {
        a.ph_lo = ph; a.ph_hi = ph + 1;
        hipLaunchKernelGGL(mega_fwd, dim3(grid), dim3(512), LDS_BYTES, stream, a);
    }
#endif
}
```

```cpp
#include <hip/hip_runtime.h>
#include <hip/hip_cooperative_groups.h>
#include <cstdio>
#include <cstdint>
namespace cg = cooperative_groups;

#ifndef MK_ONE_LAUNCH
#define MK_ONE_LAUNCH 1
#endif

#ifndef REP_P0
#define REP_P0 1
#endif
#ifndef DRY_SUB
#define DRY_SUB -1
#endif
#ifndef P0R_T
#define P0R_T 1
#define P0R_X 1
#define P0R_C 1
#endif
#ifndef REP_Z
#define REP_Z 1
#endif
#ifndef REP_POSTZ
#define REP_POSTZ 1
#endif
#ifndef REP_MIX
#define REP_MIX 1
#endif
#ifndef REP_COMB
#define REP_COMB 1
#endif
#ifndef REP_BR
#define REP_BR 1
#endif
#ifndef REP_GU
#define REP_GU 1
#endif
constexpr int D = 1024, TP = 16384, NSEQ = 32, TS = 8, MP = TP, MS = NSEQ * TS, M = MP + MS;
constexpr int DC = 384, NH = 12, HD = 64, DQ = NH * HD, DFF = 2816, DPLE = 256, DIN = 8320, NZ = 8448, ZP = 4352;
constexpr int ZA = 0, ZB = 384, ZQ = 768, ZK = 1536, ZV = 2304, ZU = 3072, ZVV = 3456, ZD = 3840, ZG = 4224;
constexpr float EPS = 1e-6f, LN_EPS = 1e-5f;
constexpr float LOG2E = 1.4426950408889634f, LN2 = 0.6931471805599453f, ATT_C2 = 12.0f;

constexpr size_t O_YP = 0, O_YS = O_YP + (size_t)MP * D, O_KVP0 = O_YS + (size_t)MS * D,
    O_KVP1 = O_KVP0 + 2ull * 128 * 512, O_KVP2 = O_KVP1 + 2ull * 512 * 512, O_CONVP = O_KVP2 + 2ull * 2048 * 512,
    O_POOLP = O_CONVP + 2ull * 30 * 384, O_KVS0 = O_POOLP + 2ull * 15 * 384, O_KVS1 = O_KVS0 + 2ull * 32 * 128 * 512,
    O_KVS2 = O_KVS1 + 2ull * 32 * 512 * 512, O_CONVS = O_KVS2 + 2ull * 32 * 2048 * 512, O_POOLS = O_CONVS + 2ull * 32 * 30 * 384,
    O_SGUS = O_POOLS + 2ull * 32 * 15 * 384, O_END = O_SGUS + 2ull * 32 * 8 * 384;
static_assert(O_END == 109209344ull, "output size");

constexpr size_t MiB = 1u << 20;
constexpr size_t WS_CTL = 0, CTL_ZERO_BYTES = 1 * MiB;
constexpr size_t WS_W = 2 * MiB, WL = 44 * MiB;
constexpr size_t W_IN = 0, W_A = 17 * MiB, W_B = 18 * MiB, W_C = 19 * MiB, W_D = 20 * MiB, W_O = 21 * MiB, W_GU = 23 * MiB, W_DN = 34 * MiB, W_PG = 40 * MiB, W_PLE = 42 * MiB;
constexpr size_t WS_XB = 90 * MiB;
constexpr size_t WS_XRES = 123 * MiB;
constexpr size_t WS_Z = 188 * MiB;
constexpr size_t WS_ZG8 = 340 * MiB;
static_assert(WS_Z + (size_t)M * ZP * 2 <= WS_ZG8 && WS_ZG8 + (size_t)M * 4096 <= 457 * MiB, "ws map z");
constexpr size_t WS_PEB = 457 * MiB;
constexpr size_t WS_GLU = 474 * MiB;
constexpr size_t WS_QN = 487 * MiB;
constexpr size_t WS_KN = 512 * MiB;
constexpr size_t WS_VLN = 537 * MiB;
constexpr size_t WS_ACTA = 550 * MiB, WS_ACTB = 563 * MiB, WS_ACTC = 572 * MiB, WS_ACTD = 585 * MiB;
constexpr size_t WS_MG = 598 * MiB;
constexpr size_t WS_MGB = 663 * MiB;
constexpr size_t WS_HFF = 696 * MiB;
constexpr size_t WS_PL = 786 * MiB;
constexpr size_t WS_OPART = 852 * MiB;
constexpr size_t WS_LSE = 877 * MiB;
constexpr size_t WS_XB2 = 879 * MiB;
constexpr size_t WS_SGUW = 912 * MiB;
constexpr size_t WS_END = 913 * MiB;
static_assert(WS_XB2 + (size_t)M * D * 2 <= WS_SGUW && WS_SGUW + 2ull * 4 * 128 * 128 * 2 <= WS_END, "ws map 6");
static_assert(WS_OPART + (size_t)M * DQ * 2 <= WS_LSE && WS_LSE + (size_t)M * 12 * 4 <= WS_XB2, "ws map 5");
static_assert(W_IN + (size_t)NZ * D * 2 <= W_A && W_GU + 2ull * DFF * D * 2 <= W_DN && W_DN + (size_t)D * DFF * 2 <= W_PG && W_PLE + (size_t)D * DPLE * 2 <= WL, "weight map");
static_assert(WS_W + 2 * WL <= WS_XB && WS_XB + (size_t)M * D * 2 <= WS_XRES && WS_XRES + (size_t)M * D * 4 <= WS_Z && WS_Z + (size_t)M * ZP * 2 <= WS_PEB, "ws map 1");
static_assert(WS_PEB + 2ull * M * DPLE * 2 <= WS_GLU && WS_GLU + (size_t)M * 384 * 2 <= WS_QN && WS_QN + (size_t)M * DQ * 2 <= WS_KN && WS_KN + (size_t)M * DQ * 2 <= WS_VLN, "ws map 2");
static_assert(WS_VLN + (size_t)M * 384 * 2 <= WS_ACTA && WS_ACTA + (size_t)M * 384 * 2 <= WS_ACTB && WS_ACTB + (size_t)M * 256 * 2 <= WS_ACTC && WS_ACTC + (size_t)M * 384 * 2 <= WS_ACTD, "ws map 3");
static_assert(WS_ACTD + (size_t)M * 384 * 2 <= WS_MG && WS_MG + (size_t)M * D * 4 <= WS_MGB && WS_MGB + (size_t)M * D * 2 <= WS_HFF && WS_HFF + (size_t)M * DFF * 2 <= WS_PL && WS_PL + (size_t)M * D * 4 <= WS_OPART, "ws map 4");
constexpr int RS_STRIDE = 16896;
constexpr int RS_MIX0 = 0, RS_FFN0 = 1, RS_PLE0 = 2, RS_MIX1 = 3, RS_FFN1 = 4, RS_PLE1 = 5;
static_assert(6ull * RS_STRIDE * 4 <= CTL_ZERO_BYTES, "ctl");

constexpr int RING_BYTES = 131072, LDS_BYTES = 147456;

#define LAS __attribute__((address_space(3)))
typedef unsigned short bf16_t;
typedef short bf16x8 __attribute__((ext_vector_type(8)));
typedef float f32x4 __attribute__((ext_vector_type(4)));
typedef float f32x16 __attribute__((ext_vector_type(16)));
typedef float f32x2 __attribute__((ext_vector_type(2)));
typedef unsigned u32x4 __attribute__((ext_vector_type(4)));
typedef unsigned u32x2 __attribute__((ext_vector_type(2)));

__device__ __forceinline__ unsigned cvt_pk_bf16(float lo, float hi) { unsigned r; asm("v_cvt_pk_bf16_f32 %0, %1, %2" : "=v"(r) : "v"(lo), "v"(hi)); return r; }
__device__ __forceinline__ float bf_lo(unsigned w) { return __uint_as_float(w << 16); }
__device__ __forceinline__ float bf_hi(unsigned w) { return __uint_as_float(w & 0xffff0000u); }
__device__ __forceinline__ void unpack8(const u32x4 w, float (&f)[8]) { f[0] = bf_lo(w.x); f[1] = bf_hi(w.x); f[2] = bf_lo(w.y); f[3] = bf_hi(w.y); f[4] = bf_lo(w.z); f[5] = bf_hi(w.z); f[6] = bf_lo(w.w); f[7] = bf_hi(w.w); }
__device__ __forceinline__ u32x4 pack8(const float (&f)[8]) { u32x4 w; w.x = cvt_pk_bf16(f[0], f[1]); w.y = cvt_pk_bf16(f[2], f[3]); w.z = cvt_pk_bf16(f[4], f[5]); w.w = cvt_pk_bf16(f[6], f[7]); return w; }
__device__ __forceinline__ float bf1(bf16_t b) { return __uint_as_float((unsigned)b << 16); }
__device__ __forceinline__ float sigmoidf_(float x) { return __builtin_amdgcn_rcpf(1.0f + __expf(-x)); }
__device__ __forceinline__ float wave_sum(float v) {
#pragma unroll
    for (int o = 1; o < 64; o <<= 1) v += __shfl_xor(v, o);
    return v;
}

namespace pg8 {
#define PG8_LAS __attribute__((address_space(3)))
typedef unsigned short bf16_t;
typedef short bf16x8 __attribute__((ext_vector_type(8)));
typedef float f32x4 __attribute__((ext_vector_type(4)));
typedef unsigned u32x4 __attribute__((ext_vector_type(4)));
constexpr int BM = 256, BK = 64, HALF = 128, HTB = HALF * BK * 2  , STAGE_BYTES = 8 * HTB, NXCD = 8, WGM = 8;

__host__ __device__ __forceinline__ int lds_byte(int r, int c) { const int st = (r >> 4) * 2 + (c >> 5), rr = r & 15, cc = c & 31, ob = rr * 64 + cc * 2; return st * 1024 + (ob ^ (((ob >> 9) & 1) << 5)); }
__host__ __device__ __forceinline__ void stage_rc(int b, int& R, int& C) { const int st = b / 1024, sb = b % 1024, swz = sb ^ (((sb >> 9) & 1) << 5); R = (st >> 1) * 16 + swz / 64; C = (st & 1) * 32 + (swz % 64) / 2; }
__host__ __device__ __forceinline__ int perm32(int rho) { const int n = rho >> 4, i = rho & 15; return 8 * (i >> 2) + 4 * n + (i & 3); }

struct Unit { int pm, pn; };
struct Gemm { const bf16_t* A; const bf16_t* Bt; int M, N, K; };

struct StaticOrder {
    int nM, nN, nwg, G, c, wgm;
    __host__ __device__ __forceinline__ void init(int M, int N, int G_, int c_, int wgm_) { nM = M / BM; nN = N / BM; nwg = nM * nN; G = G_; c = c_; wgm = wgm_; }
    __host__ __device__ __forceinline__ bool next(int i, Unit& u) const { return next_at((long)i * G + c, u); }
    __host__ __device__ __forceinline__ bool next_at(long L, Unit& u) const {
        if (L >= nwg) return false;
        int wgid = (int)L; { const int q = nwg / NXCD, r = nwg % NXCD, xcd = wgid % NXCD, off = wgid / NXCD; wgid = (xcd < r ? xcd * (q + 1) : r * (q + 1) + (xcd - r) * q) + off; }
        const int nig = wgm * nN, gid = wgid / nig, fm = gid * wgm, gsz = (nM - fm) < wgm ? (nM - fm) : wgm;
        u.pm = fm + ((wgid % nig) % gsz); u.pn = (wgid % nig) / gsz; return true;
    }
    __device__ __forceinline__ void a_ready(const Unit&) const {}
    __device__ __forceinline__ void done(const Unit&) const {}
};


enum EpiMode { EP_Z = 0, EP_BR_FIRST = 1, EP_BR_MID = 2, EP_BR_LAST = 3, EP_RES = 4, EP_GLU = 5, EP_PL = 6, EP_PLE = 7, EP_BRC = 8 };
struct UnitX;
__device__ __forceinline__ void unpackg8(const u32x2 w, float (&g)[8]) {
#pragma unroll
    for (int j = 0; j < 4; ++j) { g[j] = (float)((w.x >> (8 * j)) & 0xffu) + 0.5f; g[4 + j] = (float)((w.y >> (8 * j)) & 0xffu) + 0.5f; }
}
struct Epi {
    static constexpr bool PERM = true, AFTER_DRAIN = false;
    int mode;
    const float* rowss;
    bf16_t* ob; int ldb;
    float* of;
    const float* rin_p; const float* rin_s;
    const bf16_t* rin_b;
    float* rs_out;
    unsigned char* gate8;
    const bf16_t* pl;
    float* mg;
    __device__ __forceinline__ bool needs_rstd() const { return mode == EP_Z || mode == EP_PLE || mode == EP_GLU; }
    __device__ __forceinline__ float row_rstd(int row) const { return rsqrtf(rowss[row] * (1.0f / 1024.0f) + EPS); }
    __device__ __forceinline__ const float* res_base(int row) const { return (row < MP) ? rin_p : (rin_s - (size_t)MP * 1024); }
    __device__ __forceinline__ float epi8(int row, int col, f32x4 v0, f32x4 v1, float r, const float* rbase) const {
        float ss = 0.f;
        if (mode == EP_Z) {
            v0 *= r; v1 *= r;
            if (col < ZG) {
                u32x4 w; w.x = cvt_pk_bf16(v0[0], v0[1]); w.y = cvt_pk_bf16(v0[2], v0[3]); w.z = cvt_pk_bf16(v1[0], v1[1]); w.w = cvt_pk_bf16(v1[2], v1[3]);
                *(u32x4*)(ob + (size_t)row * ldb + col) = w;
            } else if (col < DIN) {
                unsigned q[8];
#pragma unroll
                for (int j = 0; j < 4; ++j) { q[j] = (unsigned)(sigmoidf_(v0[j]) * 256.0f); q[4 + j] = (unsigned)(sigmoidf_(v1[j]) * 256.0f); }
#pragma unroll
                for (int j = 0; j < 8; ++j) q[j] = q[j] > 255u ? 255u : q[j];
                u32x2 w; w.x = q[0] | (q[1] << 8) | (q[2] << 16) | (q[3] << 24); w.y = q[4] | (q[5] << 8) | (q[6] << 16) | (q[7] << 24);
                *(u32x2*)(gate8 + (size_t)row * 4096 + (col - ZG)) = w;
            }
        } else if (mode == EP_BR_FIRST || mode == EP_BR_MID || mode == EP_BR_LAST) {
            float g[8]; unpackg8(*(const u32x2*)(gate8 + (size_t)row * 4096 + col), g);
#pragma unroll
            for (int j = 0; j < 8; ++j) g[j] *= (1.0f / 256.0f);
            v0[0] *= g[0]; v0[1] *= g[1]; v0[2] *= g[2]; v0[3] *= g[3];
            v1[0] *= g[4]; v1[1] *= g[5]; v1[2] *= g[6]; v1[3] *= g[7];
            float* mp = mg + (size_t)row * 1024 + col;
            if (mode != EP_BR_FIRST) { v0 += *(const f32x4*)mp; v1 += *(const f32x4*)(mp + 4); }
            if (mode != EP_BR_LAST) { *(f32x4*)mp = v0; *(f32x4*)(mp + 4) = v1; }
            else {
                u32x4 w; w.x = cvt_pk_bf16(v0[0], v0[1]); w.y = cvt_pk_bf16(v0[2], v0[3]); w.z = cvt_pk_bf16(v1[0], v1[1]); w.w = cvt_pk_bf16(v1[2], v1[3]);
                *(u32x4*)(ob + (size_t)row * ldb + col) = w;
            }
        } else if (mode == EP_RES || mode == EP_PLE) {
            f32x4 x0, x1;
            if (rin_b) { float xr[8]; unpack8(*(const u32x4*)(rin_b + (size_t)row * 1024 + col), xr); x0 = (f32x4){xr[0], xr[1], xr[2], xr[3]}; x1 = (f32x4){xr[4], xr[5], xr[6], xr[7]}; }
            else { const float* rp = rbase + (size_t)row * 1024 + col; x0 = *(const f32x4*)rp; x1 = *(const f32x4*)(rp + 4); }
            if (mode == EP_PLE) {
                float p[8]; unpack8(*(const u32x4*)(pl + (size_t)row * 1024 + col), p);
                v0[0] = p[0] * sigmoidf_(v0[0] * r); v0[1] = p[1] * sigmoidf_(v0[1] * r); v0[2] = p[2] * sigmoidf_(v0[2] * r); v0[3] = p[3] * sigmoidf_(v0[3] * r);
                v1[0] = p[4] * sigmoidf_(v1[0] * r); v1[1] = p[5] * sigmoidf_(v1[1] * r); v1[2] = p[6] * sigmoidf_(v1[2] * r); v1[3] = p[7] * sigmoidf_(v1[3] * r);
            }
            x0 += v0; x1 += v1;
            if (of) { float* op = of + (size_t)row * 1024 + col; *(f32x4*)op = x0; *(f32x4*)(op + 4) = x1; }
            if (ob) {
                u32x4 w; w.x = cvt_pk_bf16(x0[0], x0[1]); w.y = cvt_pk_bf16(x0[2], x0[3]); w.z = cvt_pk_bf16(x1[0], x1[1]); w.w = cvt_pk_bf16(x1[2], x1[3]);
                *(u32x4*)(ob + (size_t)row * ldb + col) = w;
            }
            ss = (x0[0] * x0[0] + x0[1] * x0[1]) + (x0[2] * x0[2] + x0[3] * x0[3]) + (x1[0] * x1[0] + x1[1] * x1[1]) + (x1[2] * x1[2] + x1[3] * x1[3]);
        } else {
            u32x4 w; w.x = cvt_pk_bf16(v0[0], v0[1]); w.y = cvt_pk_bf16(v0[2], v0[3]); w.z = cvt_pk_bf16(v1[0], v1[1]); w.w = cvt_pk_bf16(v1[2], v1[3]);
            *(u32x4*)(ob + (size_t)row * ldb + col) = w;
        }
        return ss;
    }
    template <class U>
    __device__ __forceinline__ void rescale(f32x4 (&acc)[2][2][4][2], const U& u, int wr, int wc, int fr, int fq) const {
        const int rowb = u.pm * BM + wr * 64 + fr;
        const int colb = u.pn * BM + wc * 32 + 8 * fq;
        const bool zero = u.zero_after;
        const unsigned char* gb = gate8 + u.seg * 1024;
#pragma unroll
        for (int ai = 0; ai < 2; ++ai)
#pragma unroll
            for (int m = 0; m < 4; ++m) {
                const int row = rowb + ai * HALF + m * 16;
#pragma unroll
                for (int bj = 0; bj < 2; ++bj) {
                    f32x4 r0 = {0.f, 0.f, 0.f, 0.f}, r1 = {0.f, 0.f, 0.f, 0.f};
                    if (!zero) {
                        const unsigned char* gp = gb + (size_t)row * 4096 + colb + bj * HALF;
                        float g0[8], g1[8]; unpackg8(*(const u32x2*)gp, g0); unpackg8(*(const u32x2*)(gp + 1024), g1);
#pragma unroll
                        for (int j = 0; j < 4; ++j) { r0[j] = g0[j] * __builtin_amdgcn_rcpf(g1[j]); r1[j] = g0[4 + j] * __builtin_amdgcn_rcpf(g1[4 + j]); }
                    }
                    acc[ai][bj][m][0] = acc[ai][bj][m][0] * r0; acc[ai][bj][m][1] = acc[ai][bj][m][1] * r1;
                }
            }
    }
    __device__ __forceinline__ void brc_store(const f32x4 (&acc)[2][2][4][2], int seg, int rowb, int colb) const {
        const unsigned char* gb = gate8 + seg * 1024 + colb;
        u32x2 cg[2];
#define BRS_LOAD(I, G) do { const unsigned char* _gp = gb + (size_t)(rowb + ((I) >> 2) * HALF + ((I) & 3) * 16) * 4096; (G)[0] = *(const u32x2*)_gp; (G)[1] = *(const u32x2*)(_gp + HALF); } while (0)
        BRS_LOAD(0, cg);
#pragma unroll
        for (int i = 0; i < 8; ++i) {
            u32x2 ng[2];
            if (i < 7) BRS_LOAD(i + 1, ng);
            const int ai = i >> 2, m = i & 3;
            const int row = rowb + ai * HALF + m * 16;
#pragma unroll
            for (int bj = 0; bj < 2; ++bj) {
                float g0[8]; unpackg8(cg[bj], g0);
#pragma unroll
                for (int j = 0; j < 8; ++j) g0[j] *= (1.0f / 256.0f);
                const f32x4 v0 = acc[ai][bj][m][0], v1 = acc[ai][bj][m][1];
                u32x4 w; w.x = cvt_pk_bf16(v0[0] * g0[0], v0[1] * g0[1]); w.y = cvt_pk_bf16(v0[2] * g0[2], v0[3] * g0[3]); w.z = cvt_pk_bf16(v1[0] * g0[4], v1[1] * g0[5]); w.w = cvt_pk_bf16(v1[2] * g0[6], v1[3] * g0[7]);
                *(u32x4*)(ob + (size_t)row * ldb + colb + bj * HALF) = w;
            }
            if (i < 7) { cg[0] = ng[0]; cg[1] = ng[1]; }
            asm volatile("" ::: "memory");
        }
#undef BRS_LOAD
    }
    template <bool BFRES, bool PLE>
    __device__ __forceinline__ void res_loop(const f32x4 (&acc)[2][2][4][2], int rowb, int colb, int fq, const float (&rs8)[8]) const {
        const float* rbase = res_base(rowb);
        const bool ssq = rs_out != nullptr;
        u32x4 cb[2], cp[2]; f32x4 cf[2][2];
#define RES_LOAD(I, B, F, P) do { const int _row = rowb + ((I) >> 2) * HALF + ((I) & 3) * 16; _Pragma("unroll") for (int _bj = 0; _bj < 2; ++_bj) { const size_t _o = (size_t)_row * 1024 + colb + _bj * HALF; \
            if constexpr (BFRES) (B)[_bj] = *(const u32x4*)(rin_b + _o); else { (F)[_bj][0] = *(const f32x4*)(rbase + _o); (F)[_bj][1] = *(const f32x4*)(rbase + _o + 4); } \
            if constexpr (PLE) (P)[_bj] = *(const u32x4*)(pl + _o); } } while (0)
        RES_LOAD(0, cb, cf, cp);
#pragma unroll
        for (int i = 0; i < 8; ++i) {
            u32x4 nb[2], np[2]; f32x4 nf[2][2];
            if (i < 7) RES_LOAD(i + 1, nb, nf, np);
            const int ai = i >> 2, m = i & 3;
            const int row = rowb + ai * HALF + m * 16;
            const float r = rs8[i];
            float ss = 0.f;
#pragma unroll
            for (int bj = 0; bj < 2; ++bj) {
                const int col = colb + bj * HALF;
                f32x4 x0, x1;
                if constexpr (BFRES) { float xr[8]; unpack8(cb[bj], xr); x0 = (f32x4){xr[0], xr[1], xr[2], xr[3]}; x1 = (f32x4){xr[4], xr[5], xr[6], xr[7]}; }
                else { x0 = cf[bj][0]; x1 = cf[bj][1]; }
                f32x4 v0 = acc[ai][bj][m][0], v1 = acc[ai][bj][m][1];
                if constexpr (PLE) {
                    float p[8]; unpack8(cp[bj], p);
                    v0[0] = p[0] * sigmoidf_(v0[0] * r); v0[1] = p[1] * sigmoidf_(v0[1] * r); v0[2] = p[2] * sigmoidf_(v0[2] * r); v0[3] = p[3] * sigmoidf_(v0[3] * r);
                    v1[0] = p[4] * sigmoidf_(v1[0] * r); v1[1] = p[5] * sigmoidf_(v1[1] * r); v1[2] = p[6] * sigmoidf_(v1[2] * r); v1[3] = p[7] * sigmoidf_(v1[3] * r);
                }
                x0 += v0; x1 += v1;
                if (of) { float* op = of + (size_t)row * 1024 + col; *(f32x4*)op = x0; *(f32x4*)(op + 4) = x1; }
                if (ob) {
                    u32x4 w; w.x = cvt_pk_bf16(x0[0], x0[1]); w.y = cvt_pk_bf16(x0[2], x0[3]); w.z = cvt_pk_bf16(x1[0], x1[1]); w.w = cvt_pk_bf16(x1[2], x1[3]);
                    *(u32x4*)(ob + (size_t)row * ldb + col) = w;
                }
                ss += (x0[0] * x0[0] + x0[1] * x0[1]) + (x0[2] * x0[2] + x0[3] * x0[3]) + (x1[0] * x1[0] + x1[1] * x1[1]) + (x1[2] * x1[2] + x1[3] * x1[3]);
            }
            if (ssq) { ss += __shfl_xor(ss, 16); ss += __shfl_xor(ss, 32); if (fq == 0) unsafeAtomicAdd(rs_out + row, ss); }
            if (i < 7) {
#pragma unroll
                for (int bj = 0; bj < 2; ++bj) { cb[bj] = nb[bj]; cp[bj] = np[bj]; cf[bj][0] = nf[bj][0]; cf[bj][1] = nf[bj][1]; }
            }
            asm volatile("" ::: "memory");
        }
#undef RES_LOAD
    }
    template <class U>
    __device__ __forceinline__ void operator()(const f32x4 (&acc)[2][2][4][2], const U& u, int wr, int wc, int fr, int fq) const {
        const int rowb = u.pm * BM + wr * 64 + fr;
        const int colb = u.pn * BM + wc * 32 + 8 * fq;
        if (mode == EP_BRC) { brc_store(acc, u.seg, rowb, colb); return; }
        float rs8[8];
        if (needs_rstd()) {
#pragma unroll
            for (int i = 0; i < 8; ++i) rs8[i] = rowss[rowb + (i >> 2) * HALF + (i & 3) * 16];
            __builtin_amdgcn_sched_barrier(0);
#pragma unroll
            for (int i = 0; i < 8; ++i) rs8[i] = rsqrtf(rs8[i] * (1.0f / 1024.0f) + EPS);
        } else {
#pragma unroll
            for (int i = 0; i < 8; ++i) rs8[i] = 1.0f;
        }
        if (mode == EP_GLU) {
            const int colh = u.pn * HALF + wc * 32 + 8 * fq;
#pragma unroll
            for (int ai = 0; ai < 2; ++ai)
#pragma unroll
                for (int m = 0; m < 4; ++m) {
                    const int row = rowb + ai * HALF + m * 16;
                    const float r = rs8[ai * 4 + m];
                    float h[8];
#pragma unroll
                    for (int n = 0; n < 2; ++n)
#pragma unroll
                        for (int j = 0; j < 4; ++j) { const float g = acc[ai][0][m][n][j] * r, uu = acc[ai][1][m][n][j] * r; h[4 * n + j] = g * sigmoidf_(g) * uu; }
                    *(u32x4*)(ob + (size_t)row * ldb + colh) = pack8(h);
                }
            return;
        }
        if (mode == EP_RES) { if (rin_b) res_loop<true, false>(acc, rowb, colb, fq, rs8); else res_loop<false, false>(acc, rowb, colb, fq, rs8); return; }
        if (mode == EP_PLE) { res_loop<true, true>(acc, rowb, colb, fq, rs8); return; }
#pragma unroll
        for (int ai = 0; ai < 2; ++ai)
#pragma unroll
            for (int m = 0; m < 4; ++m) {
                const int row = rowb + ai * HALF + m * 16;
#pragma unroll
                for (int bj = 0; bj < 2; ++bj) (void)epi8(row, colb + bj * HALF, acc[ai][bj][m][0], acc[ai][bj][m][1], rs8[ai * 4 + m], nullptr);
            }
    }
};


struct UnitX { int pm, pn; const bf16_t* A; const bf16_t* Bt; int K; int seg; bool zero_after; };
template <class Epi, class Sched, bool ALIGN_EPI = false>
__device__ __forceinline__ void gemm_phase(PG8_LAS unsigned char* lds, const Sched& S, const Epi& E, const int tid) {
    const int wid = __builtin_amdgcn_readfirstlane(tid >> 6), lane = tid & 63, wr = wid >> 2, wc = wid & 3, fr = lane & 15, fq = lane >> 4;
    const size_t kstep = (size_t)(BK * 2);
    const unsigned ldsw = (unsigned)wid * 1024u;
    const int aoff = lds_byte(wr * 64 + fr, fq * 8), boff = lds_byte(wc * 32 + fr, fq * 8);
#define PG8_SA(b, h) (((b) * 2 + (h)) * HTB)
#define PG8_SB(b, h) ((4 + (b) * 2 + (h)) * HTB)
#define PG8_STAGE(bufoff, gbase, voff) do { _Pragma("unroll") for (int _i = 0; _i < 2; ++_i) \
        __builtin_amdgcn_global_load_lds((const unsigned*)((const char*)(gbase) + (voff)[_i]), (PG8_LAS unsigned*)(lds + (bufoff) + ldsw + _i * 8192), 16, 0, 0); } while (0)
#define PG8_VOFF(KK, vA, vB) do { int _t = tid; asm volatile("" : "+v"(_t)); _Pragma("unroll") for (int _i = 0; _i < 2; ++_i) { int _R, _C; stage_rc(_t * 16 + _i * 8192, _R, _C); \
        const int _Rb = Epi::PERM ? ((_R & ~31) + perm32(_R & 31)) : _R; (vA)[_i] = (unsigned)(_R * (KK) + _C) * 2u; (vB)[_i] = (unsigned)(_Rb * (KK) + _C) * 2u; } } while (0)
#define PG8_LDA(dst, b, h) do { _Pragma("unroll") for (int m = 0; m < 4; ++m) _Pragma("unroll") for (int k = 0; k < 2; ++k) dst[m][k] = *(const PG8_LAS bf16x8*)(lds + PG8_SA(b, h) + aoff + m * 2048 + k * 1024); } while (0)
#define PG8_LDB(dst, b, h) do { _Pragma("unroll") for (int n = 0; n < 2; ++n) _Pragma("unroll") for (int k = 0; k < 2; ++k) dst[n][k] = *(const PG8_LAS bf16x8*)(lds + PG8_SB(b, h) + boff + n * 2048 + k * 1024); } while (0)
#define PG8_MMA(ai, bj, At, Bt) do { __builtin_amdgcn_s_setprio(1); _Pragma("unroll") for (int m = 0; m < 4; ++m) _Pragma("unroll") for (int n = 0; n < 2; ++n) _Pragma("unroll") for (int k = 0; k < 2; ++k) \
        acc[ai][bj][m][n] = __builtin_amdgcn_mfma_f32_16x16x32_bf16(Bt[n][k], At[m][k], acc[ai][bj][m][n], 0, 0, 0); __builtin_amdgcn_s_setprio(0); } while (0)
#define PG8_WAIT_V(n) asm volatile("s_waitcnt vmcnt(" #n ")" ::: "memory")
#define PG8_WAIT_L(n) asm volatile("s_waitcnt lgkmcnt(" #n ")" ::: "memory")
#define PG8_BAR __builtin_amdgcn_s_barrier()
#define PG8_SCHED __builtin_amdgcn_sched_barrier(0)
#define PG8_SETUNIT(u, pA, pB, hs) do { (hs) = (size_t)HALF * (u).K * 2; (pA) = (const char*)(u).A + (size_t)(u).pm * 2 * (hs); (pB) = (const char*)(u).Bt + (size_t)(u).pn * 2 * (hs); } while (0)
    UnitX cur, nxt; int ui = 0;
    if (!S.next(0, cur)) return;
    f32x4 acc[2][2][4][2];
#pragma unroll
    for (int a = 0; a < 2; ++a)
#pragma unroll
        for (int b = 0; b < 2; ++b)
#pragma unroll
            for (int m = 0; m < 4; ++m)
#pragma unroll
                for (int n = 0; n < 2; ++n) acc[a][b][m][n] = (f32x4){0.f, 0.f, 0.f, 0.f};
    bf16x8 At[4][2], B0[2][2], B1[2][2];
    const char* cA; const char* cB; size_t hstep;
    PG8_SETUNIT(cur, cA, cB, hstep);
    int cK = cur.K;
    unsigned voffA[2], voffB[2];
    PG8_VOFF(cK, voffA, voffB);
    PG8_STAGE(PG8_SB(0, 0), cB, voffB); PG8_STAGE(PG8_SB(0, 1), cB + hstep, voffB); PG8_STAGE(PG8_SA(0, 0), cA, voffA); PG8_STAGE(PG8_SA(0, 1), cA + hstep, voffA);
    if (wr == 1) PG8_BAR;
    PG8_WAIT_V(2); PG8_BAR;
    PG8_STAGE(PG8_SB(1, 0), cB + kstep, voffB); PG8_STAGE(PG8_SA(1, 0), cA + kstep, voffA); PG8_STAGE(PG8_SB(1, 1), cB + hstep + kstep, voffB);
    PG8_WAIT_V(6); PG8_BAR;
    for (;;) {
        const bool has_next = S.next(ui + 1, nxt);
        const char* nA = cA; const char* nB = cB; size_t nhstep = hstep; int nK = cK;
        if (has_next) { PG8_SETUNIT(nxt, nA, nB, nhstep); nK = nxt.K; }
        const int nt = cK / BK;
        for (int t = 0; t < nt; t += 2) {
            const bool last = (t == nt - 2);
            const char* a1 = cA + (size_t)(t + 1) * kstep;
            const char* a2 = last ? nA : cA + (size_t)(t + 2) * kstep; const char* b2 = last ? nB : cB + (size_t)(t + 2) * kstep;
            const char* a3 = a2 + kstep; const char* b3 = b2 + kstep;
            PG8_LDB(B0, 0, 0); PG8_LDB(B1, 0, 1); PG8_SCHED; PG8_LDA(At, 0, 0); PG8_STAGE(PG8_SA(1, 1), a1 + hstep, voffA);
            if (last) { PG8_VOFF(nK, voffA, voffB); hstep = nhstep; }
            PG8_WAIT_V(8); PG8_WAIT_L(0); PG8_BAR; PG8_MMA(0, 0, At, B0); PG8_MMA(0, 1, At, B1); PG8_BAR; PG8_SCHED;
            PG8_LDA(At, 0, 1); PG8_STAGE(PG8_SB(0, 0), b2, voffB); PG8_STAGE(PG8_SB(0, 1), b2 + hstep, voffB); PG8_STAGE(PG8_SA(0, 0), a2, voffA);
            PG8_WAIT_V(8); PG8_WAIT_L(0); PG8_BAR; PG8_MMA(1, 0, At, B0); PG8_MMA(1, 1, At, B1); PG8_BAR; PG8_SCHED;
            PG8_LDB(B0, 1, 0); PG8_LDB(B1, 1, 1); PG8_SCHED; PG8_LDA(At, 1, 0); PG8_STAGE(PG8_SA(0, 1), a2 + hstep, voffA);
            PG8_WAIT_V(8); PG8_WAIT_L(0); PG8_BAR; PG8_MMA(0, 0, At, B0); PG8_MMA(0, 1, At, B1); PG8_BAR; PG8_SCHED;
            PG8_LDA(At, 1, 1); PG8_STAGE(PG8_SB(1, 0), b3, voffB); PG8_STAGE(PG8_SB(1, 1), b3 + hstep, voffB); PG8_STAGE(PG8_SA(1, 0), a3, voffA);
            PG8_WAIT_V(8); PG8_WAIT_L(0); PG8_BAR; PG8_MMA(1, 0, At, B0); PG8_MMA(1, 1, At, B1); PG8_BAR; PG8_SCHED;
        }
        if constexpr (ALIGN_EPI) { if (wr == 0) PG8_BAR; }
        if (cur.zero_after) E(acc, cur, wr, wc, fr, fq);
        if (!has_next) break;
        E.rescale(acc, cur, wr, wc, fr, fq);
        cur = nxt; cA = nA; cB = nB; cK = nK;
        ++ui;
        if constexpr (ALIGN_EPI) { if (wr == 1) PG8_BAR; }
    }
    PG8_WAIT_V(0);
    if constexpr (!ALIGN_EPI) { if (wr == 0) PG8_BAR; }
    PG8_BAR;
#undef PG8_SA
#undef PG8_SB
#undef PG8_STAGE
#undef PG8_VOFF
#undef PG8_LDA
#undef PG8_LDB
#undef PG8_MMA
#undef PG8_WAIT_V
#undef PG8_WAIT_L
#undef PG8_BAR
#undef PG8_SCHED
#undef PG8_SETUNIT
}

struct SegSched {
    StaticOrder so; int nseg;
    int split_rounds;
    const bf16_t* A0; const bf16_t* B0; int K0;
    const unsigned char* ws; const unsigned char* wl;
    __device__ __forceinline__ bool next(int i, UnitX& u) const {
        const int q = (nseg == 1) ? i : (i >> 2), sg = (nseg == 1) ? 0 : (i & 3);
        Unit b;
        if (split_rounds > 0) {
            const int c = so.c; long L;
            if (c < 128) L = (q < split_rounds) ? (long)c + 128 * q : (long)128 * split_rounds + c + 256 * (q - split_rounds);
            else L = (long)128 * split_rounds + c + 256 * q;
            if (!so.next_at(L, b)) return false;
        } else if (!so.next(q, b)) return false;
        u.pm = b.pm; u.pn = b.pn; u.seg = sg; u.zero_after = (sg == nseg - 1);
        if (nseg == 1) { u.A = A0; u.Bt = B0; u.K = K0; }
        else {
            const size_t ao = sg == 0 ? WS_ACTA : (sg == 1 ? WS_ACTB : (sg == 2 ? WS_ACTC : WS_ACTD));
            const size_t bo = sg == 0 ? W_A : (sg == 1 ? W_B : (sg == 2 ? W_C : W_D));
            u.A = (const bf16_t*)(ws + ao); u.Bt = (const bf16_t*)(wl + bo); u.K = (sg == 1) ? 256 : 384;
        }
        return true;
    }
};
}


__device__ const unsigned char T5_BUCKET[3][132] = {
 {0,1,2,3,4,5,6,7,8,9,10,11,12,13,14,15,16,16,16,16,16,16,17,17,17,17,17,17,17,17,18,18,18,18,18,18,18,18,18,18,19,19,19,19,19,19,19,19,19,19,19,19,19,19,20,20,20,20,20,20,20,20,20,20,20,20,20,20,20,20,20,20,20,21,21,21,21,21,21,21,21,21,21,21,21,21,21,21,21,21,21,21,21,21,21,21,21,21,21,22,22,22,22,22,22,22,22,22,22,22,22,22,22,22,22,22,22,22,22,22,22,22,22,22,22,22,22,22,22,0,0,0},
 {0,4,8,12,16,16,17,17,18,18,19,19,19,19,20,20,20,20,20,21,21,21,21,21,21,22,22,22,22,22,22,22,22,22,23,23,23,23,23,23,23,23,23,23,23,23,24,24,24,24,24,24,24,24,24,24,24,24,24,24,24,24,25,25,25,25,25,25,25,25,25,25,25,25,25,25,25,25,25,25,25,25,25,26,26,26,26,26,26,26,26,26,26,26,26,26,26,26,26,26,26,26,26,26,26,26,26,26,26,26,26,26,26,27,27,27,27,27,27,27,27,27,27,27,27,27,27,27,27,0,0,0},
 {0,16,18,19,20,21,21,22,22,23,23,23,24,24,24,24,25,25,25,25,25,26,26,26,26,26,26,26,26,27,27,27,27,27,27,27,27,27,27,28,28,28,28,28,28,28,28,28,28,28,28,28,29,29,29,29,29,29,29,29,29,29,29,29,29,29,29,29,29,29,30,30,30,30,30,30,30,30,30,30,30,30,30,30,30,30,30,30,30,30,30,30,30,30,30,31,31,31,31,31,31,31,31,31,31,31,31,31,31,31,31,31,31,31,31,31,31,31,31,31,31,31,31,31,31,31,31,31,31,0,0,0}};

struct Args { const float* in[36]; float* out; unsigned char* ws; int ph_lo, ph_hi; };
typedef const __attribute__((address_space(4))) Args* ArgsP;


enum { IN_XP = 0, IN_XS, IN_C128, IN_C512, IN_C2048, IN_SCONV, IN_SPOOL, IN_PP, IN_PS, IN_RELB, IN_NMIX, IN_WIN, IN_CONVW, IN_CONVB, IN_CLNG, IN_CLNB, IN_WA,
       IN_QN, IN_KN, IN_WB, IN_SLNG, IN_SLNB, IN_SGUW, IN_SGUB, IN_WC, IN_POOLW, IN_POOLS, IN_WD, IN_WO, IN_NFFN, IN_WGATE, IN_WUP, IN_WDOWN, IN_NPLE, IN_WPG, IN_WPLE };

#define LDS_WAIT() asm volatile("s_waitcnt lgkmcnt(0)" ::: "memory")

__device__ __forceinline__ void transpose_item(const float* W, int K, int N, bf16_t* WT, const float* gain, int mode, LAS float* scr, int item, int lane) {
    const int nblk = N / 64, kb = item / nblk, nb = item % nblk, k0 = 64 * kb, n0 = 64 * nb;
    {
        const int kk = lane >> 4, n4 = (lane & 15) * 4;
        f32x4 v[16];
#pragma unroll
        for (int i = 0; i < 16; ++i) v[i] = *(const f32x4*)(W + (size_t)(k0 + kk + 4 * i) * N + n0 + n4);
#pragma unroll
        for (int i = 0; i < 16; ++i) { LAS float* d = scr + (kk + 4 * i) * 65 + n4; d[0] = v[i][0]; d[1] = v[i][1]; d[2] = v[i][2]; d[3] = v[i][3]; }
    }
    LDS_WAIT(); asm volatile("" ::: "memory");
    const int c = lane & 7;
    f32x4 g0 = {1.f, 1.f, 1.f, 1.f}, g1 = {1.f, 1.f, 1.f, 1.f};
    if (gain) { g0 = *(const f32x4*)(gain + k0 + 8 * c); g1 = *(const f32x4*)(gain + k0 + 8 * c + 4); }
#pragma unroll
    for (int j = 0; j < 8; ++j) {
        const int n = (lane >> 3) + 8 * j; const LAS float* s = scr + (8 * c) * 65 + n;
        u32x4 o; o.x = cvt_pk_bf16(s[0 * 65] * g0[0], s[1 * 65] * g0[1]); o.y = cvt_pk_bf16(s[2 * 65] * g0[2], s[3 * 65] * g0[3]); o.z = cvt_pk_bf16(s[4 * 65] * g1[0], s[5 * 65] * g1[1]); o.w = cvt_pk_bf16(s[6 * 65] * g1[2], s[7 * 65] * g1[3]);
        const int nn = n0 + n;
        const int row = (mode == 0) ? nn : ((nn >> 7) * 256 + (nn & 127) + (mode == 2 ? 128 : 0));
        *(u32x4*)(WT + (size_t)row * K + k0 + 8 * c) = o;
    }
    LDS_WAIT(); asm volatile("" ::: "memory");
}

__device__ __forceinline__ void poolfold_item(const float* pw, const float* psc, const float* wd, bf16_t* WT, int item, int lane) {
    const int nb = item / 48, cb = item - nb * 48, c0 = 8 * cb, g = c0 / 96, cl0 = c0 - 96 * g, n = 64 * nb + lane;
    float acc[8];
#pragma unroll
    for (int i = 0; i < 8; ++i) acc[i] = 0.f;
    const float* pwg = pw + (size_t)(g * 96 + cl0) * 96;
    const float* wdg = wd + (size_t)(g * 96) * D + n;
    const float* scg = psc + g * 96;
#pragma unroll 32
    for (int cp = 0; cp < 96; ++cp) {
        const float x = wdg[(size_t)cp * D] * scg[cp];
#pragma unroll
        for (int i = 0; i < 8; ++i) acc[i] += pwg[i * 96 + cp] * x;
    }
    *(u32x4*)(WT + (size_t)n * 384 + c0) = pack8(acc);
}

constexpr int STAG_Q_Z = 224, STAG_Q_GU = 320;
constexpr int STAG_TOT_Z = STAG_Q_Z * (159 * 158 / 2), STAG_TOT_GU = STAG_Q_GU * (106 * 105 / 2), STAG_TOT = 2 * (STAG_TOT_Z + STAG_TOT_GU);
static_assert(2145 - 8 * 256 == 97 && 1430 - 5 * 256 == 150, "stagger geometry");
constexpr int CP_N0 = 64 * (128 - 8) * 128, CP_N1 = 64 * (512 - 8) * 128, CP_N2 = 64 * (2048 - 8) * 128, CP_TOT = CP_N0 + CP_N1 + CP_N2;
__device__ __forceinline__ void cache_copy_addr(ArgsP a, int i, const f32x4*& src, f32x4*& dst) {
    if (i < CP_N0) { constexpr int n4 = 120 * 128; const int ls = i / n4, off = i - ls * n4; src = (const f32x4*)a->in[IN_C128] + (size_t)ls * 128 * 128 + 1024 + off; dst = (f32x4*)(a->out + O_KVS0) + (size_t)ls * 128 * 128 + off; }
    else if (i < CP_N0 + CP_N1) { constexpr int n4 = 504 * 128; const int k = i - CP_N0, ls = k / n4, off = k - ls * n4; src = (const f32x4*)a->in[IN_C512] + (size_t)ls * 512 * 128 + 1024 + off; dst = (f32x4*)(a->out + O_KVS1) + (size_t)ls * 512 * 128 + off; }
    else { constexpr int n4 = 2040 * 128; const int k = i - CP_N0 - CP_N1, ls = k / n4, off = k - ls * n4; src = (const f32x4*)a->in[IN_C2048] + (size_t)ls * 2048 * 128 + 1024 + off; dst = (f32x4*)(a->out + O_KVS2) + (size_t)ls * 2048 * 128 + off; }
}
__device__ __forceinline__ void cache_copy_range(ArgsP a, int lo, int hi, int ith, int nth) {
    constexpr int U = 16;
    for (int i0 = lo + ith; i0 < hi; i0 += U * nth) {
        f32x4 v[U];
#pragma unroll
        for (int k = 0; k < U; ++k) { int i = i0 + k * nth; i = i < hi ? i : hi - 1; const f32x4* src; f32x4* dst; cache_copy_addr(a, i, src, dst); v[k] = __builtin_nontemporal_load(src); }
#pragma unroll
        for (int k = 0; k < U; ++k) { const int i = i0 + k * nth; if (i < hi) { const f32x4* src; f32x4* dst; cache_copy_addr(a, i, src, dst); __builtin_nontemporal_store(v[k], dst); } }
    }
}

__device__ __forceinline__ void p0_prologue(ArgsP a, LAS unsigned char* lds, int tid, int lane, int wave, int NCU, int cu, int part, bool stag_z0_here) {
    const int G = NCU, bid = cu;
    const bool do0 = part != 1, do1 = part != 0;
    unsigned char* ws = a->ws;
    LAS float* scr = (LAS float*)(lds + wave * 16640);
    const int gw = bid * 8 + wave, NGW = G * 8;
    const int gtid = bid * 512 + tid, NT = G * 512;
    constexpr int I_IN = 16 * 130, I_A = 6 * 16, I_B = 4 * 16, I_O = 16 * 16, I_G = 16 * 44, I_DN = 44 * 16, I_PLE = 4 * 16, I_PF = 16 * 48;
    constexpr int I_LAYER = I_IN + 2 * I_A + I_PF + I_B + 2 * I_O + 2 * I_G + I_DN + I_PLE;
    for (int it0 = gw; it0 < 2 * I_LAYER * P0R_T; it0 += NGW) {
        const int it = it0 % (2 * I_LAYER);
        const int l = it / I_LAYER; int r = it - l * I_LAYER;
        const bool crit = (l == 0 && r < I_IN);
        if (crit ? !do0 : !do1) continue;
        unsigned char* wl = ws + WS_W + (size_t)l * WL;
        if (r < I_IN) { transpose_item(a->in[IN_WIN] + (size_t)l * D * DIN, D, DIN, (bf16_t*)(wl + W_IN), a->in[IN_NMIX] + l * D, 0, scr, r, lane); continue; } r -= I_IN;
        if (r < I_A) { transpose_item(a->in[IN_WA] + (size_t)l * 384 * D, 384, D, (bf16_t*)(wl + W_A), nullptr, 0, scr, r, lane); continue; } r -= I_A;
        if (r < I_B) { transpose_item(a->in[IN_WB] + (size_t)l * 256 * D, 256, D, (bf16_t*)(wl + W_B), nullptr, 0, scr, r, lane); continue; } r -= I_B;
        if (r < I_A) { transpose_item(a->in[IN_WC] + (size_t)l * 384 * D, 384, D, (bf16_t*)(wl + W_C), nullptr, 0, scr, r, lane); continue; } r -= I_A;
        if (r < I_PF) { poolfold_item(a->in[IN_POOLW] + (size_t)l * 4 * 96 * 96, a->in[IN_POOLS] + l * 384, a->in[IN_WD] + (size_t)l * 384 * D, (bf16_t*)(wl + W_D), r, lane); continue; } r -= I_PF;
        if (r < I_O) { transpose_item(a->in[IN_WO] + (size_t)l * D * D, D, D, (bf16_t*)(wl + W_O), nullptr, 0, scr, r, lane); continue; } r -= I_O;
        if (r < I_G) { transpose_item(a->in[IN_WGATE] + (size_t)l * D * DFF, D, DFF, (bf16_t*)(wl + W_GU), a->in[IN_NFFN] + l * D, 1, scr, r, lane); continue; } r -= I_G;
        if (r < I_G) { transpose_item(a->in[IN_WUP] + (size_t)l * D * DFF, D, DFF, (bf16_t*)(wl + W_GU), a->in[IN_NFFN] + l * D, 2, scr, r, lane); continue; } r -= I_G;
        if (r < I_DN) { transpose_item(a->in[IN_WDOWN] + (size_t)l * DFF * D, DFF, D, (bf16_t*)(wl + W_DN), nullptr, 0, scr, r, lane); continue; } r -= I_DN;
        if (r < I_O) { transpose_item(a->in[IN_WPG] + (size_t)l * D * D, D, D, (bf16_t*)(wl + W_PG), a->in[IN_NPLE] + l * D, 0, scr, r, lane); continue; } r -= I_O;
        transpose_item(a->in[IN_WPLE] + (size_t)l * DPLE * D, DPLE, D, (bf16_t*)(wl + W_PLE), nullptr, 0, scr, r, lane);
    }
    for (int i = gtid; i < 2 * (NZ - DIN) * D / 8; i += NT) { const int l = i / ((NZ - DIN) * D / 8), o = i - l * ((NZ - DIN) * D / 8);
        if (l == 0 ? !do0 : !do1) continue;
        u32x4 z4 = {0u, 0u, 0u, 0u}; asm volatile("" : "+v"(z4));
        *(u32x4*)(ws + WS_W + (size_t)l * WL + W_IN + ((size_t)DIN * D + (size_t)o * 8) * 2) = z4; }
    float* rs0 = (float*)(ws + WS_CTL) + RS_MIX0 * RS_STRIDE;
    bf16_t* xb = (bf16_t*)(ws + WS_XB);
    if (do0) for (int m0 = gw; m0 < M * P0R_X; m0 += NGW) {
        const int m = m0 % M;
        const float* xr = (m < MP) ? a->in[IN_XP] + (size_t)m * D : a->in[IN_XS] + (size_t)(m - MP) * D;
        f32x4 v[4]; float s = 0.f;
#pragma unroll
        for (int j = 0; j < 4; ++j) { v[j] = ((const f32x4*)xr)[lane + 64 * j]; s += (v[j][0] * v[j][0] + v[j][1] * v[j][1]) + (v[j][2] * v[j][2] + v[j][3] * v[j][3]); }
        s = wave_sum(s);
        if (lane == 0) rs0[m] = s;
#pragma unroll
        for (int j = 0; j < 4; ++j) { u32x2 w; w.x = cvt_pk_bf16(v[j][0], v[j][1]); w.y = cvt_pk_bf16(v[j][2], v[j][3]); ((u32x2*)(xb + (size_t)m * D))[lane + 64 * j] = w; }
    }
    if (!do1) return;
    bf16_t* peb = (bf16_t*)(ws + WS_PEB);
    for (int i = gtid; i < 2 * M * 32; i += NT) {
        const int l = i / (M * 32), rem = i - l * (M * 32), m = rem >> 5, c8 = rem & 31;
        const float* src = (m < MP) ? a->in[IN_PP] + ((size_t)l * MP + m) * DPLE + c8 * 8 : a->in[IN_PS] + ((size_t)l * MS + (m - MP)) * DPLE + c8 * 8;
        const f32x4 p0 = *(const f32x4*)src, p1 = *(const f32x4*)(src + 4);
        u32x4 w; w.x = cvt_pk_bf16(p0[0], p0[1]); w.y = cvt_pk_bf16(p0[2], p0[3]); w.z = cvt_pk_bf16(p1[0], p1[1]); w.w = cvt_pk_bf16(p1[2], p1[3]);
        *(u32x4*)(peb + ((size_t)l * M + m) * DPLE + c8 * 8) = w;
    }
    cache_copy_range(a, STAG_TOT, CP_TOT, gtid, NT);
    if (stag_z0_here) cache_copy_range(a, 0, STAG_TOT_Z, gtid, NT);
    if (!stag_z0_here && part == 2) cache_copy_range(a, 0, STAG_TOT, gtid, NT);
    for (int i = gtid; i < 2 * 4 * 128 * 16; i += NT) {
        const int row = i >> 4, j8 = (i & 15) * 8, ii = row & 127;
        const float* src = a->in[IN_SGUW] + (size_t)row * 128 + j8; const f32x4 p0 = *(const f32x4*)src, p1 = *(const f32x4*)(src + 4);
        float v[8] = {p0[0], p0[1], p0[2], p0[3], p1[0], p1[1], p1[2], p1[3]};
#pragma unroll
        for (int k = 0; k < 8; ++k) v[k] = (j8 + k <= ii) ? v[k] : 0.f;
        *(u32x4*)((bf16_t*)(ws + WS_SGUW) + (size_t)row * 128 + j8) = pack8(v);
    }
    for (int i = gtid; i < 64 * 22 * 96; i += NT) { const int ls = i / (22 * 96), off = i - ls * (22 * 96);
        ((f32x4*)(a->out + O_CONVS))[(size_t)ls * 30 * 96 + off] = ((const f32x4*)a->in[IN_SCONV])[(size_t)ls * 30 * 96 + 8 * 96 + off]; }
    for (int i = gtid; i < 64 * 7 * 96; i += NT) { const int ls = i / (7 * 96), off = i - ls * (7 * 96);
        ((f32x4*)(a->out + O_POOLS))[(size_t)ls * 15 * 96 + off] = ((const f32x4*)a->in[IN_SPOOL])[(size_t)ls * 15 * 96 + 8 * 96 + off]; }
}

__device__ __forceinline__ float* kv_out_ptr(float* out, int g, bool isP, int l, int s, int pos) {
    const int W = 128 << (2 * g);
    const size_t base = isP ? (g == 0 ? O_KVP0 : (g == 1 ? O_KVP1 : O_KVP2)) : (g == 0 ? O_KVS0 : (g == 1 ? O_KVS1 : O_KVS2));
    const size_t seq = isP ? (size_t)l : (size_t)(l * 32 + s);
    return out + base + (seq * W + pos) * 512;
}

struct PzRow { u32x4 La, Lb, Lvv, Lq0, Lk0, Lq1, Lk1; };
__device__ __forceinline__ PzRow postz_load(ArgsP a, int m, int lane) {
    const bf16_t* zr = (const bf16_t*)(a->ws + WS_Z) + (size_t)m * ZP;
    const int lc48 = lane < 48 ? lane : 47, ch1 = 64 + (lane & 31);
    PzRow R;
    R.La = *(const u32x4*)(zr + ZA + 8 * lc48); R.Lb = *(const u32x4*)(zr + ZB + 8 * lc48); R.Lvv = *(const u32x4*)(zr + ZVV + 8 * lc48);
    R.Lq0 = *(const u32x4*)(zr + ZQ + 8 * lane); R.Lk0 = *(const u32x4*)(zr + ZK + 8 * lane); R.Lq1 = *(const u32x4*)(zr + ZQ + 8 * ch1); R.Lk1 = *(const u32x4*)(zr + ZK + 8 * ch1);
    return R;
}
__device__ __forceinline__ u32x4 postz_row(ArgsP a, int l, int m, int lane, const PzRow& R) {
    u32x4 vvpk = {0u, 0u, 0u, 0u};
    unsigned char* ws = a->ws;
    const bf16_t* zr = (const bf16_t*)(ws + WS_Z) + (size_t)m * ZP;
    const bool isP = m < MP; const int t = isP ? m : ((m - MP) & 7); const int s = isP ? 0 : ((m - MP) >> 3);
    const int ch1 = 64 + (lane & 31);
    const u32x4 La = R.La, Lb = R.Lb, Lvv = R.Lvv, Lq0 = R.Lq0, Lk0 = R.Lk0, Lq1 = R.Lq1, Lk1 = R.Lk1;
    if (lane < 48) {
        float av[8], bv[8], g[8]; unpack8(La, av); unpack8(Lb, bv);
#pragma unroll
        for (int i = 0; i < 8; ++i) g[i] = av[i] * sigmoidf_(bv[i]);
        *(u32x4*)((bf16_t*)(ws + WS_GLU) + (size_t)m * 384 + 8 * lane) = pack8(g);
        float* dst = nullptr;
        if (isP) { if (t >= TP - 30) dst = a->out + O_CONVP + ((size_t)l * 30 + (t - (TP - 30))) * 384 + 8 * lane; }
        else dst = a->out + O_CONVS + ((size_t)(l * 32 + s) * 30 + 22 + t) * 384 + 8 * lane;
        if (dst) { *(f32x4*)dst = (f32x4){g[0], g[1], g[2], g[3]}; *(f32x4*)(dst + 4) = (f32x4){g[4], g[5], g[6], g[7]}; }
        float* pd = nullptr;
        if (isP) { if (t >= TP - 15) pd = a->out + O_POOLP + ((size_t)l * 15 + (t - (TP - 15))) * 384 + 8 * lane; }
        else pd = a->out + O_POOLS + ((size_t)(l * 32 + s) * 15 + 7 + t) * 384 + 8 * lane;
        if (pd) { float zd[8]; unpack8(*(const u32x4*)(zr + ZD + 8 * lane), zd); *(f32x4*)pd = (f32x4){zd[0], zd[1], zd[2], zd[3]}; *(f32x4*)(pd + 4) = (f32x4){zd[4], zd[5], zd[6], zd[7]}; }
    }
    const float* qw = a->in[IN_QN] + l * HD; const float* kw = a->in[IN_KN] + l * HD;
#pragma unroll
    for (int it = 0; it < 2; ++it) {
        const int ch = lane + 64 * it; const bool act = ch < 96; const int chc = (it == 0) ? lane : ch1;
        const int h = chc >> 3, dc = (chc & 7) * 8, g = h >> 2, hs = h & 3;
        float q[8], k[8];
        unpack8(it == 0 ? Lq0 : Lq1, q); unpack8(it == 0 ? Lk0 : Lk1, k);
        float sq = 0.f, sk = 0.f;
#pragma unroll
        for (int i = 0; i < 8; ++i) { sq += q[i] * q[i]; sk += k[i] * k[i]; }
        sq += __shfl_xor(sq, 1); sq += __shfl_xor(sq, 2); sq += __shfl_xor(sq, 4);
        sk += __shfl_xor(sk, 1); sk += __shfl_xor(sk, 2); sk += __shfl_xor(sk, 4);
        const float rq = rsqrtf(sq * (1.0f / 64.0f) + EPS) * (0.125f * LOG2E), rk = rsqrtf(sk * (1.0f / 64.0f) + EPS);
        const f32x4 qw0 = *(const f32x4*)(qw + dc), qw1 = *(const f32x4*)(qw + dc + 4), kw0 = *(const f32x4*)(kw + dc), kw1 = *(const f32x4*)(kw + dc + 4);
#pragma unroll
        for (int i = 0; i < 4; ++i) { q[i] *= rq * qw0[i]; q[4 + i] *= rq * qw1[i]; k[i] *= rk * kw0[i]; k[4 + i] *= rk * kw1[i]; }
        if (act) {
            *(u32x4*)((bf16_t*)(ws + WS_QN) + (size_t)m * DQ + 8 * ch) = pack8(q);
            *(u32x4*)((bf16_t*)(ws + WS_KN) + (size_t)m * DQ + 8 * ch) = pack8(k);
            const int W = 128 << (2 * g);
            const int pos = isP ? t - (TP - W) : W - 8 + t;
            if (pos >= 0) {
                float* kvp = kv_out_ptr(a->out, g, isP, l, s, pos) + hs * 64 + dc;
                *(f32x4*)kvp = (f32x4){k[0], k[1], k[2], k[3]}; *(f32x4*)(kvp + 4) = (f32x4){k[4], k[5], k[6], k[7]};
                float v[8]; unpack8(*(const u32x4*)(zr + ZV + 8 * ch), v);
                *(f32x4*)(kvp + 256) = (f32x4){v[0], v[1], v[2], v[3]}; *(f32x4*)(kvp + 260) = (f32x4){v[4], v[5], v[6], v[7]};
            }
        }
    }
    {
        float x[8]; const bool act = lane < 48;
        unpack8(Lvv, x);
        float sm = 0.f;
#pragma unroll
        for (int i = 0; i < 8; ++i) sm += x[i];
        sm = wave_sum(act ? sm : 0.f);
        const float mean = sm * (1.0f / 384.0f);
        float sv = 0.f;
#pragma unroll
        for (int i = 0; i < 8; ++i) { x[i] -= mean; sv += x[i] * x[i]; }
        sv = wave_sum(act ? sv : 0.f);
        const float rstd = rsqrtf(sv * (1.0f / 384.0f) + LN_EPS);
        if (act) {
            const float* gg = a->in[IN_SLNG] + l * 384 + 8 * lane; const float* bb = a->in[IN_SLNB] + l * 384 + 8 * lane;
            const f32x4 g0 = *(const f32x4*)gg, g1 = *(const f32x4*)(gg + 4), b0 = *(const f32x4*)bb, b1 = *(const f32x4*)(bb + 4);
#pragma unroll
            for (int i = 0; i < 4; ++i) { x[i] = x[i] * rstd * g0[i] + b0[i]; x[4 + i] = x[4 + i] * rstd * g1[i] + b1[i]; }
            vvpk = pack8(x);
            if (!isP) *(u32x4*)((bf16_t*)(ws + WS_VLN) + (size_t)m * 384 + 8 * lane) = vvpk;
            if (!isP) { float* sp = a->out + O_SGUS + ((size_t)(l * 32 + s) * 8 + t) * 384 + 8 * lane; *(f32x4*)sp = (f32x4){x[0], x[1], x[2], x[3]}; *(f32x4*)(sp + 4) = (f32x4){x[4], x[5], x[6], x[7]}; }
        }
    }
    return vvpk;
}
__device__ __forceinline__ void postz_rows8(ArgsP a, int l, int m0, int lane) {
    u32x4 pk[8];
    PzRow cur = postz_load(a, m0, lane);
#pragma unroll
    for (int r = 0; r < 8; ++r) {
        PzRow nxt = cur;
        if (r < 7) nxt = postz_load(a, m0 + r + 1, lane);
        __builtin_amdgcn_sched_barrier(0);
        pk[r] = postz_row(a, l, m0 + r, lane, cur);
        cur = nxt;
    }
    if (lane < 48) {
        bf16_t* vt = (bf16_t*)(a->ws + WS_VLN) + ((size_t)(m0 >> 7) * 384 + 8 * lane) * 128 + (m0 & 127);
#define PZ_LO(w) ((w) & 0xffffu)
#define PZ_HI(w) ((w) >> 16)
#define PZ_ROW(sel, comp) (u32x4){ sel(pk[0].comp) | (sel(pk[1].comp) << 16), sel(pk[2].comp) | (sel(pk[3].comp) << 16), sel(pk[4].comp) | (sel(pk[5].comp) << 16), sel(pk[6].comp) | (sel(pk[7].comp) << 16) }
        *(u32x4*)(vt + 0 * 128) = PZ_ROW(PZ_LO, x); *(u32x4*)(vt + 1 * 128) = PZ_ROW(PZ_HI, x);
        *(u32x4*)(vt + 2 * 128) = PZ_ROW(PZ_LO, y); *(u32x4*)(vt + 3 * 128) = PZ_ROW(PZ_HI, y);
        *(u32x4*)(vt + 4 * 128) = PZ_ROW(PZ_LO, z); *(u32x4*)(vt + 5 * 128) = PZ_ROW(PZ_HI, z);
        *(u32x4*)(vt + 6 * 128) = PZ_ROW(PZ_LO, w); *(u32x4*)(vt + 7 * 128) = PZ_ROW(PZ_HI, w);
#undef PZ_LO
#undef PZ_HI
#undef PZ_ROW
    }
}

constexpr int TAB_OFF = 122880;
__device__ __forceinline__ void attn_sample_task(ArgsP a, int l, int m, int h, int lane, const LAS float* tab) {
    unsigned char* ws = a->ws;
    const bf16_t* qn = (const bf16_t*)(ws + WS_QN); const bf16_t* kn = (const bf16_t*)(ws + WS_KN); const bf16_t* z = (const bf16_t*)(ws + WS_Z);
    const int g = h >> 2, hs = h & 3, sh = 2 * g, W = 128 << sh;
    const int t = (m - MP) & 7, s = (m - MP) >> 3;
    const int ks = lane >> 3, c = lane & 7;
    float qf[8]; unpack8(*(const u32x4*)(qn + (size_t)m * DQ + h * 64 + 8 * c), qf);
    const float* cache = a->in[IN_C128 + g] + ((size_t)(l * 32 + s) * W) * 512 + hs * 64 + 8 * c;
    const LAS float* tb = tab + h * 132;
    float sc[17];
    const int tk0 = t - (ks << sh);
    const size_t nrow = (size_t)(MP + 8 * s + (tk0 < 0 ? 0 : tk0));
    const int prow0 = tk0 < 0 ? W + tk0 : W - 1;
    {
        float kf[8]; unpack8(*(const u32x4*)(kn + nrow * DQ + h * 64 + 8 * c), kf);
        const float* p = cache + (size_t)prow0 * 512; const f32x4 x0 = *(const f32x4*)p, x1 = *(const f32x4*)(p + 4);
        if (tk0 < 0) { kf[0] = x0[0]; kf[1] = x0[1]; kf[2] = x0[2]; kf[3] = x0[3]; kf[4] = x1[0]; kf[5] = x1[1]; kf[6] = x1[2]; kf[7] = x1[3]; }
        float d = 0.f;
#pragma unroll
        for (int i = 0; i < 8; ++i) d += qf[i] * kf[i];
        d += __shfl_xor(d, 1); d += __shfl_xor(d, 2); d += __shfl_xor(d, 4);
        sc[0] = d + tb[ks];
    }
#pragma unroll
    for (int hb = 0; hb < 2; ++hb) {
        f32x4 x0[8], x1[8];
#pragma unroll
        for (int q = 0; q < 8; ++q) { const int it = 1 + 8 * hb + q; const int j = it * 8 + ks; const int jj = j <= 128 ? j : 128; const float* p = cache + (size_t)(W + t - (jj << sh)) * 512; x0[q] = *(const f32x4*)p; x1[q] = *(const f32x4*)(p + 4); }
        __builtin_amdgcn_sched_barrier(0);
#pragma unroll
        for (int q = 0; q < 8; ++q) {
            const int it = 1 + 8 * hb + q; const int j = it * 8 + ks; const bool inr = j <= 128; const int jj = inr ? j : 128;
            const f32x4 a0 = x0[q], a1 = x1[q];
            float d = (qf[0] * a0[0] + qf[1] * a0[1]) + (qf[2] * a0[2] + qf[3] * a0[3]) + (qf[4] * a1[0] + qf[5] * a1[1]) + (qf[6] * a1[2] + qf[7] * a1[3]);
            d += __shfl_xor(d, 1); d += __shfl_xor(d, 2); d += __shfl_xor(d, 4);
            d += tb[jj];
            sc[it] = inr ? d : -1.0e30f;
        }
        __builtin_amdgcn_sched_barrier(0);
    }
    float mx = sc[0];
#pragma unroll
    for (int it = 1; it < 17; ++it) mx = fmaxf(mx, sc[it]);
    mx = fmaxf(mx, __shfl_xor(mx, 8)); mx = fmaxf(mx, __shfl_xor(mx, 16)); mx = fmaxf(mx, __shfl_xor(mx, 32));
    float sum = 0.f;
#pragma unroll
    for (int it = 0; it < 17; ++it) { sc[it] = __builtin_amdgcn_exp2f(sc[it] - mx); sum += sc[it]; }
    sum += __shfl_xor(sum, 8); sum += __shfl_xor(sum, 16); sum += __shfl_xor(sum, 32);
    float acc[8];
    {
        float vf[8]; unpack8(*(const u32x4*)(z + nrow * ZP + ZV + h * 64 + 8 * c), vf);
        const float* p = cache + (size_t)prow0 * 512 + 256; const f32x4 x0 = *(const f32x4*)p, x1 = *(const f32x4*)(p + 4);
        if (tk0 < 0) { vf[0] = x0[0]; vf[1] = x0[1]; vf[2] = x0[2]; vf[3] = x0[3]; vf[4] = x1[0]; vf[5] = x1[1]; vf[6] = x1[2]; vf[7] = x1[3]; }
#pragma unroll
        for (int i = 0; i < 8; ++i) acc[i] = sc[0] * vf[i];
    }
#pragma unroll
    for (int hb = 0; hb < 2; ++hb) {
        f32x4 x0[8], x1[8];
#pragma unroll
        for (int q = 0; q < 8; ++q) { const int it = 1 + 8 * hb + q; const int j = it * 8 + ks; const int jj = j <= 128 ? j : 128; const float* p = cache + (size_t)(W + t - (jj << sh)) * 512 + 256; x0[q] = *(const f32x4*)p; x1[q] = *(const f32x4*)(p + 4); }
        __builtin_amdgcn_sched_barrier(0);
#pragma unroll
        for (int q = 0; q < 8; ++q) {
            const float pw = sc[1 + 8 * hb + q]; const f32x4 a0 = x0[q], a1 = x1[q];
            acc[0] += pw * a0[0]; acc[1] += pw * a0[1]; acc[2] += pw * a0[2]; acc[3] += pw * a0[3]; acc[4] += pw * a1[0]; acc[5] += pw * a1[1]; acc[6] += pw * a1[2]; acc[7] += pw * a1[3];
        }
        __builtin_amdgcn_sched_barrier(0);
    }
    const float inv = 1.0f / sum;
#pragma unroll
    for (int i = 0; i < 8; ++i) { float v = acc[i]; v += __shfl_xor(v, 8); v += __shfl_xor(v, 16); v += __shfl_xor(v, 32); acc[i] = v * inv; }
    if (lane < 8) *(u32x4*)((bf16_t*)(ws + WS_OPART) + (size_t)m * DQ + h * 64 + 8 * c) = pack8(acc);
    if (lane == 0) ((float*)(ws + WS_LSE))[(size_t)m * 12 + h] = (mx + __builtin_amdgcn_logf(sum) + ATT_C2) * LN2;
}

constexpr int VSP = 72;
typedef short v4i16_t __attribute__((ext_vector_type(4)));
constexpr int NT_ATTP = 12 * (TP / 32);
constexpr int AKS_OFF = 0, AVS_OFF = 49152;
__device__ __forceinline__ void attn_mfma_unit(ArgsP a, LAS unsigned char* lds, int l, int unit, int tid, int lane, int wave, const LAS float* tab) {
    unsigned char* ws = a->ws;
    const bf16_t* qn = (const bf16_t*)(ws + WS_QN); const bf16_t* kn = (const bf16_t*)(ws + WS_KN); const bf16_t* z = (const bf16_t*)(ws + WS_Z);
    LAS unsigned char* Ks = lds + AKS_OFF;
    LAS bf16_t* Vs = (LAS bf16_t*)(lds + AVS_OFF);
    const int task0 = unit * 8;
    const int h = task0 / (TP / 32); const int rem = task0 - h * (TP / 32);
    const int sh = 2 * (h >> 2);
    const int nb = (TP / 32) >> sh;
    const int r = rem / nb, ib8 = rem - r * nb;
    const int ib = ib8 + wave;
    const int c = lane & 31, hh = lane >> 5;
    const int tq = ((32 * ib + c) << sh) + r;
    bf16x8 qf[4];
#pragma unroll
    for (int s = 0; s < 4; ++s) qf[s] = *(const bf16x8*)(qn + (size_t)tq * DQ + h * 64 + 16 * s + 8 * hh);
    {
        const int k0 = 32 * ib8 - 128;
        int t2 = tid; asm volatile("" : "+v"(t2));
        const int key0 = t2 >> 3, ch = t2 & 7;
        const unsigned kcol = (unsigned)(h * 128 + ch * 16), vcol = (unsigned)(ZV * 2 + h * 128 + ch * 16);
        u32x4 kr[6], vr[6];
#pragma unroll
        for (int i = 0; i < 6; ++i) {
            int ik = k0 + key0 + 64 * i; ik = ik < 0 ? 0 : ik; const unsigned tk = ((unsigned)ik << sh) + r;
            kr[i] = *(const u32x4*)((const unsigned char*)kn + (tk * (unsigned)(DQ * 2) + kcol));
            vr[i] = *(const u32x4*)((const unsigned char*)z + (tk * (unsigned)(ZP * 2) + vcol));
        }
        __builtin_amdgcn_sched_barrier(0);
        LAS unsigned char* kw = Ks + key0 * 128 + ((ch ^ (key0 & 7)) << 4);
        LAS unsigned char* vw = (LAS unsigned char*)Vs + key0 * (VSP * 2) + ch * 16;
#pragma unroll
        for (int i = 0; i < 6; ++i) { *(LAS u32x4*)(kw + i * 8192) = kr[i]; *(LAS u32x4*)(vw + i * (64 * VSP * 2)) = vr[i]; }
    }
    f32x16 o0, o1;
#pragma unroll
    for (int i = 0; i < 16; ++i) { o0[i] = 0.f; o1[i] = 0.f; }
    float lrun = 0.f;
    const int i0 = 32 * ib - 128;
    const LAS float* tb = tab + h * 132;
    __syncthreads();
#pragma unroll 1
    for (int kt = 0; kt < 5; ++kt) {
        const int ib0 = i0 + 32 * kt;
        const int lk = 32 * (wave + kt);
        bf16x8 kf[4];
#pragma unroll
        for (int s = 0; s < 4; ++s) kf[s] = *(const LAS bf16x8*)(Ks + (lk + c) * 128 + (((2 * s + hh) ^ (c & 7)) << 4));
        const bool need_mask = (kt == 0) || (kt == 4) || (ib < 4);
        f32x16 sa;
        if (need_mask) {
#pragma unroll
            for (int reg = 0; reg < 16; ++reg) { const int kr = (reg & 3) + 8 * (reg >> 2) + 4 * hh; const int j = c + 128 - 32 * kt - kr; const int jj = j < 0 ? 0 : (j > 128 ? 128 : j); sa[reg] = tb[jj]; }
        } else {
            const LAS float* tbl = tb + (c + 128 - 27 - 32 * kt - 4 * hh);
#pragma unroll
            for (int reg = 0; reg < 16; ++reg) sa[reg] = tbl[27 - ((reg & 3) + 8 * (reg >> 2))];
        }
#pragma unroll
        for (int s = 0; s < 4; ++s) sa = __builtin_amdgcn_mfma_f32_32x32x16_bf16(kf[s], qf[s], sa, 0, 0, 0);
        if (need_mask) {
#pragma unroll
            for (int reg = 0; reg < 16; ++reg) {
                const int kr = (reg & 3) + 8 * (reg >> 2) + 4 * hh;
                const int j = c + 128 - 32 * kt - kr;
                const bool valid = (j >= 0) && (j <= 128) && (ib0 + kr >= 0);
                sa[reg] = valid ? sa[reg] : -1.0e30f;
            }
        }
        float lsum = 0.f;
#pragma unroll
        for (int reg = 0; reg < 16; ++reg) { const float p = __builtin_amdgcn_exp2f(sa[reg]); sa[reg] = p; lsum += p; }
        lrun += lsum;
#pragma unroll
        for (int s = 0; s < 2; ++s) {
            u32x4 pw; pw.x = cvt_pk_bf16(sa[8 * s + 0], sa[8 * s + 1]); pw.y = cvt_pk_bf16(sa[8 * s + 2], sa[8 * s + 3]); pw.z = cvt_pk_bf16(sa[8 * s + 4], sa[8 * s + 5]); pw.w = cvt_pk_bf16(sa[8 * s + 6], sa[8 * s + 7]);
            const bf16x8 pf = __builtin_bit_cast(bf16x8, pw);
            const LAS bf16_t* vq = Vs + (lk + 16 * s + 4 * hh + ((lane & 15) >> 2)) * VSP + 16 * ((lane >> 4) & 1) + 4 * (lane & 3);
            {   const v4i16_t lo = __builtin_amdgcn_ds_read_tr16_b64_v4i16((LAS v4i16_t*)vq), hi = __builtin_amdgcn_ds_read_tr16_b64_v4i16((LAS v4i16_t*)(vq + 8 * VSP));
                const bf16x8 af = {lo[0], lo[1], lo[2], lo[3], hi[0], hi[1], hi[2], hi[3]};
                o0 = __builtin_amdgcn_mfma_f32_32x32x16_bf16(af, pf, o0, 0, 0, 0); }
            {   const v4i16_t lo = __builtin_amdgcn_ds_read_tr16_b64_v4i16((LAS v4i16_t*)(vq + 32)), hi = __builtin_amdgcn_ds_read_tr16_b64_v4i16((LAS v4i16_t*)(vq + 8 * VSP + 32));
                const bf16x8 af = {lo[0], lo[1], lo[2], lo[3], hi[0], hi[1], hi[2], hi[3]};
                o1 = __builtin_amdgcn_mfma_f32_32x32x16_bf16(af, pf, o1, 0, 0, 0); }
        }
    }
    const float ltot = lrun + __shfl_xor(lrun, 32);
    const float inv = 1.0f / ltot;
    bf16_t* op = (bf16_t*)(ws + WS_OPART) + (size_t)tq * DQ + h * 64 + 4 * hh;
#pragma unroll
    for (int q4 = 0; q4 < 4; ++q4) {
        u32x2 w0; w0.x = cvt_pk_bf16(o0[4 * q4 + 0] * inv, o0[4 * q4 + 1] * inv); w0.y = cvt_pk_bf16(o0[4 * q4 + 2] * inv, o0[4 * q4 + 3] * inv);
        u32x2 w1; w1.x = cvt_pk_bf16(o1[4 * q4 + 0] * inv, o1[4 * q4 + 1] * inv); w1.y = cvt_pk_bf16(o1[4 * q4 + 2] * inv, o1[4 * q4 + 3] * inv);
        *(u32x2*)(op + 8 * q4) = w0; *(u32x2*)(op + 32 + 8 * q4) = w1;
    }
    if (hh == 0) ((float*)(ws + WS_LSE))[(size_t)tq * 12 + h] = (__builtin_amdgcn_logf(ltot) + ATT_C2) * LN2;
}

struct CbRow { float l0, l1, l2; u32x2 w0, w1, w2; };
__device__ __forceinline__ CbRow combine_load(ArgsP a, int m, int lane) {
    unsigned char* ws = a->ws;
    const int hs = lane >> 4, d4 = 4 * (lane & 15);
    const float* ls = (const float*)(ws + WS_LSE) + (size_t)m * 12 + hs;
    const bf16_t* op = (const bf16_t*)(ws + WS_OPART) + (size_t)m * DQ + hs * 64 + d4;
    CbRow R; R.l0 = ls[0]; R.l1 = ls[4]; R.l2 = ls[8]; R.w0 = *(const u32x2*)op; R.w1 = *(const u32x2*)(op + 256); R.w2 = *(const u32x2*)(op + 512);
    return R;
}
__device__ __forceinline__ void combine_row(ArgsP a, int m, int lane, const CbRow& R) {
    unsigned char* ws = a->ws;
    const int hs = lane >> 4, d4 = 4 * (lane & 15);
    const float l0 = R.l0, l1 = R.l1, l2 = R.l2;
    const float mx = fmaxf(l0, fmaxf(l1, l2));
    float e0 = __expf(l0 - mx), e1 = __expf(l1 - mx), e2 = __expf(l2 - mx);
    const float inv = 1.0f / (e0 + e1 + e2); e0 *= inv; e1 *= inv; e2 *= inv;
    const u32x2 w0 = R.w0, w1 = R.w1, w2 = R.w2;
    const float r0 = e0 * bf_lo(w0.x) + e1 * bf_lo(w1.x) + e2 * bf_lo(w2.x), r1 = e0 * bf_hi(w0.x) + e1 * bf_hi(w1.x) + e2 * bf_hi(w2.x);
    const float r2 = e0 * bf_lo(w0.y) + e1 * bf_lo(w1.y) + e2 * bf_lo(w2.y), r3 = e0 * bf_hi(w0.y) + e1 * bf_hi(w1.y) + e2 * bf_hi(w2.y);
    u32x2 o; o.x = cvt_pk_bf16(r0, r1); o.y = cvt_pk_bf16(r2, r3);
    *(u32x2*)((bf16_t*)(ws + WS_ACTB) + (size_t)m * 256 + hs * 64 + d4) = o;
}

constexpr int CT = 32;
template <bool EDGE>
__device__ __forceinline__ void convpool_unit(ArgsP a, LAS unsigned char* lds, int l, int mbase, int s, int t0, int nt, int tid, int lane, int wave) {
    unsigned char* ws = a->ws;
    LAS bf16_t* Gs = (LAS bf16_t*)lds;
    LAS float* CV = (LAS float*)lds;
    LAS bf16_t* Zs = (LAS bf16_t*)(lds + 49152);
    const bf16_t* glub = (const bf16_t*)(ws + WS_GLU) + (size_t)mbase * 384;
    const bf16_t* zd = (const bf16_t*)(ws + WS_Z) + (size_t)mbase * ZP + ZD;
    float w[31]; float cb = 0.f;
    if (tid < 384) {
        const float* cw = a->in[IN_CONVW] + (size_t)l * 31 * 384 + tid;
#pragma unroll
        for (int k = 0; k < 31; ++k) w[k] = cw[k * 384];
        cb = a->in[IN_CONVB][l * 384 + tid];
    }
    __builtin_amdgcn_sched_barrier(0);
    if constexpr (!EDGE) {
        constexpr int NCH = (62 + 47) * 48, NIT = (NCH + 511) / 512;
        u32x4 v[NIT];
#pragma unroll
        for (int k = 0; k < NIT; ++k) {
            int i = tid + 512 * k; i = i < NCH ? i : NCH - 1;
            const bool isg = i < 62 * 48; const int kk = isg ? i : i - 62 * 48; const int r = kk / 48, c8 = kk - r * 48;
            v[k] = isg ? *(const u32x4*)(glub + (size_t)(t0 - 30 + r) * 384 + 8 * c8) : *(const u32x4*)(zd + (size_t)(t0 - 15 + r) * ZP + 8 * c8);
        }
#pragma unroll
        for (int k = 0; k < NIT; ++k) {
            const int i = tid + 512 * k;
            if (i < NCH) { const bool isg = i < 62 * 48; const int kk = isg ? i : i - 62 * 48; const int r = kk / 48, c8 = kk - r * 48; *(LAS u32x4*)((isg ? Gs : Zs) + r * 384 + 8 * c8) = v[k]; }
        }
    } else {
        for (int i = tid; i < (62 + 47) * 48; i += 512) {
            const bool isg = i < 62 * 48; const int k = isg ? i : i - 62 * 48; const int r = k / 48, c8 = k - r * 48;
            const int tt = isg ? t0 - 30 + r : t0 - 15 + r;
            u32x4 v = {0u, 0u, 0u, 0u};
            if (tt >= 0) { if (tt < t0 + nt) v = isg ? *(const u32x4*)(glub + (size_t)tt * 384 + 8 * c8) : *(const u32x4*)(zd + (size_t)tt * ZP + 8 * c8); }
            else if (s >= 0) {
                const float* p = isg ? a->in[IN_SCONV] + ((size_t)(l * 32 + s) * 30 + 30 + tt) * 384 + 8 * c8 : a->in[IN_SPOOL] + ((size_t)(l * 32 + s) * 15 + 15 + tt) * 384 + 8 * c8;
                const f32x4 x0 = *(const f32x4*)p, x1 = *(const f32x4*)(p + 4);
                v.x = cvt_pk_bf16(x0[0], x0[1]); v.y = cvt_pk_bf16(x0[2], x0[3]); v.z = cvt_pk_bf16(x1[0], x1[1]); v.w = cvt_pk_bf16(x1[2], x1[3]);
            }
            *(LAS u32x4*)((isg ? Gs : Zs) + r * 384 + 8 * c8) = v;
        }
    }
    __syncthreads();
    if (tid < 384) {
        const int c = tid;
        float x[CT + 30];
#pragma unroll
        for (int r = 0; r < CT + 30; ++r) x[r] = bf1(Gs[r * 384 + c]);
        asm volatile("s_waitcnt lgkmcnt(0)" ::: "memory");
        __syncthreads();
#pragma unroll
        for (int q = 0; q < CT; ++q) {
            float acc = cb;
#pragma unroll
            for (int k = 0; k < 31; ++k) acc += w[k] * x[q + k];
            CV[q * 384 + c] = acc;
        }
    } else {
        __syncthreads();
        const int c0 = tid - 384;
#pragma unroll 1
        for (int q3 = 0; q3 < 3; ++q3) {
            const int c = c0 + 128 * q3, wg = c / 96;
            float x[CT + 15];
#pragma unroll
            for (int r = 0; r < CT + 15; ++r) x[r] = bf1(Zs[r * 384 + c]);
            float lv[CT + 15], res[CT];
#pragma unroll
            for (int i = 0; i < CT + 15; ++i) lv[i] = x[i];
#pragma unroll
            for (int i = CT + 14; i >= 1; --i) lv[i] += lv[i - 1];
#pragma unroll
            for (int q = 0; q < CT; ++q) res[q] = lv[15 + q];
#pragma unroll
            for (int i = CT + 14; i >= 2; --i) lv[i] += lv[i - 2];
#pragma unroll
            for (int q = 0; q < CT; ++q) res[q] = wg >= 1 ? lv[15 + q] : res[q];
#pragma unroll
            for (int i = CT + 14; i >= 4; --i) lv[i] += lv[i - 4];
#pragma unroll
            for (int q = 0; q < CT; ++q) res[q] = wg >= 2 ? lv[15 + q] : res[q];
#pragma unroll
            for (int i = CT + 14; i >= 8; --i) lv[i] += lv[i - 8];
#pragma unroll
            for (int q = 0; q < CT; ++q) res[q] = wg >= 3 ? lv[15 + q] : res[q];
            const int wlen = 2 << wg;
            bf16_t* op = (bf16_t*)(ws + WS_ACTD) + (size_t)(mbase + t0) * 384 + c;
#pragma unroll
            for (int q = 0; q < CT; ++q) {
                const int cnt = (s < 0) ? min(wlen, t0 + q + 1) : wlen;
                const float pv = res[q] / (float)cnt - x[15 + q];
                if (q < nt) op[(size_t)q * 384] = (bf16_t)(cvt_pk_bf16(pv, 0.f) & 0xffffu);
            }
        }
    }
    float lg[6], lb[6];
    { const float* gp = a->in[IN_CLNG] + l * 384 + lane; const float* bp = a->in[IN_CLNB] + l * 384 + lane;
#pragma unroll
      for (int i = 0; i < 6; ++i) { lg[i] = gp[64 * i]; lb[i] = bp[64 * i]; } }
    __syncthreads();
    for (int tt = wave; tt < nt; tt += 8) {
        float x[6]; float sm = 0.f;
#pragma unroll
        for (int i = 0; i < 6; ++i) { x[i] = CV[tt * 384 + lane + 64 * i]; sm += x[i]; }
        const float mean = wave_sum(sm) * (1.0f / 384.0f);
        float sv = 0.f;
#pragma unroll
        for (int i = 0; i < 6; ++i) { x[i] -= mean; sv += x[i] * x[i]; }
        const float rstd = rsqrtf(wave_sum(sv) * (1.0f / 384.0f) + LN_EPS);
        bf16_t* o = (bf16_t*)(ws + WS_ACTA) + (size_t)(mbase + t0 + tt) * 384;
#pragma unroll
        for (int i = 0; i < 6; ++i) { const int c = lane + 64 * i; const float y = x[i] * rstd * lg[i] + lb[i]; o[c] = (bf16_t)(cvt_pk_bf16(y * sigmoidf_(y), 0.f) & 0xffffu); }
    }
    __syncthreads();
}

__device__ __forceinline__ void sgu_unit(ArgsP a, LAS unsigned char* lds, int l, int m0, int L, int g, int tid) {
    unsigned char* ws = a->ws;
    LAS float* V = (LAS float*)lds;
    LAS float* Wt = (LAS float*)(lds + 128 * 96 * 4);
    const bf16_t* vln = (const bf16_t*)(ws + WS_VLN); const bf16_t* z = (const bf16_t*)(ws + WS_Z);
    for (int i = tid; i < L * 12; i += 512) {
        const int j = i / 12, c8 = i - j * 12; float v[8]; unpack8(*(const u32x4*)(vln + (size_t)(m0 + j) * 384 + g * 96 + 8 * c8), v);
        *(LAS f32x4*)(V + j * 96 + 8 * c8) = (f32x4){v[0], v[1], v[2], v[3]}; *(LAS f32x4*)(V + j * 96 + 8 * c8 + 4) = (f32x4){v[4], v[5], v[6], v[7]};
    }
    const float* sw = a->in[IN_SGUW] + ((size_t)(l * 4 + g) * 128) * 128;
    const int L4 = L / 4;
    for (int i = tid; i < L * L4; i += 512) { const int r = i / L4, j4 = i - r * L4; *(LAS f32x4*)(Wt + r * 128 + 4 * j4) = *(const f32x4*)(sw + (size_t)r * 128 + 4 * j4); }
    __syncthreads();
    if (tid < 384) {
        const int c = tid % 96, iq = tid / 96;
        for (int i = iq; i < L; i += 4) {
            float acc = a->in[IN_SGUB][(l * 4 + g) * 128 + i];
            for (int j = 0; j <= i; ++j) acc += Wt[i * 128 + j] * V[j * 96 + c];
            const float u = bf1(z[(size_t)(m0 + i) * ZP + ZU + g * 96 + c]);
            ((bf16_t*)(ws + WS_ACTC))[(size_t)(m0 + i) * 384 + g * 96 + c] = (bf16_t)(cvt_pk_bf16(u * acc, 0.f) & 0xffffu);
        }
    }
    __syncthreads();
}

template <int IT>
__device__ __forceinline__ void sgu_mfma_tile(ArgsP a, int l, int m0, int g, int ct, int lane) {
    unsigned char* ws = a->ws;
    const int c = lane & 31, hh = lane >> 5;
    const bf16_t* wsb = (const bf16_t*)(ws + WS_SGUW) + ((size_t)(l * 4 + g) * 128 + 32 * IT + c) * 128 + 8 * hh;
    const bf16_t* vp = (const bf16_t*)(ws + WS_VLN) + ((size_t)(m0 >> 7) * 384 + g * 96 + 32 * ct + c) * 128 + 8 * hh;
    f32x16 acc;
#pragma unroll
    for (int i = 0; i < 16; ++i) acc[i] = 0.f;
    constexpr int NST = 2 * (IT + 1);
    bf16x8 afr[NST], bfr[NST];
#pragma unroll
    for (int st = 0; st < NST; ++st) { bfr[st] = *(const bf16x8*)(wsb + 16 * st); afr[st] = *(const bf16x8*)(vp + 16 * st); }
#pragma unroll
    for (int st = 0; st < NST; ++st) acc = __builtin_amdgcn_mfma_f32_32x32x16_bf16(afr[st], bfr[st], acc, 0, 0, 0);
    const int tok = m0 + 32 * IT + c;
    const float bias = a->in[IN_SGUB][(l * 4 + g) * 128 + 32 * IT + c];
    const bf16_t* up = (const bf16_t*)(ws + WS_Z) + (size_t)tok * ZP + ZU + g * 96 + 32 * ct + 4 * hh;
    bf16_t* op = (bf16_t*)(ws + WS_ACTC) + (size_t)tok * 384 + g * 96 + 32 * ct + 4 * hh;
#pragma unroll
    for (int q4 = 0; q4 < 4; ++q4) {
        const u32x2 uw = *(const u32x2*)(up + 8 * q4);
        u32x2 o; o.x = cvt_pk_bf16(bf_lo(uw.x) * (acc[4 * q4 + 0] + bias), bf_hi(uw.x) * (acc[4 * q4 + 1] + bias)); o.y = cvt_pk_bf16(bf_lo(uw.y) * (acc[4 * q4 + 2] + bias), bf_hi(uw.y) * (acc[4 * q4 + 3] + bias));
        *(u32x2*)(op + 8 * q4) = o;
    }
}
__device__ __forceinline__ void sgu_mfma_unit(ArgsP a, int l, int m0, int g, int lane, int wave) {
    if (wave < 3) sgu_mfma_tile<3>(a, l, m0, g, wave, lane);
    else if (wave < 6) { sgu_mfma_tile<2>(a, l, m0, g, wave - 3, lane); sgu_mfma_tile<0>(a, l, m0, g, wave - 3, lane); }
    else if (wave == 6) { sgu_mfma_tile<1>(a, l, m0, g, 0, lane); sgu_mfma_tile<1>(a, l, m0, g, 1, lane); }
    else sgu_mfma_tile<1>(a, l, m0, g, 2, lane);
}

constexpr int NU_ATTP = NT_ATTP / 8;
constexpr int NU_ATTS = MS * 12 / 8;
constexpr int NU_ATT = NU_ATTP + NU_ATTS;
constexpr int NU_SGU = 128 * 4 + 32 * 4;
constexpr int NU_CONV = MP / CT + 32;
constexpr int NU_MIX = NU_ATT + NU_SGU + NU_CONV;
#ifndef MIX_EXTRA_LO
#define MIX_EXTRA_LO 0
#define MIX_EXTRA_HI 0
#endif

__device__ __forceinline__ void p3_mixer(ArgsP a, LAS unsigned char* lds, int l, int tid, int lane, int wave, int G, int bid) {
    LAS float* tab = (LAS float*)(lds + TAB_OFF);
    for (int i = tid; i < 12 * 132; i += 512) { const int h = i / 132, j = i - h * 132; tab[i] = (j <= 128) ? a->in[IN_RELB][(int)T5_BUCKET[h >> 2][j] * 12 + h] * LOG2E - ATT_C2 : 0.f; }
    __syncthreads();
    const int vcu = (G % 8 == 0) ? (bid % 8) * (G / 8) + bid / 8 : bid;
    for (int u = vcu; u < NU_MIX + (MIX_EXTRA_HI - MIX_EXTRA_LO); u += G) {
        int r = u < NU_MIX ? u : MIX_EXTRA_LO + (u - NU_MIX);
        if (r < NU_ATTP) { attn_mfma_unit(a, lds, l, r, tid, lane, wave, tab); __syncthreads(); continue; } r -= NU_ATTP;
        if (r < NU_ATTS) { const int task = r * 8 + wave; attn_sample_task(a, l, MP + task / 12, task % 12, lane, tab); continue; } r -= NU_ATTS;
        if (r < NU_SGU) { if (r < 512) sgu_mfma_unit(a, l, (r >> 2) * 128, r & 3, lane, wave); else { r -= 512; sgu_unit(a, lds, l, MP + (r >> 2) * 8, 8, r & 3, tid); } continue; } r -= NU_SGU;
        if (r == 0) convpool_unit<true>(a, lds, l, 0, -1, 0, CT, tid, lane, wave); else if (r < MP / CT) convpool_unit<false>(a, lds, l, 0, -1, r * CT, CT, tid, lane, wave); else { r -= MP / CT; convpool_unit<true>(a, lds, l, MP + r * 8, r, 0, 8, tid, lane, wave); }
    }
}


__device__ __forceinline__ void small_gemm_tile(LAS unsigned char* lds, const pg8::Gemm& g, const pg8::Epi& e, int mt, int nt, int tid, int lane, int wave) {
    const int K = g.K, kw = K >> 3, nsteps = kw >> 4;
    const int c = lane & 31, hh = lane >> 5;
    const bf16_t* ap = g.A + (size_t)(MP + 32 * mt + c) * K + wave * kw + 8 * hh;
    const bf16_t* bp = g.Bt + (size_t)(32 * nt + c) * K + wave * kw + 8 * hh;
    f32x16 acc;
#pragma unroll
    for (int i = 0; i < 16; ++i) acc[i] = 0.f;
    for (int s0 = 0; s0 < nsteps; s0 += 8) {
        bf16x8 af[8], bf[8];
#pragma unroll
        for (int i = 0; i < 8; ++i) { const int st = (s0 + i < nsteps) ? s0 + i : nsteps - 1; af[i] = *(const bf16x8*)(ap + 16 * st); bf[i] = *(const bf16x8*)(bp + 16 * st); }
#pragma unroll
        for (int i = 0; i < 8; ++i) { const bf16x8 zz = {0, 0, 0, 0, 0, 0, 0, 0}; const bf16x8 aa = (s0 + i < nsteps) ? af[i] : zz; acc = __builtin_amdgcn_mfma_f32_32x32x16_bf16(bf[i], aa, acc, 0, 0, 0); }
    }
    LAS float* P = (LAS float*)lds;
#pragma unroll
    for (int i = 0; i < 16; ++i) P[(wave * 16 + i) * 64 + lane] = acc[i];
    __syncthreads();
    if (tid < 128) {
        const int m = tid & 31, q4 = tid >> 5;
        f32x4 v0 = {0.f, 0.f, 0.f, 0.f}, v1 = {0.f, 0.f, 0.f, 0.f};
#pragma unroll
        for (int w = 0; w < 8; ++w)
#pragma unroll
            for (int j = 0; j < 4; ++j) { v0[j] += P[(w * 16 + 4 * q4 + j) * 64 + m]; v1[j] += P[(w * 16 + 4 * q4 + j) * 64 + 32 + m]; }
        const int row = MP + 32 * mt + m, col = 32 * nt + 8 * q4;
        const float r = e.needs_rstd() ? e.row_rstd(row) : 1.0f;
        const float ss = e.epi8(row, col, v0, v1, r, e.res_base(row));
        if ((e.mode == pg8::EP_RES || e.mode == pg8::EP_PLE) && e.rs_out) unsafeAtomicAdd(e.rs_out + row, ss);
    }
    __syncthreads();
}

enum { SUB_Z = 0, SUB_POSTZ = 1, SUB_MIX = 2, SUB_COMB = 3, SUB_BR = 4, SUB_WO = 5, SUB_GU = 6, SUB_DN = 7, SUB_PLE = 8, NSUB = 9 };
constexpr int N_PHASES = 1 + 2 * NSUB;
__device__ __forceinline__ int n_passes(int sub) { return sub == SUB_BR ? 4 : (sub == SUB_PLE ? 2 : 1); }
__device__ __forceinline__ void make_pass(ArgsP a, int l, int sub, int p, pg8::Gemm& g, pg8::Epi& e) {
    unsigned char* ws = a->ws; unsigned char* wl = ws + WS_W + (size_t)l * WL;
    float* rs = (float*)(ws + WS_CTL);
    bf16_t* xb = (bf16_t*)(ws + WS_XB); bf16_t* xb2 = (bf16_t*)(ws + WS_XB2); float* xres = (float*)(ws + WS_XRES); bf16_t* z = (bf16_t*)(ws + WS_Z);
    e.mode = 0; e.rowss = nullptr; e.ob = nullptr; e.ldb = 0; e.of = nullptr; e.rin_p = nullptr; e.rin_s = nullptr; e.rin_b = nullptr; e.rs_out = nullptr; e.gate8 = nullptr; e.pl = nullptr; e.mg = nullptr;
    g.M = (sub == SUB_Z || sub == SUB_GU) ? M : MP;
    if (sub == SUB_Z) {
        g.A = xb; g.Bt = (const bf16_t*)(wl + W_IN); g.N = NZ; g.K = D;
        e.mode = pg8::EP_Z; e.rowss = rs + (l == 0 ? RS_MIX0 : RS_MIX1) * RS_STRIDE; e.ob = z; e.ldb = ZP; e.gate8 = ws + WS_ZG8;
    } else if (sub == SUB_BR) {
        g.N = D;
        if (p == 0) { g.A = (const bf16_t*)(ws + WS_ACTA); g.Bt = (const bf16_t*)(wl + W_A); g.K = 384; e.mode = pg8::EP_BR_FIRST; }
        else if (p == 1) { g.A = (const bf16_t*)(ws + WS_ACTB); g.Bt = (const bf16_t*)(wl + W_B); g.K = 256; e.mode = pg8::EP_BR_MID; }
        else if (p == 2) { g.A = (const bf16_t*)(ws + WS_ACTC); g.Bt = (const bf16_t*)(wl + W_C); g.K = 384; e.mode = pg8::EP_BR_MID; }
        else { g.A = (const bf16_t*)(ws + WS_ACTD); g.Bt = (const bf16_t*)(wl + W_D); g.K = 384; e.mode = pg8::EP_BR_LAST; }
        e.gate8 = ws + WS_ZG8 + p * 1024; e.mg = (float*)(ws + WS_MG); e.ob = (bf16_t*)(ws + WS_MGB); e.ldb = D;
    } else if (sub == SUB_WO) {
        g.A = (const bf16_t*)(ws + WS_MGB); g.Bt = (const bf16_t*)(wl + W_O); g.N = D; g.K = D;
        e.mode = pg8::EP_RES; e.ob = xb2; e.ldb = D; e.rs_out = rs + (l == 0 ? RS_FFN0 : RS_FFN1) * RS_STRIDE;
        if (l == 0) { e.rin_p = a->in[IN_XP]; e.rin_s = a->in[IN_XS]; } else e.rin_b = xb;
    } else if (sub == SUB_GU) {
        g.A = xb2; g.Bt = (const bf16_t*)(wl + W_GU); g.N = 2 * DFF; g.K = D;
        e.mode = pg8::EP_GLU; e.rowss = rs + (l == 0 ? RS_FFN0 : RS_FFN1) * RS_STRIDE; e.ob = (bf16_t*)(ws + WS_HFF); e.ldb = DFF;
    } else if (sub == SUB_DN) {
        g.A = (const bf16_t*)(ws + WS_HFF); g.Bt = (const bf16_t*)(wl + W_DN); g.N = D; g.K = DFF;
        e.mode = pg8::EP_RES; e.ob = xb2; e.ldb = D; e.rs_out = rs + (l == 0 ? RS_PLE0 : RS_PLE1) * RS_STRIDE;
        e.rin_b = xb2;
    } else {
        g.N = D;
        if (p == 0) { g.A = (const bf16_t*)(ws + WS_PEB) + (size_t)l * M * DPLE; g.Bt = (const bf16_t*)(wl + W_PLE); g.K = DPLE; e.mode = pg8::EP_PL; e.ob = (bf16_t*)(ws + WS_PL); e.ldb = D; }
        else {
            g.A = xb2; g.Bt = (const bf16_t*)(wl + W_PG); g.K = D;
            e.mode = pg8::EP_PLE; e.rowss = rs + (l == 0 ? RS_PLE0 : RS_PLE1) * RS_STRIDE; e.pl = (const bf16_t*)(ws + WS_PL);
            e.rin_b = xb2;
            if (l == 0) { e.ob = xb; e.ldb = D; e.rs_out = rs + RS_MIX1 * RS_STRIDE; }
            else { e.of = a->out + O_YP; e.ob = nullptr; e.ldb = D; e.rs_out = nullptr; }
        }
    }
}


#ifndef MK_XCD_BARRIER
#define MK_XCD_BARRIER 1
#endif
constexpr int CW_BAR = 131072;
constexpr int LDS_BARST_OFF = LDS_BYTES - 64;
static_assert((CW_BAR + 3456) * 4 <= (int)CTL_ZERO_BYTES, "barrier words inside the memset region");
#define XB_TMO      128
#define XB_XCNT(j)  (256  + 64 * (j))
#define XB_XSUB(j)  (1280 + 64 * (j))
#define XB_XGEN(j)  (2304 + 64 * (j))
#define XB_TOP      3328
#define XB_TOPGEN   3392
#define XCD_BAR_WORDS 3456
#define XB_SPIN_CAP (1u << 18)

__device__ __forceinline__ unsigned xb_ld(unsigned* p)              { return __hip_atomic_load(p, __ATOMIC_RELAXED, __HIP_MEMORY_SCOPE_AGENT); }
__device__ __forceinline__ unsigned xb_add(unsigned* p, unsigned v) { return __hip_atomic_fetch_add(p, v, __ATOMIC_RELAXED, __HIP_MEMORY_SCOPE_AGENT); }
__device__ __forceinline__ unsigned xb_xcc_id() { return (unsigned)__builtin_amdgcn_s_getreg((3 << 11) | 20) & 0xFu; }
#define XB_SPIN(cond, bar) do { unsigned _sp = 0; while (cond) { __builtin_amdgcn_s_sleep(1); \
    if ((++_sp & 255u) == 0u) { if (xb_ld(&(bar)[XB_TMO])) break; if (_sp > XB_SPIN_CAP) { atomicAdd(&(bar)[XB_TMO], 1u); break; } } } } while (0)

struct XcdBarrier {
    unsigned* bar; unsigned x;
    volatile LAS unsigned* st;
};

__device__ __forceinline__ XcdBarrier xcd_barrier_post(unsigned* bar, volatile LAS unsigned* st) {
    XcdBarrier b; b.bar = bar; b.x = xb_xcc_id(); b.st = st;
    if (threadIdx.x == 0) (void)xb_add(&bar[XB_XCNT(b.x)], 1u);
    return b;
}
__device__ __forceinline__ void xcd_barrier_complete(unsigned* bar, unsigned x, unsigned& nloc, unsigned& nx) {
    const unsigned G = gridDim.x * gridDim.y * gridDim.z;
    unsigned sum, cnt, mine, sp = 0u;
    for (;;) {
        sum = 0u; cnt = 0u; mine = 0u;
#pragma unroll
        for (unsigned j = 0; j < 16; ++j) { const unsigned c = xb_ld(&bar[XB_XCNT(j)]); sum += c; cnt += (c > 0u) ? 1u : 0u; mine = (j == x) ? c : mine; }
        if (sum == G) break;
        __builtin_amdgcn_s_sleep(1);
        if ((++sp & 255u) == 0u) { if (xb_ld(&bar[XB_TMO])) break; if (sp > XB_SPIN_CAP) { atomicAdd(&bar[XB_TMO], 1u); break; } }
    }
    nloc = mine > 0u ? mine : 1u; nx = cnt > 0u ? cnt : 1u;
}

__device__ __forceinline__ void xcd_barrier(const XcdBarrier& b) {
    asm volatile("s_waitcnt vmcnt(0)" ::: "memory");
    __syncthreads();
    if (threadIdx.x == 0) {
        unsigned* bar = b.bar;
        __builtin_amdgcn_s_waitcnt(0);
        unsigned nloc = b.st[0], nx = b.st[1];
        if (nloc == 0u) { xcd_barrier_complete(bar, b.x, nloc, nx); b.st[0] = nloc; b.st[1] = nx; }
        const unsigned old = xb_add(&bar[XB_XSUB(b.x)], 1u);
        const unsigned gen = old / nloc;
        if (old + 1u == (gen + 1u) * nloc) {
            __builtin_amdgcn_fence(__ATOMIC_RELEASE, "agent");
            asm volatile("s_waitcnt vmcnt(0)" ::: "memory");
            const unsigned og = xb_add(&bar[XB_TOP], 1u);
            const unsigned tg = og / nx;
            if (og + 1u == (tg + 1u) * nx) xb_add(&bar[XB_TOPGEN], 1u);
            else XB_SPIN(xb_ld(&bar[XB_TOPGEN]) == tg, bar);
            __builtin_amdgcn_fence(__ATOMIC_ACQUIRE, "agent");
            xb_add(&bar[XB_XGEN(b.x)], 1u);
            asm volatile("s_waitcnt vmcnt(0)" ::: "memory");
        } else {
            XB_SPIN(xb_ld(&bar[XB_XGEN(b.x)]) == gen, bar);
            __builtin_amdgcn_fence(__ATOMIC_ACQUIRE, "agent");
            asm volatile("s_waitcnt vmcnt(0)" ::: "memory");
        }
    }
    __syncthreads();
}


constexpr int Z0_SPLIT_ROUNDS = 8;
#ifndef WGM_WIDE
#define WGM_WIDE 2
#define WGM_NARROW 8
#endif
__device__ __forceinline__ int phase_reps(int ph, int sub) {
    return ph == 0 ? REP_P0 : sub == SUB_Z ? REP_Z : sub == SUB_POSTZ ? REP_POSTZ : sub == SUB_MIX ? REP_MIX : sub == SUB_COMB ? REP_COMB : sub == SUB_BR ? REP_BR : sub == SUB_GU ? REP_GU : 1;
}
__global__ void __launch_bounds__(512, 2) mega_fwd(Args a) {
    extern __shared__ __attribute__((aligned(16))) unsigned char lds_raw[];
    LAS unsigned char* lds = (LAS unsigned char*)lds_raw;
    const int G = gridDim.x, bid = blockIdx.x;
    const int ph_lo = a.ph_lo, ph_hi = a.ph_hi;
#if MK_XCD_BARRIER
    if (threadIdx.x < 2) ((volatile LAS unsigned*)(lds + LDS_BARST_OFF))[threadIdx.x] = 0u;
    __syncthreads();
    (void)xcd_barrier_post((unsigned*)(((ArgsP)__builtin_amdgcn_kernarg_segment_ptr())->ws + WS_CTL) + CW_BAR, (volatile LAS unsigned*)(lds + LDS_BARST_OFF));
#else
    cg::grid_group grid = cg::this_grid();
#endif
    for (int ph = ph_lo; ph < ph_hi; ++ph) {
#if MK_XCD_BARRIER
        if (ph > ph_lo) {
            XcdBarrier xb; xb.bar = (unsigned*)(((ArgsP)__builtin_amdgcn_kernarg_segment_ptr())->ws + WS_CTL) + CW_BAR; xb.x = xb_xcc_id(); xb.st = (volatile LAS unsigned*)(lds + LDS_BARST_OFF);
            xcd_barrier(xb);
        }
#else
        if (ph > ph_lo) grid.sync();
#endif
        ArgsP ap = (ArgsP)__builtin_amdgcn_kernarg_segment_ptr(); asm volatile("" : "+s"(ap));
        int tid = threadIdx.x; asm volatile("" : "+v"(tid));
        const int lane = tid & 63, wave = __builtin_amdgcn_readfirstlane(tid >> 6);
        if (ph == 0 || (ph == 1 && G == 256 && bid >= 128)) {
            p0_prologue(ap, lds, tid, lane, wave, ph == 0 ? G : 128, ph == 0 ? bid : bid - 128, ph == 0 ? (G == 256 ? 0 : 2) : 1, ph == 1);
            if (ph == 0) continue;
            __syncthreads();
        }
        const int l = (ph - 1) / NSUB, sub = (ph - 1) - l * NSUB;
        if (sub == SUB_POSTZ) {
            for (int rep = 0; rep < REP_POSTZ; ++rep) {
                for (int t8 = bid * 8 + wave; t8 < MP / 8; t8 += G * 8) postz_rows8(ap, l, t8 * 8, lane);
                for (int m = MP + bid * 8 + wave; m < M; m += G * 8) { const PzRow R = postz_load(ap, m, lane); __builtin_amdgcn_sched_barrier(0); (void)postz_row(ap, l, m, lane, R); }
            }
            continue;
        }
        if (sub == SUB_MIX) { p3_mixer(ap, lds, l, tid, lane, wave, G, bid); __syncthreads(); continue; }
        if (sub == SUB_COMB) { for (int rep = 0; rep < REP_COMB; ++rep) {
                int m = bid * 8 + wave; if (m >= M) continue;
                CbRow cur = combine_load(ap, m, lane);
                for (; m < M; m += G * 8) { const int mn = m + G * 8; CbRow nxt = cur; if (mn < M) nxt = combine_load(ap, mn, lane); __builtin_amdgcn_sched_barrier(0); combine_row(ap, m, lane, cur); cur = nxt; }
            } continue; }
        const int np = n_passes(sub);
        const int nrep = phase_reps(ph, sub) + ((DRY_SUB >= 0 && sub == DRY_SUB) ? 1 : 0);
        const int nmain = (sub == SUB_BR ? 1 : np) * nrep;
        for (int pp = 0; pp < nmain; ++pp) {
            const int p = (sub == SUB_BR) ? 0 : pp % np;
            pg8::Gemm g; pg8::Epi e; pg8::SegSched S;
            make_pass(ap, l, sub, p, g, e);
#if DRY_SUB >= 0
            if (sub == DRY_SUB && pp < np) {
                if (e.ob) e.ob = (bf16_t*)(ap->ws + WS_XRES); if (e.of) e.of = (float*)(ap->ws + WS_MG); if (e.rs_out) e.rs_out = (float*)(ap->ws + WS_CTL) + 6 * RS_STRIDE;
            }
#endif
            S.nseg = 1; S.A0 = g.A; S.B0 = g.Bt; S.K0 = g.K; S.ws = ap->ws; S.wl = ap->ws + WS_W + (size_t)l * WL;
            if (sub == SUB_BR) { S.nseg = 4; e.mode = pg8::EP_BRC; }
            S.so.init(g.M, g.N, G, bid, (g.N > D) ? WGM_WIDE : WGM_NARROW);
            S.split_rounds = 0;
            if (G == 256 && sub == SUB_Z && l == 0 && pp == 0) {
                S.split_rounds = Z0_SPLIT_ROUNDS;
            }
            if (G == 256 && (sub == SUB_Z || sub == SUB_GU) && pp == 0 && !(sub == SUB_Z && l == 0)) {
                const int nwg = (g.M / 256) * (g.N / 256), rem = nwg - (nwg / G) * G;
                if (bid >= rem) {
                    const int k = bid - rem, Q = (sub == SUB_Z) ? STAG_Q_Z : STAG_Q_GU;
                    const int base = ((sub == SUB_GU) ? STAG_TOT_Z : 0) + l * (STAG_TOT_Z + STAG_TOT_GU);
                    const int lo = base + Q * (k * (k - 1) / 2);
                    cache_copy_range(ap, lo, lo + Q * k, tid, 512);
                }
            }
            const bool has_small = (sub != SUB_BR && g.M == MP);
            const bool small_first = has_small && ((bid >> 3) & 1);
#pragma unroll 1
            for (int step = 0; step < 2; ++step) {
                if ((step == 0) != small_first) pg8::gemm_phase<pg8::Epi, pg8::SegSched, true>(lds, S, e, tid);
                else if (has_small) { for (int tile = bid; tile < 256; tile += G) small_gemm_tile(lds, g, e, tile >> 5, tile & 31, tid, lane, wave); }
            }
        }
        if (sub == SUB_BR) {
            for (int pp = 0; pp < 4 * nrep; ++pp) {
                pg8::Gemm g; pg8::Epi e; make_pass(ap, l, sub, pp & 3, g, e);
                for (int tile = bid; tile < 256; tile += G) small_gemm_tile(lds, g, e, tile >> 5, tile & 31, tid, lane, wave);
            }
        }
    }
}

extern "C" void kernel_launch(void* const* d_in, const int* in_sizes, int n_in, void* d_out, int out_size, void* d_ws, size_t ws_size, hipStream_t stream) {
    static int grid = 0;
    if (grid == 0) {
        if (n_in != 36 || (size_t)out_size != O_END || ws_size < WS_END) { fprintf(stderr, "kernel_launch: unexpected shapes: n_in %d out %d ws %zu (need %zu)\n", n_in, out_size, ws_size, (size_t)WS_END); grid = -1; return; }
        int dev = 0, cus = 0, per_cu = 0;
        if (hipGetDevice(&dev) != hipSuccess || hipDeviceGetAttribute(&cus, hipDeviceAttributeMultiprocessorCount, dev) != hipSuccess) { grid = -1; return; }
        if (hipFuncSetAttribute((const void*)mega_fwd, hipFuncAttributeMaxDynamicSharedMemorySize, LDS_BYTES) != hipSuccess) { fprintf(stderr, "kernel_launch: hipFuncSetAttribute failed\n"); grid = -1; return; }
        if (hipOccupancyMaxActiveBlocksPerMultiprocessor(&per_cu, (const void*)mega_fwd, 512, LDS_BYTES) != hipSuccess || per_cu < 1) { fprintf(stderr, "kernel_launch: occupancy query says %d blocks per CU\n", per_cu); per_cu = 1; }
        (void)hipGetLastError();
        grid = cus;
    }
    if (grid < 0) return;
    (void)hipMemsetAsync((char*)d_ws + WS_CTL, 0, CTL_ZERO_BYTES, stream);
    Args a{};
    for (int i = 0; i < 36; ++i) a.in[i] = (const float*)d_in[i];
    a.out = (float*)d_out; a.ws = (unsigned char*)d_ws;
#if MK_ONE_LAUNCH
    a.ph_lo = 0; a.ph_hi = N_PHASES;
    void* args[] = {&a};
    hipError_t e = hipLaunchCooperativeKernel((const void*)mega_fwd, dim3(grid), dim3(512), args, LDS_BYTES, stream);
    if (e != hipSuccess) fprintf(stderr, "cooperative launch failed: %s (grid %d)\n", hipGetErrorString(e), grid);
#else
    for (int ph = 0; ph < N_PHASES; ++ph) {
        a.ph_lo = ph; a.ph_hi = ph + 1;
        hipLaunchKernelGGL(mega_fwd, dim3(grid), dim3(512), LDS_BYTES, stream, a);
    }
#endif
}
```

```cpp
#include <hip/hip_runtime.h>
#include <hip/hip_cooperative_groups.h>
#include <cstdio>
#include <cstdint>
namespace cg = cooperative_groups;

#ifndef MK_ONE_LAUNCH
#define MK_ONE_LAUNCH 1
#endif

#ifndef REP_P0
#define REP_P0 1
#endif
#ifndef DRY_SUB
#define DRY_SUB -1
#endif
#ifndef P0R_T
#define P0R_T 1
#define P0R_X 1
#define P0R_C 1
#endif
#ifndef REP_Z
#define REP_Z 1
#endif
#ifndef REP_POSTZ
#define REP_POSTZ 1
#endif
#ifndef REP_MIX
#define REP_MIX 1
#endif
#ifndef REP_COMB
#define REP_COMB 1
#endif
#ifndef REP_BR
#define REP_BR 1
#endif
#ifndef REP_GU
#define REP_GU 1
#endif
constexpr int D = 1024, TP = 16384, NSEQ = 32, TS = 8, MP = TP, MS = NSEQ * TS, M = MP + MS;
constexpr int DC = 384, NH = 12, HD = 64, DQ = NH * HD, DFF = 2816, DPLE = 256, DIN = 8320, NZ = 8448, ZP = 4352;
constexpr int ZA = 0, ZB = 384, ZQ = 768, ZK = 1536, ZV = 2304, ZU = 3072, ZVV = 3456, ZD = 3840, ZG = 4224;
constexpr float EPS = 1e-6f, LN_EPS = 1e-5f;
constexpr float LOG2E = 1.4426950408889634f, LN2 = 0.6931471805599453f, ATT_C2 = 12.0f;

constexpr size_t O_YP = 0, O_YS = O_YP + (size_t)MP * D, O_KVP0 = O_YS + (size_t)MS * D,
    O_KVP1 = O_KVP0 + 2ull * 128 * 512, O_KVP2 = O_KVP1 + 2ull * 512 * 512, O_CONVP = O_KVP2 + 2ull * 2048 * 512,
    O_POOLP = O_CONVP + 2ull * 30 * 384, O_KVS0 = O_POOLP + 2ull * 15 * 384, O_KVS1 = O_KVS0 + 2ull * 32 * 128 * 512,
    O_KVS2 = O_KVS1 + 2ull * 32 * 512 * 512, O_CONVS = O_KVS2 + 2ull * 32 * 2048 * 512, O_POOLS = O_CONVS + 2ull * 32 * 30 * 384,
    O_SGUS = O_POOLS + 2ull * 32 * 15 * 384, O_END = O_SGUS + 2ull * 32 * 8 * 384;
static_assert(O_END == 109209344ull, "output size");

constexpr size_t MiB = 1u << 20;
constexpr size_t WS_CTL = 0, CTL_ZERO_BYTES = 1 * MiB;
constexpr size_t WS_W = 2 * MiB, WL = 44 * MiB;
constexpr size_t W_IN = 0, W_A = 17 * MiB, W_B = 18 * MiB, W_C = 19 * MiB, W_D = 20 * MiB, W_O = 21 * MiB, W_GU = 23 * MiB, W_DN = 34 * MiB, W_PG = 40 * MiB, W_PLE = 42 * MiB;
constexpr size_t WS_XB = 90 * MiB;
constexpr size_t WS_XRES = 123 * MiB;
constexpr size_t WS_Z = 188 * MiB;
constexpr size_t WS_ZG8 = 340 * MiB;
static_assert(WS_Z + (size_t)M * ZP * 2 <= WS_ZG8 && WS_ZG8 + (size_t)M * 4096 <= 457 * MiB, "ws map z");
constexpr size_t WS_PEB = 457 * MiB;
constexpr size_t WS_GLU = 474 * MiB;
constexpr size_t WS_QN = 487 * MiB;
constexpr size_t WS_KN = 512 * MiB;
constexpr size_t WS_VLN = 537 * MiB;
constexpr size_t WS_ACTA = 550 * MiB, WS_ACTB = 563 * MiB, WS_ACTC = 572 * MiB, WS_ACTD = 585 * MiB;
constexpr size_t WS_MG = 598 * MiB;
constexpr size_t WS_MGB = 663 * MiB;
constexpr size_t WS_HFF = 696 * MiB;
constexpr size_t WS_PL = 786 * MiB;
constexpr size_t WS_OPART = 852 * MiB;
constexpr size_t WS_LSE = 877 * MiB;
constexpr size_t WS_XB2 = 879 * MiB;
constexpr size_t WS_SGUW = 912 * MiB;
constexpr size_t WS_END = 913 * MiB;
static_assert(WS_XB2 + (size_t)M * D * 2 <= WS_SGUW && WS_SGUW + 2ull * 4 * 128 * 128 * 2 <= WS_END, "ws map 6");
static_assert(WS_OPART + (size_t)M * DQ * 2 <= WS_LSE && WS_LSE + (size_t)M * 12 * 4 <= WS_XB2, "ws map 5");
static_assert(W_IN + (size_t)NZ * D * 2 <= W_A && W_GU + 2ull * DFF * D * 2 <= W_DN && W_DN + (size_t)D * DFF * 2 <= W_PG && W_PLE + (size_t)D * DPLE * 2 <= WL, "weight map");
static_assert(WS_W + 2 * WL <= WS_XB && WS_XB + (size_t)M * D * 2 <= WS_XRES && WS_XRES + (size_t)M * D * 4 <= WS_Z && WS_Z + (size_t)M * ZP * 2 <= WS_PEB, "ws map 1");
static_assert(WS_PEB + 2ull * M * DPLE * 2 <= WS_GLU && WS_GLU + (size_t)M * 384 * 2 <= WS_QN && WS_QN + (size_t)M * DQ * 2 <= WS_KN && WS_KN + (size_t)M * DQ * 2 <= WS_VLN, "ws map 2");
static_assert(WS_VLN + (size_t)M * 384 * 2 <= WS_ACTA && WS_ACTA + (size_t)M * 384 * 2 <= WS_ACTB && WS_ACTB + (size_t)M * 256 * 2 <= WS_ACTC && WS_ACTC + (size_t)M * 384 * 2 <= WS_ACTD, "ws map 3");
static_assert(WS_ACTD + (size_t)M * 384 * 2 <= WS_MG && WS_MG + (size_t)M * D * 4 <= WS_MGB && WS_MGB + (size_t)M * D * 2 <= WS_HFF && WS_HFF + (size_t)M * DFF * 2 <= WS_PL && WS_PL + (size_t)M * D * 4 <= WS_OPART, "ws map 4");
constexpr int RS_STRIDE = 16896;
constexpr int RS_MIX0 = 0, RS_FFN0 = 1, RS_PLE0 = 2, RS_MIX1 = 3, RS_FFN1 = 4, RS_PLE1 = 5;
static_assert(6ull * RS_STRIDE * 4 <= CTL_ZERO_BYTES, "ctl");

constexpr int RING_BYTES = 131072, LDS_BYTES = 147456;

#define LAS __attribute__((address_space(3)))
typedef unsigned short bf16_t;
typedef short bf16x8 __attribute__((ext_vector_type(8)));
typedef float f32x4 __attribute__((ext_vector_type(4)));
typedef float f32x16 __attribute__((ext_vector_type(16)));
typedef float f32x2 __attribute__((ext_vector_type(2)));
typedef unsigned u32x4 __attribute__((ext_vector_type(4)));
typedef unsigned u32x2 __attribute__((ext_vector_type(2)));

__device__ __forceinline__ unsigned cvt_pk_bf16(float lo, float hi) { unsigned r; asm("v_cvt_pk_bf16_f32 %0, %1, %2" : "=v"(r) : "v"(lo), "v"(hi)); return r; }
__device__ __forceinline__ float bf_lo(unsigned w) { return __uint_as_float(w << 16); }
__device__ __forceinline__ float bf_hi(unsigned w) { return __uint_as_float(w & 0xffff0000u); }
__device__ __forceinline__ void unpack8(const u32x4 w, float (&f)[8]) { f[0] = bf_lo(w.x); f[1] = bf_hi(w.x); f[2] = bf_lo(w.y); f[3] = bf_hi(w.y); f[4] = bf_lo(w.z); f[5] = bf_hi(w.z); f[6] = bf_lo(w.w); f[7] = bf_hi(w.w); }
__device__ __forceinline__ u32x4 pack8(const float (&f)[8]) { u32x4 w; w.x = cvt_pk_bf16(f[0], f[1]); w.y = cvt_pk_bf16(f[2], f[3]); w.z = cvt_pk_bf16(f[4], f[5]); w.w = cvt_pk_bf16(f[6], f[7]); return w; }
__device__ __forceinline__ float bf1(bf16_t b) { return __uint_as_float((unsigned)b << 16); }
__device__ __forceinline__ float sigmoidf_(float x) { return __builtin_amdgcn_rcpf(1.0f + __expf(-x)); }
__device__ __forceinline__ float wave_sum(float v) {
#pragma unroll
    for (int o = 1; o < 64; o <<= 1) v += __shfl_xor(v, o);
    return v;
}

namespace pg8 {
#define PG8_LAS __attribute__((address_space(3)))
typedef unsigned short bf16_t;
typedef short bf16x8 __attribute__((ext_vector_type(8)));
typedef float f32x4 __attribute__((ext_vector_type(4)));
typedef unsigned u32x4 __attribute__((ext_vector_type(4)));
constexpr int BM = 256, BK = 64, HALF = 128, HTB = HALF * BK * 2  , STAGE_BYTES = 8 * HTB, NXCD = 8, WGM = 8;

__host__ __device__ __forceinline__ int lds_byte(int r, int c) { const int st = (r >> 4) * 2 + (c >> 5), rr = r & 15, cc = c & 31, ob = rr * 64 + cc * 2; return st * 1024 + (ob ^ (((ob >> 9) & 1) << 5)); }
__host__ __device__ __forceinline__ void stage_rc(int b, int& R, int& C) { const int st = b / 1024, sb = b % 1024, swz = sb ^ (((sb >> 9) & 1) << 5); R = (st >> 1) * 16 + swz / 64; C = (st & 1) * 32 + (swz % 64) / 2; }
__host__ __device__ __forceinline__ int perm32(int rho) { const int n = rho >> 4, i = rho & 15; return 8 * (i >> 2) + 4 * n + (i & 3); }

struct Unit { int pm, pn; };
struct Gemm { const bf16_t* A; const bf16_t* Bt; int M, N, K; };

struct StaticOrder {
    int nM, nN, nwg, G, c, wgm;
    __host__ __device__ __forceinline__ void init(int M, int N, int G_, int c_, int wgm_) { nM = M / BM; nN = N / BM; nwg = nM * nN; G = G_; c = c_; wgm = wgm_; }
    __host__ __device__ __forceinline__ bool next(int i, Unit& u) const { return next_at((long)i * G + c, u); }
    __host__ __device__ __forceinline__ bool next_at(long L, Unit& u) const {
        if (L >= nwg) return false;
        int wgid = (int)L; { const int q = nwg / NXCD, r = nwg % NXCD, xcd = wgid % NXCD, off = wgid / NXCD; wgid = (xcd < r ? xcd * (q + 1) : r * (q + 1) + (xcd - r) * q) + off; }
        const int nig = wgm * nN, gid = wgid / nig, fm = gid * wgm, gsz = (nM - fm) < wgm ? (nM - fm) : wgm;
        u.pm = fm + ((wgid % nig) % gsz); u.pn = (wgid % nig) / gsz; return true;
    }
    __device__ __forceinline__ void a_ready(const Unit&) const {}
    __device__ __forceinline__ void done(const Unit&) const {}
};


enum EpiMode { EP_Z = 0, EP_BR_FIRST = 1, EP_BR_MID = 2, EP_BR_LAST = 3, EP_RES = 4, EP_GLU = 5, EP_PL = 6, EP_PLE = 7, EP_BRC = 8 };
struct UnitX;
__device__ __forceinline__ void unpackg8(const u32x2 w, float (&g)[8]) {
#pragma unroll
    for (int j = 0; j < 4; ++j) { g[j] = (float)((w.x >> (8 * j)) & 0xffu) + 0.5f; g[4 + j] = (float)((w.y >> (8 * j)) & 0xffu) + 0.5f; }
}
struct EpiPre { bool hp, hx; f32x4 p0, p1, x0, x1; };
struct Epi {
    static constexpr bool PERM = true, AFTER_DRAIN = false;
    int mode;
    const float* rowss;
    bf16_t* ob; int ldb;
    bf16_t* ob2;
    float* of;
    const float* rin_p; const float* rin_s;
    const bf16_t* rin_b;
    float* rs_out;
    unsigned char* gate8;
    const bf16_t* pl;
    float* mg;
    __device__ __forceinline__ bool needs_rstd() const { return mode == EP_Z || mode == EP_PLE || mode == EP_GLU; }
    __device__ __forceinline__ float row_rstd(int row) const { return rsqrtf(rowss[row] * (1.0f / 1024.0f) + EPS); }
    __device__ __forceinline__ const float* res_base(int row) const { return (row < MP) ? rin_p : (rin_s - (size_t)MP * 1024); }
    __device__ __forceinline__ float epi8(int row, int col, f32x4 v0, f32x4 v1, float r, const float* rbase, const EpiPre pre = EpiPre{false, false, {0.f, 0.f, 0.f, 0.f}, {0.f, 0.f, 0.f, 0.f}, {0.f, 0.f, 0.f, 0.f}, {0.f, 0.f, 0.f, 0.f}}) const {
        float ss = 0.f;
        if (mode == EP_Z) {
            v0 *= r; v1 *= r;
            if (col < ZG) {
                u32x4 w; w.x = cvt_pk_bf16(v0[0], v0[1]); w.y = cvt_pk_bf16(v0[2], v0[3]); w.z = cvt_pk_bf16(v1[0], v1[1]); w.w = cvt_pk_bf16(v1[2], v1[3]);
                *(u32x4*)(ob + (size_t)row * ldb + col) = w;
            } else if (col < DIN) {
                unsigned q[8];
#pragma unroll
                for (int j = 0; j < 4; ++j) { q[j] = (unsigned)(sigmoidf_(v0[j]) * 256.0f); q[4 + j] = (unsigned)(sigmoidf_(v1[j]) * 256.0f); }
#pragma unroll
                for (int j = 0; j < 8; ++j) q[j] = q[j] > 255u ? 255u : q[j];
                u32x2 w; w.x = q[0] | (q[1] << 8) | (q[2] << 16) | (q[3] << 24); w.y = q[4] | (q[5] << 8) | (q[6] << 16) | (q[7] << 24);
                *(u32x2*)(gate8 + (size_t)row * 4096 + (col - ZG)) = w;
            }
        } else if (mode == EP_BR_FIRST || mode == EP_BR_MID || mode == EP_BR_LAST) {
            float g[8]; unpackg8(*(const u32x2*)(gate8 + (size_t)row * 4096 + col), g);
#pragma unroll
            for (int j = 0; j < 8; ++j) g[j] *= (1.0f / 256.0f);
            v0[0] *= g[0]; v0[1] *= g[1]; v0[2] *= g[2]; v0[3] *= g[3];
            v1[0] *= g[4]; v1[1] *= g[5]; v1[2] *= g[6]; v1[3] *= g[7];
            float* mp = mg + (size_t)row * 1024 + col;
            if (mode != EP_BR_FIRST) { v0 += *(const f32x4*)mp; v1 += *(const f32x4*)(mp + 4); }
            if (mode != EP_BR_LAST) { *(f32x4*)mp = v0; *(f32x4*)(mp + 4) = v1; }
            else {
                u32x4 w; w.x = cvt_pk_bf16(v0[0], v0[1]); w.y = cvt_pk_bf16(v0[2], v0[3]); w.z = cvt_pk_bf16(v1[0], v1[1]); w.w = cvt_pk_bf16(v1[2], v1[3]);
                *(u32x4*)(ob + (size_t)row * ldb + col) = w;
            }
        } else if (mode == EP_RES || mode == EP_PLE) {
            f32x4 x0, x1;
            if (pre.hx) { x0 = pre.x0; x1 = pre.x1; }
            else if (rin_b) { float xr[8]; unpack8(*(const u32x4*)(rin_b + (size_t)row * 1024 + col), xr); x0 = (f32x4){xr[0], xr[1], xr[2], xr[3]}; x1 = (f32x4){xr[4], xr[5], xr[6], xr[7]}; }
            else { const float* rp = rbase + (size_t)row * 1024 + col; x0 = *(const f32x4*)rp; x1 = *(const f32x4*)(rp + 4); }
            if (mode == EP_PLE) {
                float p[8];
                if (pre.hp) { p[0] = pre.p0[0]; p[1] = pre.p0[1]; p[2] = pre.p0[2]; p[3] = pre.p0[3]; p[4] = pre.p1[0]; p[5] = pre.p1[1]; p[6] = pre.p1[2]; p[7] = pre.p1[3]; }
                else unpack8(*(const u32x4*)(pl + (size_t)row * 1024 + col), p);
                v0[0] = p[0] * sigmoidf_(v0[0] * r); v0[1] = p[1] * sigmoidf_(v0[1] * r); v0[2] = p[2] * sigmoidf_(v0[2] * r); v0[3] = p[3] * sigmoidf_(v0[3] * r);
                v1[0] = p[4] * sigmoidf_(v1[0] * r); v1[1] = p[5] * sigmoidf_(v1[1] * r); v1[2] = p[6] * sigmoidf_(v1[2] * r); v1[3] = p[7] * sigmoidf_(v1[3] * r);
            }
            x0 += v0; x1 += v1;
            if (of) { float* op = of + (size_t)row * 1024 + col; *(f32x4*)op = x0; *(f32x4*)(op + 4) = x1; }
            if (ob) {
                u32x4 w; w.x = cvt_pk_bf16(x0[0], x0[1]); w.y = cvt_pk_bf16(x0[2], x0[3]); w.z = cvt_pk_bf16(x1[0], x1[1]); w.w = cvt_pk_bf16(x1[2], x1[3]);
                *(u32x4*)(ob + (size_t)row * ldb + col) = w;
            }
            ss = (x0[0] * x0[0] + x0[1] * x0[1]) + (x0[2] * x0[2] + x0[3] * x0[3]) + (x1[0] * x1[0] + x1[1] * x1[1]) + (x1[2] * x1[2] + x1[3] * x1[3]);
        } else {
            u32x4 w; w.x = cvt_pk_bf16(v0[0], v0[1]); w.y = cvt_pk_bf16(v0[2], v0[3]); w.z = cvt_pk_bf16(v1[0], v1[1]); w.w = cvt_pk_bf16(v1[2], v1[3]);
            *(u32x4*)(ob + (size_t)row * ldb + col) = w;
        }
        return ss;
    }
    template <class U>
    __device__ __forceinline__ void rescale(f32x4 (&acc)[2][2][4][2], const U& u, int wr, int wc, int fr, int fq) const {
        const int rowb = u.pm * BM + wr * 64 + fr;
        const int colb = u.pn * BM + wc * 32 + 8 * fq;
        const bool zero = u.zero_after;
        const unsigned char* gb = gate8 + u.seg * 1024;
#pragma unroll
        for (int ai = 0; ai < 2; ++ai)
#pragma unroll
            for (int m = 0; m < 4; ++m) {
                const int row = rowb + ai * HALF + m * 16;
#pragma unroll
                for (int bj = 0; bj < 2; ++bj) {
                    f32x4 r0 = {0.f, 0.f, 0.f, 0.f}, r1 = {0.f, 0.f, 0.f, 0.f};
                    if (!zero) {
                        const unsigned char* gp = gb + (size_t)row * 4096 + colb + bj * HALF;
                        float g0[8], g1[8]; unpackg8(*(const u32x2*)gp, g0); unpackg8(*(const u32x2*)(gp + 1024), g1);
#pragma unroll
                        for (int j = 0; j < 4; ++j) { r0[j] = g0[j] * __builtin_amdgcn_rcpf(g1[j]); r1[j] = g0[4 + j] * __builtin_amdgcn_rcpf(g1[4 + j]); }
                    }
                    acc[ai][bj][m][0] = acc[ai][bj][m][0] * r0; acc[ai][bj][m][1] = acc[ai][bj][m][1] * r1;
                }
            }
    }
    __device__ __forceinline__ void brc_store(const f32x4 (&acc)[2][2][4][2], int seg, int rowb, int colb) const {
        const unsigned char* gb = gate8 + seg * 1024 + colb;
        u32x2 cg[2];
#define BRS_LOAD(I, G) do { const unsigned char* _gp = gb + (size_t)(rowb + ((I) >> 2) * HALF + ((I) & 3) * 16) * 4096; (G)[0] = *(const u32x2*)_gp; (G)[1] = *(const u32x2*)(_gp + HALF); } while (0)
        BRS_LOAD(0, cg);
#pragma unroll
        for (int i = 0; i < 8; ++i) {
            u32x2 ng[2];
            if (i < 7) BRS_LOAD(i + 1, ng);
            const int ai = i >> 2, m = i & 3;
            const int row = rowb + ai * HALF + m * 16;
#pragma unroll
            for (int bj = 0; bj < 2; ++bj) {
                float g0[8]; unpackg8(cg[bj], g0);
#pragma unroll
                for (int j = 0; j < 8; ++j) g0[j] *= (1.0f / 256.0f);
                const f32x4 v0 = acc[ai][bj][m][0], v1 = acc[ai][bj][m][1];
                u32x4 w; w.x = cvt_pk_bf16(v0[0] * g0[0], v0[1] * g0[1]); w.y = cvt_pk_bf16(v0[2] * g0[2], v0[3] * g0[3]); w.z = cvt_pk_bf16(v1[0] * g0[4], v1[1] * g0[5]); w.w = cvt_pk_bf16(v1[2] * g0[6], v1[3] * g0[7]);
                *(u32x4*)(ob + (size_t)row * ldb + colb + bj * HALF) = w;
            }
            if (i < 7) { cg[0] = ng[0]; cg[1] = ng[1]; }
            asm volatile("" ::: "memory");
        }
#undef BRS_LOAD
    }
    template <bool BFRES, bool PLE>
    __device__ __forceinline__ void res_loop(const f32x4 (&acc)[2][2][4][2], int rowb, int colb, int fq, const float (&rs8)[8]) const {
        const float* rbase = res_base(rowb);
        const bool ssq = rs_out != nullptr;
        u32x4 cb[2], cp[2]; f32x4 cf[2][2];
#define RES_LOAD(I, B, F, P) do { const int _row = rowb + ((I) >> 2) * HALF + ((I) & 3) * 16; _Pragma("unroll") for (int _bj = 0; _bj < 2; ++_bj) { const size_t _o = (size_t)_row * 1024 + colb + _bj * HALF; \
            if constexpr (BFRES) (B)[_bj] = *(const u32x4*)(rin_b + _o); else { (F)[_bj][0] = *(const f32x4*)(rbase + _o); (F)[_bj][1] = *(const f32x4*)(rbase + _o + 4); } \
            if constexpr (PLE) (P)[_bj] = *(const u32x4*)(pl + _o); } } while (0)
        RES_LOAD(0, cb, cf, cp);
#pragma unroll
        for (int i = 0; i < 8; ++i) {
            u32x4 nb[2], np[2]; f32x4 nf[2][2];
            if (i < 7) RES_LOAD(i + 1, nb, nf, np);
            const int ai = i >> 2, m = i & 3;
            const int row = rowb + ai * HALF + m * 16;
            const float r = rs8[i];
            float ss = 0.f;
#pragma unroll
            for (int bj = 0; bj < 2; ++bj) {
                const int col = colb + bj * HALF;
                f32x4 x0, x1;
                if constexpr (BFRES) { float xr[8]; unpack8(cb[bj], xr); x0 = (f32x4){xr[0], xr[1], xr[2], xr[3]}; x1 = (f32x4){xr[4], xr[5], xr[6], xr[7]}; }
                else { x0 = cf[bj][0]; x1 = cf[bj][1]; }
                f32x4 v0 = acc[ai][bj][m][0], v1 = acc[ai][bj][m][1];
                if constexpr (PLE) {
                    float p[8]; unpack8(cp[bj], p);
                    v0[0] = p[0] * sigmoidf_(v0[0] * r); v0[1] = p[1] * sigmoidf_(v0[1] * r); v0[2] = p[2] * sigmoidf_(v0[2] * r); v0[3] = p[3] * sigmoidf_(v0[3] * r);
                    v1[0] = p[4] * sigmoidf_(v1[0] * r); v1[1] = p[5] * sigmoidf_(v1[1] * r); v1[2] = p[6] * sigmoidf_(v1[2] * r); v1[3] = p[7] * sigmoidf_(v1[3] * r);
                }
                x0 += v0; x1 += v1;
                if (of) { float* op = of + (size_t)row * 1024 + col; *(f32x4*)op = x0; *(f32x4*)(op + 4) = x1; }
                if (ob) {
                    u32x4 w; w.x = cvt_pk_bf16(x0[0], x0[1]); w.y = cvt_pk_bf16(x0[2], x0[3]); w.z = cvt_pk_bf16(x1[0], x1[1]); w.w = cvt_pk_bf16(x1[2], x1[3]);
                    *(u32x4*)(ob + (size_t)row * ldb + col) = w;
                }
                ss += (x0[0] * x0[0] + x0[1] * x0[1]) + (x0[2] * x0[2] + x0[3] * x0[3]) + (x1[0] * x1[0] + x1[1] * x1[1]) + (x1[2] * x1[2] + x1[3] * x1[3]);
            }
            if (ssq) { ss += __shfl_xor(ss, 16); ss += __shfl_xor(ss, 32); if (fq == 0) unsafeAtomicAdd(rs_out + row, ss); }
            if (i < 7) {
#pragma unroll
                for (int bj = 0; bj < 2; ++bj) { cb[bj] = nb[bj]; cp[bj] = np[bj]; cf[bj][0] = nf[bj][0]; cf[bj][1] = nf[bj][1]; }
            }
            asm volatile("" ::: "memory");
        }
#undef RES_LOAD
    }
    template <class U>
    __device__ __forceinline__ void operator()(const f32x4 (&acc)[2][2][4][2], const U& u, int wr, int wc, int fr, int fq) const {
        const int rowb = u.pm * BM + wr * 64 + fr;
        const int colb = u.pn * BM + wc * 32 + 8 * fq;
        if (mode == EP_BRC) { brc_store(acc, u.seg, rowb, colb); return; }
        if (ob2 != nullptr && u.seg == 1) {
#pragma unroll
            for (int ai = 0; ai < 2; ++ai)
#pragma unroll
                for (int m = 0; m < 4; ++m) {
                    const int row = rowb + ai * HALF + m * 16;
#pragma unroll
                    for (int bj = 0; bj < 2; ++bj) {
                        const f32x4 v0 = acc[ai][bj][m][0], v1 = acc[ai][bj][m][1];
                        u32x4 w; w.x = cvt_pk_bf16(v0[0], v0[1]); w.y = cvt_pk_bf16(v0[2], v0[3]); w.z = cvt_pk_bf16(v1[0], v1[1]); w.w = cvt_pk_bf16(v1[2], v1[3]);
                        *(u32x4*)(ob2 + (size_t)row * 1024 + colb + bj * HALF) = w;
                    }
                }
            return;
        }
        float rs8[8];
        if (needs_rstd()) {
#pragma unroll
            for (int i = 0; i < 8; ++i) rs8[i] = rowss[rowb + (i >> 2) * HALF + (i & 3) * 16];
            __builtin_amdgcn_sched_barrier(0);
#pragma unroll
            for (int i = 0; i < 8; ++i) rs8[i] = rsqrtf(rs8[i] * (1.0f / 1024.0f) + EPS);
        } else {
#pragma unroll
            for (int i = 0; i < 8; ++i) rs8[i] = 1.0f;
        }
        if (mode == EP_GLU) {
            const int colh = u.pn * HALF + wc * 32 + 8 * fq;
#pragma unroll
            for (int ai = 0; ai < 2; ++ai)
#pragma unroll
                for (int m = 0; m < 4; ++m) {
                    const int row = rowb + ai * HALF + m * 16;
                    const float r = rs8[ai * 4 + m];
                    float h[8];
#pragma unroll
                    for (int n = 0; n < 2; ++n)
#pragma unroll
                        for (int j = 0; j < 4; ++j) { const float g = acc[ai][0][m][n][j] * r, uu = acc[ai][1][m][n][j] * r; h[4 * n + j] = g * sigmoidf_(g) * uu; }
                    *(u32x4*)(ob + (size_t)row * ldb + colh) = pack8(h);
                }
            return;
        }
        if (mode == EP_RES) { if (rin_b) res_loop<true, false>(acc, rowb, colb, fq, rs8); else res_loop<false, false>(acc, rowb, colb, fq, rs8); return; }
        if (mode == EP_PLE) { res_loop<true, true>(acc, rowb, colb, fq, rs8); return; }
#pragma unroll
        for (int ai = 0; ai < 2; ++ai)
#pragma unroll
            for (int m = 0; m < 4; ++m) {
                const int row = rowb + ai * HALF + m * 16;
#pragma unroll
                for (int bj = 0; bj < 2; ++bj) (void)epi8(row, colb + bj * HALF, acc[ai][bj][m][0], acc[ai][bj][m][1], rs8[ai * 4 + m], nullptr);
            }
    }
};


struct UnitX { int pm, pn; const bf16_t* A; const bf16_t* Bt; int K; int seg; bool zero_after; };
template <class Epi, class Sched, bool ALIGN_EPI = false>
__device__ __forceinline__ void gemm_phase(PG8_LAS unsigned char* lds, const Sched& S, const Epi& E, const int tid) {
    const int wid = __builtin_amdgcn_readfirstlane(tid >> 6), lane = tid & 63, wr = wid >> 2, wc = wid & 3, fr = lane & 15, fq = lane >> 4;
    const size_t kstep = (size_t)(BK * 2);
    const unsigned ldsw = (unsigned)wid * 1024u;
    const int aoff = lds_byte(wr * 64 + fr, fq * 8), boff = lds_byte(wc * 32 + fr, fq * 8);
#define PG8_SA(b, h) (((b) * 2 + (h)) * HTB)
#define PG8_SB(b, h) ((4 + (b) * 2 + (h)) * HTB)
#define PG8_STAGE(bufoff, gbase, voff) do { _Pragma("unroll") for (int _i = 0; _i < 2; ++_i) \
        __builtin_amdgcn_global_load_lds((const unsigned*)((const char*)(gbase) + (voff)[_i]), (PG8_LAS unsigned*)(lds + (bufoff) + ldsw + _i * 8192), 16, 0, 0); } while (0)
#define PG8_VOFF(KK, vA, vB) do { int _t = tid; asm volatile("" : "+v"(_t)); _Pragma("unroll") for (int _i = 0; _i < 2; ++_i) { int _R, _C; stage_rc(_t * 16 + _i * 8192, _R, _C); \
        const int _Rb = Epi::PERM ? ((_R & ~31) + perm32(_R & 31)) : _R; (vA)[_i] = (unsigned)(_R * (KK) + _C) * 2u; (vB)[_i] = (unsigned)(_Rb * (KK) + _C) * 2u; } } while (0)
#define PG8_LDA(dst, b, h) do { _Pragma("unroll") for (int m = 0; m < 4; ++m) _Pragma("unroll") for (int k = 0; k < 2; ++k) dst[m][k] = *(const PG8_LAS bf16x8*)(lds + PG8_SA(b, h) + aoff + m * 2048 + k * 1024); } while (0)
#define PG8_LDB(dst, b, h) do { _Pragma("unroll") for (int n = 0; n < 2; ++n) _Pragma("unroll") for (int k = 0; k < 2; ++k) dst[n][k] = *(const PG8_LAS bf16x8*)(lds + PG8_SB(b, h) + boff + n * 2048 + k * 1024); } while (0)
#define PG8_MMA(ai, bj, At, Bt) do { __builtin_amdgcn_s_setprio(1); _Pragma("unroll") for (int m = 0; m < 4; ++m) _Pragma("unroll") for (int n = 0; n < 2; ++n) _Pragma("unroll") for (int k = 0; k < 2; ++k) \
        acc[ai][bj][m][n] = __builtin_amdgcn_mfma_f32_16x16x32_bf16(Bt[n][k], At[m][k], acc[ai][bj][m][n], 0, 0, 0); __builtin_amdgcn_s_setprio(0); } while (0)
#define PG8_WAIT_V(n) asm volatile("s_waitcnt vmcnt(" #n ")" ::: "memory")
#define PG8_WAIT_L(n) asm volatile("s_waitcnt lgkmcnt(" #n ")" ::: "memory")
#define PG8_BAR __builtin_amdgcn_s_barrier()
#define PG8_SCHED __builtin_amdgcn_sched_barrier(0)
#define PG8_SETUNIT(u, pA, pB, hs) do { (hs) = (size_t)HALF * (u).K * 2; (pA) = (const char*)(u).A + (size_t)(u).pm * 2 * (hs); (pB) = (const char*)(u).Bt + (size_t)(u).pn * 2 * (hs); } while (0)
    UnitX cur, nxt; int ui = 0;
    if (!S.next(0, cur)) return;
    f32x4 acc[2][2][4][2];
#pragma unroll
    for (int a = 0; a < 2; ++a)
#pragma unroll
        for (int b = 0; b < 2; ++b)
#pragma unroll
            for (int m = 0; m < 4; ++m)
#pragma unroll
                for (int n = 0; n < 2; ++n) acc[a][b][m][n] = (f32x4){0.f, 0.f, 0.f, 0.f};
    bf16x8 At[4][2], B0[2][2], B1[2][2];
    const char* cA; const char* cB; size_t hstep;
    PG8_SETUNIT(cur, cA, cB, hstep);
    int cK = cur.K;
    unsigned voffA[2], voffB[2];
    PG8_VOFF(cK, voffA, voffB);
    PG8_STAGE(PG8_SB(0, 0), cB, voffB); PG8_STAGE(PG8_SB(0, 1), cB + hstep, voffB); PG8_STAGE(PG8_SA(0, 0), cA, voffA); PG8_STAGE(PG8_SA(0, 1), cA + hstep, voffA);
    if (wr == 1) PG8_BAR;
    PG8_WAIT_V(2); PG8_BAR;
    PG8_STAGE(PG8_SB(1, 0), cB + kstep, voffB); PG8_STAGE(PG8_SA(1, 0), cA + kstep, voffA); PG8_STAGE(PG8_SB(1, 1), cB + hstep + kstep, voffB);
    PG8_WAIT_V(6); PG8_BAR;
    for (;;) {
        const bool has_next = S.next(ui + 1, nxt);
        const char* nA = cA; const char* nB = cB; size_t nhstep = hstep; int nK = cK;
        if (has_next) { PG8_SETUNIT(nxt, nA, nB, nhstep); nK = nxt.K; }
        const int nt = cK / BK;
        for (int t = 0; t < nt; t += 2) {
            const bool last = (t == nt - 2);
            const char* a1 = cA + (size_t)(t + 1) * kstep;
            const char* a2 = last ? nA : cA + (size_t)(t + 2) * kstep; const char* b2 = last ? nB : cB + (size_t)(t + 2) * kstep;
            const char* a3 = a2 + kstep; const char* b3 = b2 + kstep;
            PG8_LDB(B0, 0, 0); PG8_LDB(B1, 0, 1); PG8_SCHED; PG8_LDA(At, 0, 0); PG8_STAGE(PG8_SA(1, 1), a1 + hstep, voffA);
            if (last) { PG8_VOFF(nK, voffA, voffB); hstep = nhstep; }
            PG8_WAIT_V(8); PG8_WAIT_L(0); PG8_BAR; PG8_MMA(0, 0, At, B0); PG8_MMA(0, 1, At, B1); PG8_BAR; PG8_SCHED;
            PG8_LDA(At, 0, 1); PG8_STAGE(PG8_SB(0, 0), b2, voffB); PG8_STAGE(PG8_SB(0, 1), b2 + hstep, voffB); PG8_STAGE(PG8_SA(0, 0), a2, voffA);
            PG8_WAIT_V(8); PG8_WAIT_L(0); PG8_BAR; PG8_MMA(1, 0, At, B0); PG8_MMA(1, 1, At, B1); PG8_BAR; PG8_SCHED;
            PG8_LDB(B0, 1, 0); PG8_LDB(B1, 1, 1); PG8_SCHED; PG8_LDA(At, 1, 0); PG8_STAGE(PG8_SA(0, 1), a2 + hstep, voffA);
            PG8_WAIT_V(8); PG8_WAIT_L(0); PG8_BAR; PG8_MMA(0, 0, At, B0); PG8_MMA(0, 1, At, B1); PG8_BAR; PG8_SCHED;
            PG8_LDA(At, 1, 1); PG8_STAGE(PG8_SB(1, 0), b3, voffB); PG8_STAGE(PG8_SB(1, 1), b3 + hstep, voffB); PG8_STAGE(PG8_SA(1, 0), a3, voffA);
            PG8_WAIT_V(8); PG8_WAIT_L(0); PG8_BAR; PG8_MMA(1, 0, At, B0); PG8_MMA(1, 1, At, B1); PG8_BAR; PG8_SCHED;
        }
        if constexpr (ALIGN_EPI) { if (wr == 0) PG8_BAR; }
        if (cur.zero_after) E(acc, cur, wr, wc, fr, fq);
        if (!has_next) break;
        E.rescale(acc, cur, wr, wc, fr, fq);
        cur = nxt; cA = nA; cB = nB; cK = nK;
        ++ui;
        if constexpr (ALIGN_EPI) { if (wr == 1) PG8_BAR; }
    }
    PG8_WAIT_V(0);
    if constexpr (!ALIGN_EPI) { if (wr == 0) PG8_BAR; }
    PG8_BAR;
#undef PG8_SA
#undef PG8_SB
#undef PG8_STAGE
#undef PG8_VOFF
#undef PG8_LDA
#undef PG8_LDB
#undef PG8_MMA
#undef PG8_WAIT_V
#undef PG8_WAIT_L
#undef PG8_BAR
#undef PG8_SCHED
#undef PG8_SETUNIT
}

struct SegSched {
    StaticOrder so; int nseg;
    int split_rounds;
    const bf16_t* A0; const bf16_t* B0; int K0;
    const bf16_t* A1; const bf16_t* B1; int K1;
    const unsigned char* ws; const unsigned char* wl;
    __device__ __forceinline__ bool next(int i, UnitX& u) const {
        const int q = (nseg == 1) ? i : (nseg == 2 ? (i >> 1) : (i >> 2)), sg = (nseg == 1) ? 0 : (nseg == 2 ? ((i & 1) ^ 1) : (i & 3));
        Unit b;
        if (split_rounds > 0) {
            const int c = so.c; long L;
            if (c < 128) L = (q < split_rounds) ? (long)c + 128 * q : (long)128 * split_rounds + c + 256 * (q - split_rounds);
            else L = (long)128 * split_rounds + c + 256 * q;
            if (!so.next_at(L, b)) return false;
        } else if (!so.next(q, b)) return false;
        u.pm = b.pm; u.pn = b.pn; u.seg = sg; u.zero_after = (nseg == 2) || (sg == nseg - 1);
        if (nseg == 1 || (nseg == 2 && sg == 0)) { u.A = A0; u.Bt = B0; u.K = K0; }
        else if (nseg == 2) { u.A = A1; u.Bt = B1; u.K = K1; }
        else {
            const size_t ao = sg == 0 ? WS_ACTA : (sg == 1 ? WS_ACTB : (sg == 2 ? WS_ACTC : WS_ACTD));
            const size_t bo = sg == 0 ? W_A : (sg == 1 ? W_B : (sg == 2 ? W_C : W_D));
            u.A = (const bf16_t*)(ws + ao); u.Bt = (const bf16_t*)(wl + bo); u.K = (sg == 1) ? 256 : 384;
        }
        return true;
    }
};
}


__device__ const unsigned char T5_BUCKET[3][132] = {
 {0,1,2,3,4,5,6,7,8,9,10,11,12,13,14,15,16,16,16,16,16,16,17,17,17,17,17,17,17,17,18,18,18,18,18,18,18,18,18,18,19,19,19,19,19,19,19,19,19,19,19,19,19,19,20,20,20,20,20,20,20,20,20,20,20,20,20,20,20,20,20,20,20,21,21,21,21,21,21,21,21,21,21,21,21,21,21,21,21,21,21,21,21,21,21,21,21,21,21,22,22,22,22,22,22,22,22,22,22,22,22,22,22,22,22,22,22,22,22,22,22,22,22,22,22,22,22,22,22,0,0,0},
 {0,4,8,12,16,16,17,17,18,18,19,19,19,19,20,20,20,20,20,21,21,21,21,21,21,22,22,22,22,22,22,22,22,22,23,23,23,23,23,23,23,23,23,23,23,23,24,24,24,24,24,24,24,24,24,24,24,24,24,24,24,24,25,25,25,25,25,25,25,25,25,25,25,25,25,25,25,25,25,25,25,25,25,26,26,26,26,26,26,26,26,26,26,26,26,26,26,26,26,26,26,26,26,26,26,26,26,26,26,26,26,26,26,27,27,27,27,27,27,27,27,27,27,27,27,27,27,27,27,0,0,0},
 {0,16,18,19,20,21,21,22,22,23,23,23,24,24,24,24,25,25,25,25,25,26,26,26,26,26,26,26,26,27,27,27,27,27,27,27,27,27,27,28,28,28,28,28,28,28,28,28,28,28,28,28,29,29,29,29,29,29,29,29,29,29,29,29,29,29,29,29,29,29,30,30,30,30,30,30,30,30,30,30,30,30,30,30,30,30,30,30,30,30,30,30,30,30,30,31,31,31,31,31,31,31,31,31,31,31,31,31,31,31,31,31,31,31,31,31,31,31,31,31,31,31,31,31,31,31,31,31,31,0,0,0}};

struct Args { const float* in[36]; float* out; unsigned char* ws; int ph_lo, ph_hi; };
typedef const __attribute__((address_space(4))) Args* ArgsP;


enum { IN_XP = 0, IN_XS, IN_C128, IN_C512, IN_C2048, IN_SCONV, IN_SPOOL, IN_PP, IN_PS, IN_RELB, IN_NMIX, IN_WIN, IN_CONVW, IN_CONVB, IN_CLNG, IN_CLNB, IN_WA,
       IN_QN, IN_KN, IN_WB, IN_SLNG, IN_SLNB, IN_SGUW, IN_SGUB, IN_WC, IN_POOLW, IN_POOLS, IN_WD, IN_WO, IN_NFFN, IN_WGATE, IN_WUP, IN_WDOWN, IN_NPLE, IN_WPG, IN_WPLE };

#define LDS_WAIT() asm volatile("s_waitcnt lgkmcnt(0)" ::: "memory")

__device__ __forceinline__ void transpose_item(const float* W, int K, int N, bf16_t* WT, const float* gain, int mode, LAS float* scr, int item, int lane) {
    const int nblk = N / 64, kb = item / nblk, nb = item % nblk, k0 = 64 * kb, n0 = 64 * nb;
    {
        const int kk = lane >> 4, n4 = (lane & 15) * 4;
        f32x4 v[16];
#pragma unroll
        for (int i = 0; i < 16; ++i) v[i] = *(const f32x4*)(W + (size_t)(k0 + kk + 4 * i) * N + n0 + n4);
#pragma unroll
        for (int i = 0; i < 16; ++i) { LAS float* d = scr + (kk + 4 * i) * 65 + n4; d[0] = v[i][0]; d[1] = v[i][1]; d[2] = v[i][2]; d[3] = v[i][3]; }
    }
    LDS_WAIT(); asm volatile("" ::: "memory");
    const int c = lane & 7;
    f32x4 g0 = {1.f, 1.f, 1.f, 1.f}, g1 = {1.f, 1.f, 1.f, 1.f};
    if (gain) { g0 = *(const f32x4*)(gain + k0 + 8 * c); g1 = *(const f32x4*)(gain + k0 + 8 * c + 4); }
#pragma unroll
    for (int j = 0; j < 8; ++j) {
        const int n = (lane >> 3) + 8 * j; const LAS float* s = scr + (8 * c) * 65 + n;
        u32x4 o; o.x = cvt_pk_bf16(s[0 * 65] * g0[0], s[1 * 65] * g0[1]); o.y = cvt_pk_bf16(s[2 * 65] * g0[2], s[3 * 65] * g0[3]); o.z = cvt_pk_bf16(s[4 * 65] * g1[0], s[5 * 65] * g1[1]); o.w = cvt_pk_bf16(s[6 * 65] * g1[2], s[7 * 65] * g1[3]);
        const int nn = n0 + n;
        const int row = (mode == 0) ? nn : ((nn >> 7) * 256 + (nn & 127) + (mode == 2 ? 128 : 0));
        *(u32x4*)(WT + (size_t)row * K + k0 + 8 * c) = o;
    }
    LDS_WAIT(); asm volatile("" ::: "memory");
}

__device__ __forceinline__ void poolfold_item(const float* pw, const float* psc, const float* wd, bf16_t* WT, int item, int lane) {
    const int nb = item / 48, cb = item - nb * 48, c0 = 8 * cb, g = c0 / 96, cl0 = c0 - 96 * g, n = 64 * nb + lane;
    float acc[8];
#pragma unroll
    for (int i = 0; i < 8; ++i) acc[i] = 0.f;
    const float* pwg = pw + (size_t)(g * 96 + cl0) * 96;
    const float* wdg = wd + (size_t)(g * 96) * D + n;
    const float* scg = psc + g * 96;
#pragma unroll 32
    for (int cp = 0; cp < 96; ++cp) {
        const float x = wdg[(size_t)cp * D] * scg[cp];
#pragma unroll
        for (int i = 0; i < 8; ++i) acc[i] += pwg[i * 96 + cp] * x;
    }
    *(u32x4*)(WT + (size_t)n * 384 + c0) = pack8(acc);
}

constexpr int STAG_Q_Z = 224, STAG_Q_GU = 320;
constexpr int STAG_TOT_Z = STAG_Q_Z * (159 * 158 / 2), STAG_TOT_GU = STAG_Q_GU * (106 * 105 / 2), STAG_TOT = 2 * (STAG_TOT_Z + STAG_TOT_GU);
static_assert(2145 - 8 * 256 == 97 && 1430 - 5 * 256 == 150, "stagger geometry");
constexpr int CP_N0 = 64 * (128 - 8) * 128, CP_N1 = 64 * (512 - 8) * 128, CP_N2 = 64 * (2048 - 8) * 128, CP_TOT = CP_N0 + CP_N1 + CP_N2;
__device__ __forceinline__ void cache_copy_addr(ArgsP a, int i, const f32x4*& src, f32x4*& dst) {
    if (i < CP_N0) { constexpr int n4 = 120 * 128; const int ls = i / n4, off = i - ls * n4; src = (const f32x4*)a->in[IN_C128] + (size_t)ls * 128 * 128 + 1024 + off; dst = (f32x4*)(a->out + O_KVS0) + (size_t)ls * 128 * 128 + off; }
    else if (i < CP_N0 + CP_N1) { constexpr int n4 = 504 * 128; const int k = i - CP_N0, ls = k / n4, off = k - ls * n4; src = (const f32x4*)a->in[IN_C512] + (size_t)ls * 512 * 128 + 1024 + off; dst = (f32x4*)(a->out + O_KVS1) + (size_t)ls * 512 * 128 + off; }
    else { constexpr int n4 = 2040 * 128; const int k = i - CP_N0 - CP_N1, ls = k / n4, off = k - ls * n4; src = (const f32x4*)a->in[IN_C2048] + (size_t)ls * 2048 * 128 + 1024 + off; dst = (f32x4*)(a->out + O_KVS2) + (size_t)ls * 2048 * 128 + off; }
}
__device__ __forceinline__ void cache_copy_range(ArgsP a, int lo, int hi, int ith, int nth) {
    constexpr int U = 16;
    for (int i0 = lo + ith; i0 < hi; i0 += U * nth) {
        f32x4 v[U];
#pragma unroll
        for (int k = 0; k < U; ++k) { int i = i0 + k * nth; i = i < hi ? i : hi - 1; const f32x4* src; f32x4* dst; cache_copy_addr(a, i, src, dst); v[k] = __builtin_nontemporal_load(src); }
#pragma unroll
        for (int k = 0; k < U; ++k) { const int i = i0 + k * nth; if (i < hi) { const f32x4* src; f32x4* dst; cache_copy_addr(a, i, src, dst); __builtin_nontemporal_store(v[k], dst); } }
    }
}

__device__ __forceinline__ void p0_prologue(ArgsP a, LAS unsigned char* lds, int tid, int lane, int wave, int NCU, int cu, int part, bool stag_z0_here) {
    const int G = NCU, bid = cu;
    const bool do0 = part != 1, do1 = part != 0;
    unsigned char* ws = a->ws;
    LAS float* scr = (LAS float*)(lds + wave * 16640);
    const int gw = bid * 8 + wave, NGW = G * 8;
    const int gtid = bid * 512 + tid, NT = G * 512;
    constexpr int I_IN = 16 * 130, I_A = 6 * 16, I_B = 4 * 16, I_O = 16 * 16, I_G = 16 * 44, I_DN = 44 * 16, I_PLE = 4 * 16, I_PF = 16 * 48;
    constexpr int I_LAYER = I_IN + 2 * I_A + I_PF + I_B + 2 * I_O + 2 * I_G + I_DN + I_PLE;
    for (int it0 = gw; it0 < 2 * I_LAYER * P0R_T; it0 += NGW) {
        const int it = it0 % (2 * I_LAYER);
        const int l = it / I_LAYER; int r = it - l * I_LAYER;
        const bool crit = (l == 0 && r < I_IN);
        if (crit ? !do0 : !do1) continue;
        unsigned char* wl = ws + WS_W + (size_t)l * WL;
        if (r < I_IN) { transpose_item(a->in[IN_WIN] + (size_t)l * D * DIN, D, DIN, (bf16_t*)(wl + W_IN), a->in[IN_NMIX] + l * D, 0, scr, r, lane); continue; } r -= I_IN;
        if (r < I_A) { transpose_item(a->in[IN_WA] + (size_t)l * 384 * D, 384, D, (bf16_t*)(wl + W_A), nullptr, 0, scr, r, lane); continue; } r -= I_A;
        if (r < I_B) { transpose_item(a->in[IN_WB] + (size_t)l * 256 * D, 256, D, (bf16_t*)(wl + W_B), nullptr, 0, scr, r, lane); continue; } r -= I_B;
        if (r < I_A) { transpose_item(a->in[IN_WC] + (size_t)l * 384 * D, 384, D, (bf16_t*)(wl + W_C), nullptr, 0, scr, r, lane); continue; } r -= I_A;
        if (r < I_PF) { poolfold_item(a->in[IN_POOLW] + (size_t)l * 4 * 96 * 96, a->in[IN_POOLS] + l * 384, a->in[IN_WD] + (size_t)l * 384 * D, (bf16_t*)(wl + W_D), r, lane); continue; } r -= I_PF;
        if (r < I_O) { transpose_item(a->in[IN_WO] + (size_t)l * D * D, D, D, (bf16_t*)(wl + W_O), nullptr, 0, scr, r, lane); continue; } r -= I_O;
        if (r < I_G) { transpose_item(a->in[IN_WGATE] + (size_t)l * D * DFF, D, DFF, (bf16_t*)(wl + W_GU), a->in[IN_NFFN] + l * D, 1, scr, r, lane); continue; } r -= I_G;
        if (r < I_G) { transpose_item(a->in[IN_WUP] + (size_t)l * D * DFF, D, DFF, (bf16_t*)(wl + W_GU), a->in[IN_NFFN] + l * D, 2, scr, r, lane); continue; } r -= I_G;
        if (r < I_DN) { transpose_item(a->in[IN_WDOWN] + (size_t)l * DFF * D, DFF, D, (bf16_t*)(wl + W_DN), nullptr, 0, scr, r, lane); continue; } r -= I_DN;
        if (r < I_O) { transpose_item(a->in[IN_WPG] + (size_t)l * D * D, D, D, (bf16_t*)(wl + W_PG), a->in[IN_NPLE] + l * D, 0, scr, r, lane); continue; } r -= I_O;
        transpose_item(a->in[IN_WPLE] + (size_t)l * DPLE * D, DPLE, D, (bf16_t*)(wl + W_PLE), nullptr, 0, scr, r, lane);
    }
    for (int i = gtid; i < 2 * (NZ - DIN) * D / 8; i += NT) { const int l = i / ((NZ - DIN) * D / 8), o = i - l * ((NZ - DIN) * D / 8);
        if (l == 0 ? !do0 : !do1) continue;
        u32x4 z4 = {0u, 0u, 0u, 0u}; asm volatile("" : "+v"(z4));
        *(u32x4*)(ws + WS_W + (size_t)l * WL + W_IN + ((size_t)DIN * D + (size_t)o * 8) * 2) = z4; }
    float* rs0 = (float*)(ws + WS_CTL) + RS_MIX0 * RS_STRIDE;
    bf16_t* xb = (bf16_t*)(ws + WS_XB);
    if (do0) for (int m0 = gw; m0 < M * P0R_X; m0 += NGW) {
        const int m = m0 % M;
        const float* xr = (m < MP) ? a->in[IN_XP] + (size_t)m * D : a->in[IN_XS] + (size_t)(m - MP) * D;
        f32x4 v[4]; float s = 0.f;
#pragma unroll
        for (int j = 0; j < 4; ++j) { v[j] = ((const f32x4*)xr)[lane + 64 * j]; s += (v[j][0] * v[j][0] + v[j][1] * v[j][1]) + (v[j][2] * v[j][2] + v[j][3] * v[j][3]); }
        s = wave_sum(s);
        if (lane == 0) rs0[m] = s;
#pragma unroll
        for (int j = 0; j < 4; ++j) { u32x2 w; w.x = cvt_pk_bf16(v[j][0], v[j][1]); w.y = cvt_pk_bf16(v[j][2], v[j][3]); ((u32x2*)(xb + (size_t)m * D))[lane + 64 * j] = w; }
    }
    if (!do1) return;
    bf16_t* peb = (bf16_t*)(ws + WS_PEB);
    for (int i = gtid; i < 2 * M * 32; i += NT) {
        const int l = i / (M * 32), rem = i - l * (M * 32), m = rem >> 5, c8 = rem & 31;
        const float* src = (m < MP) ? a->in[IN_PP] + ((size_t)l * MP + m) * DPLE + c8 * 8 : a->in[IN_PS] + ((size_t)l * MS + (m - MP)) * DPLE + c8 * 8;
        const f32x4 p0 = *(const f32x4*)src, p1 = *(const f32x4*)(src + 4);
        u32x4 w; w.x = cvt_pk_bf16(p0[0], p0[1]); w.y = cvt_pk_bf16(p0[2], p0[3]); w.z = cvt_pk_bf16(p1[0], p1[1]); w.w = cvt_pk_bf16(p1[2], p1[3]);
        *(u32x4*)(peb + ((size_t)l * M + m) * DPLE + c8 * 8) = w;
    }
    cache_copy_range(a, STAG_TOT, CP_TOT, gtid, NT);
    if (stag_z0_here) cache_copy_range(a, 0, STAG_TOT_Z, gtid, NT);
    if (!stag_z0_here && part == 2) cache_copy_range(a, 0, STAG_TOT, gtid, NT);
    for (int i = gtid; i < 2 * 4 * 128 * 16; i += NT) {
        const int row = i >> 4, j8 = (i & 15) * 8, ii = row & 127;
        const float* src = a->in[IN_SGUW] + (size_t)row * 128 + j8; const f32x4 p0 = *(const f32x4*)src, p1 = *(const f32x4*)(src + 4);
        float v[8] = {p0[0], p0[1], p0[2], p0[3], p1[0], p1[1], p1[2], p1[3]};
#pragma unroll
        for (int k = 0; k < 8; ++k) v[k] = (j8 + k <= ii) ? v[k] : 0.f;
        *(u32x4*)((bf16_t*)(ws + WS_SGUW) + (size_t)row * 128 + j8) = pack8(v);
    }
    for (int i = gtid; i < 64 * 22 * 96; i += NT) { const int ls = i / (22 * 96), off = i - ls * (22 * 96);
        ((f32x4*)(a->out + O_CONVS))[(size_t)ls * 30 * 96 + off] = ((const f32x4*)a->in[IN_SCONV])[(size_t)ls * 30 * 96 + 8 * 96 + off]; }
    for (int i = gtid; i < 64 * 7 * 96; i += NT) { const int ls = i / (7 * 96), off = i - ls * (7 * 96);
        ((f32x4*)(a->out + O_POOLS))[(size_t)ls * 15 * 96 + off] = ((const f32x4*)a->in[IN_SPOOL])[(size_t)ls * 15 * 96 + 8 * 96 + off]; }
}

__device__ __forceinline__ float* kv_out_ptr(float* out, int g, bool isP, int l, int s, int pos) {
    const int W = 128 << (2 * g);
    const size_t base = isP ? (g == 0 ? O_KVP0 : (g == 1 ? O_KVP1 : O_KVP2)) : (g == 0 ? O_KVS0 : (g == 1 ? O_KVS1 : O_KVS2));
    const size_t seq = isP ? (size_t)l : (size_t)(l * 32 + s);
    return out + base + (seq * W + pos) * 512;
}

struct PzRow { u32x4 La, Lb, Lvv, Lq0, Lk0, Lq1, Lk1; };
__device__ __forceinline__ PzRow postz_load(ArgsP a, int m, int lane) {
    const bf16_t* zr = (const bf16_t*)(a->ws + WS_Z) + (size_t)m * ZP;
    const int lc48 = lane < 48 ? lane : 47, ch1 = 64 + (lane & 31);
    PzRow R;
    R.La = *(const u32x4*)(zr + ZA + 8 * lc48); R.Lb = *(const u32x4*)(zr + ZB + 8 * lc48); R.Lvv = *(const u32x4*)(zr + ZVV + 8 * lc48);
    R.Lq0 = *(const u32x4*)(zr + ZQ + 8 * lane); R.Lk0 = *(const u32x4*)(zr + ZK + 8 * lane); R.Lq1 = *(const u32x4*)(zr + ZQ + 8 * ch1); R.Lk1 = *(const u32x4*)(zr + ZK + 8 * ch1);
    return R;
}
__device__ __forceinline__ u32x4 postz_row(ArgsP a, int l, int m, int lane, const PzRow& R) {
    u32x4 vvpk = {0u, 0u, 0u, 0u};
    unsigned char* ws = a->ws;
    const bf16_t* zr = (const bf16_t*)(ws + WS_Z) + (size_t)m * ZP;
    const bool isP = m < MP; const int t = isP ? m : ((m - MP) & 7); const int s = isP ? 0 : ((m - MP) >> 3);
    const int ch1 = 64 + (lane & 31);
    const u32x4 La = R.La, Lb = R.Lb, Lvv = R.Lvv, Lq0 = R.Lq0, Lk0 = R.Lk0, Lq1 = R.Lq1, Lk1 = R.Lk1;
    if (lane < 48) {
        float av[8], bv[8], g[8]; unpack8(La, av); unpack8(Lb, bv);
#pragma unroll
        for (int i = 0; i < 8; ++i) g[i] = av[i] * sigmoidf_(bv[i]);
        *(u32x4*)((bf16_t*)(ws + WS_GLU) + (size_t)m * 384 + 8 * lane) = pack8(g);
        float* dst = nullptr;
        if (isP) { if (t >= TP - 30) dst = a->out + O_CONVP + ((size_t)l * 30 + (t - (TP - 30))) * 384 + 8 * lane; }
        else dst = a->out + O_CONVS + ((size_t)(l * 32 + s) * 30 + 22 + t) * 384 + 8 * lane;
        if (dst) { *(f32x4*)dst = (f32x4){g[0], g[1], g[2], g[3]}; *(f32x4*)(dst + 4) = (f32x4){g[4], g[5], g[6], g[7]}; }
        float* pd = nullptr;
        if (isP) { if (t >= TP - 15) pd = a->out + O_POOLP + ((size_t)l * 15 + (t - (TP - 15))) * 384 + 8 * lane; }
        else pd = a->out + O_POOLS + ((size_t)(l * 32 + s) * 15 + 7 + t) * 384 + 8 * lane;
        if (pd) { float zd[8]; unpack8(*(const u32x4*)(zr + ZD + 8 * lane), zd); *(f32x4*)pd = (f32x4){zd[0], zd[1], zd[2], zd[3]}; *(f32x4*)(pd + 4) = (f32x4){zd[4], zd[5], zd[6], zd[7]}; }
    }
    const float* qw = a->in[IN_QN] + l * HD; const float* kw = a->in[IN_KN] + l * HD;
#pragma unroll
    for (int it = 0; it < 2; ++it) {
        const int ch = lane + 64 * it; const bool act = ch < 96; const int chc = (it == 0) ? lane : ch1;
        const int h = chc >> 3, dc = (chc & 7) * 8, g = h >> 2, hs = h & 3;
        float q[8], k[8];
        unpack8(it == 0 ? Lq0 : Lq1, q); unpack8(it == 0 ? Lk0 : Lk1, k);
        float sq = 0.f, sk = 0.f;
#pragma unroll
        for (int i = 0; i < 8; ++i) { sq += q[i] * q[i]; sk += k[i] * k[i]; }
        sq += __shfl_xor(sq, 1); sq += __shfl_xor(sq, 2); sq += __shfl_xor(sq, 4);
        sk += __shfl_xor(sk, 1); sk += __shfl_xor(sk, 2); sk += __shfl_xor(sk, 4);
        const float rq = rsqrtf(sq * (1.0f / 64.0f) + EPS) * (0.125f * LOG2E), rk = rsqrtf(sk * (1.0f / 64.0f) + EPS);
        const f32x4 qw0 = *(const f32x4*)(qw + dc), qw1 = *(const f32x4*)(qw + dc + 4), kw0 = *(const f32x4*)(kw + dc), kw1 = *(const f32x4*)(kw + dc + 4);
#pragma unroll
        for (int i = 0; i < 4; ++i) { q[i] *= rq * qw0[i]; q[4 + i] *= rq * qw1[i]; k[i] *= rk * kw0[i]; k[4 + i] *= rk * kw1[i]; }
        if (act) {
            *(u32x4*)((bf16_t*)(ws + WS_QN) + (size_t)m * DQ + 8 * ch) = pack8(q);
            *(u32x4*)((bf16_t*)(ws + WS_KN) + (size_t)m * DQ + 8 * ch) = pack8(k);
            const int W = 128 << (2 * g);
            const int pos = isP ? t - (TP - W) : W - 8 + t;
            if (pos >= 0) {
                float* kvp = kv_out_ptr(a->out, g, isP, l, s, pos) + hs * 64 + dc;
                *(f32x4*)kvp = (f32x4){k[0], k[1], k[2], k[3]}; *(f32x4*)(kvp + 4) = (f32x4){k[4], k[5], k[6], k[7]};
                float v[8]; unpack8(*(const u32x4*)(zr + ZV + 8 * ch), v);
                *(f32x4*)(kvp + 256) = (f32x4){v[0], v[1], v[2], v[3]}; *(f32x4*)(kvp + 260) = (f32x4){v[4], v[5], v[6], v[7]};
            }
        }
    }
    {
        float x[8]; const bool act = lane < 48;
        unpack8(Lvv, x);
        float sm = 0.f;
#pragma unroll
        for (int i = 0; i < 8; ++i) sm += x[i];
        sm = wave_sum(act ? sm : 0.f);
        const float mean = sm * (1.0f / 384.0f);
        float sv = 0.f;
#pragma unroll
        for (int i = 0; i < 8; ++i) { x[i] -= mean; sv += x[i] * x[i]; }
        sv = wave_sum(act ? sv : 0.f);
        const float rstd = rsqrtf(sv * (1.0f / 384.0f) + LN_EPS);
        if (act) {
            const float* gg = a->in[IN_SLNG] + l * 384 + 8 * lane; const float* bb = a->in[IN_SLNB] + l * 384 + 8 * lane;
            const f32x4 g0 = *(const f32x4*)gg, g1 = *(const f32x4*)(gg + 4), b0 = *(const f32x4*)bb, b1 = *(const f32x4*)(bb + 4);
#pragma unroll
            for (int i = 0; i < 4; ++i) { x[i] = x[i] * rstd * g0[i] + b0[i]; x[4 + i] = x[4 + i] * rstd * g1[i] + b1[i]; }
            vvpk = pack8(x);
            if (!isP) *(u32x4*)((bf16_t*)(ws + WS_VLN) + (size_t)m * 384 + 8 * lane) = vvpk;
            if (!isP) { float* sp = a->out + O_SGUS + ((size_t)(l * 32 + s) * 8 + t) * 384 + 8 * lane; *(f32x4*)sp = (f32x4){x[0], x[1], x[2], x[3]}; *(f32x4*)(sp + 4) = (f32x4){x[4], x[5], x[6], x[7]}; }
        }
    }
    return vvpk;
}
__device__ __forceinline__ void postz_rows8(ArgsP a, int l, int m0, int lane) {
    u32x4 pk[8];
    PzRow cur = postz_load(a, m0, lane);
#pragma unroll
    for (int r = 0; r < 8; ++r) {
        PzRow nxt = cur;
        if (r < 7) nxt = postz_load(a, m0 + r + 1, lane);
        __builtin_amdgcn_sched_barrier(0);
        pk[r] = postz_row(a, l, m0 + r, lane, cur);
        cur = nxt;
    }
    if (lane < 48) {
        bf16_t* vt = (bf16_t*)(a->ws + WS_VLN) + ((size_t)(m0 >> 7) * 384 + 8 * lane) * 128 + (m0 & 127);
#define PZ_LO(w) ((w) & 0xffffu)
#define PZ_HI(w) ((w) >> 16)
#define PZ_ROW(sel, comp) (u32x4){ sel(pk[0].comp) | (sel(pk[1].comp) << 16), sel(pk[2].comp) | (sel(pk[3].comp) << 16), sel(pk[4].comp) | (sel(pk[5].comp) << 16), sel(pk[6].comp) | (sel(pk[7].comp) << 16) }
        *(u32x4*)(vt + 0 * 128) = PZ_ROW(PZ_LO, x); *(u32x4*)(vt + 1 * 128) = PZ_ROW(PZ_HI, x);
        *(u32x4*)(vt + 2 * 128) = PZ_ROW(PZ_LO, y); *(u32x4*)(vt + 3 * 128) = PZ_ROW(PZ_HI, y);
        *(u32x4*)(vt + 4 * 128) = PZ_ROW(PZ_LO, z); *(u32x4*)(vt + 5 * 128) = PZ_ROW(PZ_HI, z);
        *(u32x4*)(vt + 6 * 128) = PZ_ROW(PZ_LO, w); *(u32x4*)(vt + 7 * 128) = PZ_ROW(PZ_HI, w);
#undef PZ_LO
#undef PZ_HI
#undef PZ_ROW
    }
}

constexpr int TAB_OFF = 122880;
__device__ __forceinline__ void attn_sample_task(ArgsP a, int l, int m, int h, int lane, const LAS float* tab) {
    unsigned char* ws = a->ws;
    const bf16_t* qn = (const bf16_t*)(ws + WS_QN); const bf16_t* kn = (const bf16_t*)(ws + WS_KN); const bf16_t* z = (const bf16_t*)(ws + WS_Z);
    const int g = h >> 2, hs = h & 3, sh = 2 * g, W = 128 << sh;
    const int t = (m - MP) & 7, s = (m - MP) >> 3;
    const int ks = lane >> 3, c = lane & 7;
    float qf[8]; unpack8(*(const u32x4*)(qn + (size_t)m * DQ + h * 64 + 8 * c), qf);
    const float* cache = a->in[IN_C128 + g] + ((size_t)(l * 32 + s) * W) * 512 + hs * 64 + 8 * c;
    const LAS float* tb = tab + h * 132;
    float sc[17];
    const int tk0 = t - (ks << sh);
    const size_t nrow = (size_t)(MP + 8 * s + (tk0 < 0 ? 0 : tk0));
    const int prow0 = tk0 < 0 ? W + tk0 : W - 1;
    {
        float kf[8]; unpack8(*(const u32x4*)(kn + nrow * DQ + h * 64 + 8 * c), kf);
        const float* p = cache + (size_t)prow0 * 512; const f32x4 x0 = *(const f32x4*)p, x1 = *(const f32x4*)(p + 4);
        if (tk0 < 0) { kf[0] = x0[0]; kf[1] = x0[1]; kf[2] = x0[2]; kf[3] = x0[3]; kf[4] = x1[0]; kf[5] = x1[1]; kf[6] = x1[2]; kf[7] = x1[3]; }
        float d = 0.f;
#pragma unroll
        for (int i = 0; i < 8; ++i) d += qf[i] * kf[i];
        d += __shfl_xor(d, 1); d += __shfl_xor(d, 2); d += __shfl_xor(d, 4);
        sc[0] = d + tb[ks];
    }
#pragma unroll
    for (int hb = 0; hb < 2; ++hb) {
        f32x4 x0[8], x1[8];
#pragma unroll
        for (int q = 0; q < 8; ++q) { const int it = 1 + 8 * hb + q; const int j = it * 8 + ks; const int jj = j <= 128 ? j : 128; const float* p = cache + (size_t)(W + t - (jj << sh)) * 512; x0[q] = *(const f32x4*)p; x1[q] = *(const f32x4*)(p + 4); }
        __builtin_amdgcn_sched_barrier(0);
#pragma unroll
        for (int q = 0; q < 8; ++q) {
            const int it = 1 + 8 * hb + q; const int j = it * 8 + ks; const bool inr = j <= 128; const int jj = inr ? j : 128;
            const f32x4 a0 = x0[q], a1 = x1[q];
            float d = (qf[0] * a0[0] + qf[1] * a0[1]) + (qf[2] * a0[2] + qf[3] * a0[3]) + (qf[4] * a1[0] + qf[5] * a1[1]) + (qf[6] * a1[2] + qf[7] * a1[3]);
            d += __shfl_xor(d, 1); d += __shfl_xor(d, 2); d += __shfl_xor(d, 4);
            d += tb[jj];
            sc[it] = inr ? d : -1.0e30f;
        }
        __builtin_amdgcn_sched_barrier(0);
    }
    float mx = sc[0];
#pragma unroll
    for (int it = 1; it < 17; ++it) mx = fmaxf(mx, sc[it]);
    mx = fmaxf(mx, __shfl_xor(mx, 8)); mx = fmaxf(mx, __shfl_xor(mx, 16)); mx = fmaxf(mx, __shfl_xor(mx, 32));
    float sum = 0.f;
#pragma unroll
    for (int it = 0; it < 17; ++it) { sc[it] = __builtin_amdgcn_exp2f(sc[it] - mx); sum += sc[it]; }
    sum += __shfl_xor(sum, 8); sum += __shfl_xor(sum, 16); sum += __shfl_xor(sum, 32);
    float acc[8];
    {
        float vf[8]; unpack8(*(const u32x4*)(z + nrow * ZP + ZV + h * 64 + 8 * c), vf);
        const float* p = cache + (size_t)prow0 * 512 + 256; const f32x4 x0 = *(const f32x4*)p, x1 = *(const f32x4*)(p + 4);
        if (tk0 < 0) { vf[0] = x0[0]; vf[1] = x0[1]; vf[2] = x0[2]; vf[3] = x0[3]; vf[4] = x1[0]; vf[5] = x1[1]; vf[6] = x1[2]; vf[7] = x1[3]; }
#pragma unroll
        for (int i = 0; i < 8; ++i) acc[i] = sc[0] * vf[i];
    }
#pragma unroll
    for (int hb = 0; hb < 2; ++hb) {
        f32x4 x0[8], x1[8];
#pragma unroll
        for (int q = 0; q < 8; ++q) { const int it = 1 + 8 * hb + q; const int j = it * 8 + ks; const int jj = j <= 128 ? j : 128; const float* p = cache + (size_t)(W + t - (jj << sh)) * 512 + 256; x0[q] = *(const f32x4*)p; x1[q] = *(const f32x4*)(p + 4); }
        __builtin_amdgcn_sched_barrier(0);
#pragma unroll
        for (int q = 0; q < 8; ++q) {
            const float pw = sc[1 + 8 * hb + q]; const f32x4 a0 = x0[q], a1 = x1[q];
            acc[0] += pw * a0[0]; acc[1] += pw * a0[1]; acc[2] += pw * a0[2]; acc[3] += pw * a0[3]; acc[4] += pw * a1[0]; acc[5] += pw * a1[1]; acc[6] += pw * a1[2]; acc[7] += pw * a1[3];
        }
        __builtin_amdgcn_sched_barrier(0);
    }
    const float inv = 1.0f / sum;
#pragma unroll
    for (int i = 0; i < 8; ++i) { float v = acc[i]; v += __shfl_xor(v, 8); v += __shfl_xor(v, 16); v += __shfl_xor(v, 32); acc[i] = v * inv; }
    if (lane < 8) *(u32x4*)((bf16_t*)(ws + WS_OPART) + (size_t)m * DQ + h * 64 + 8 * c) = pack8(acc);
    if (lane == 0) ((float*)(ws + WS_LSE))[(size_t)m * 12 + h] = (mx + __builtin_amdgcn_logf(sum) + ATT_C2) * LN2;
}

constexpr int VSP = 72;
typedef short v4i16_t __attribute__((ext_vector_type(4)));
constexpr int NT_ATTP = 12 * (TP / 32);
constexpr int AKS_OFF = 0, AVS_OFF = 49152;
__device__ __forceinline__ void attn_mfma_unit(ArgsP a, LAS unsigned char* lds, int l, int unit, int tid, int lane, int wave, const LAS float* tab) {
    unsigned char* ws = a->ws;
    const bf16_t* qn = (const bf16_t*)(ws + WS_QN); const bf16_t* kn = (const bf16_t*)(ws + WS_KN); const bf16_t* z = (const bf16_t*)(ws + WS_Z);
    LAS unsigned char* Ks = lds + AKS_OFF;
    LAS bf16_t* Vs = (LAS bf16_t*)(lds + AVS_OFF);
    const int task0 = unit * 8;
    const int h = task0 / (TP / 32); const int rem = task0 - h * (TP / 32);
    const int sh = 2 * (h >> 2);
    const int nb = (TP / 32) >> sh;
    const int r = rem / nb, ib8 = rem - r * nb;
    const int ib = ib8 + wave;
    const int c = lane & 31, hh = lane >> 5;
    const int tq = ((32 * ib + c) << sh) + r;
    bf16x8 qf[4];
#pragma unroll
    for (int s = 0; s < 4; ++s) qf[s] = *(const bf16x8*)(qn + (size_t)tq * DQ + h * 64 + 16 * s + 8 * hh);
    {
        const int k0 = 32 * ib8 - 128;
        int t2 = tid; asm volatile("" : "+v"(t2));
        const int key0 = t2 >> 3, ch = t2 & 7;
        const unsigned kcol = (unsigned)(h * 128 + ch * 16), vcol = (unsigned)(ZV * 2 + h * 128 + ch * 16);
        u32x4 kr[6], vr[6];
#pragma unroll
        for (int i = 0; i < 6; ++i) {
            int ik = k0 + key0 + 64 * i; ik = ik < 0 ? 0 : ik; const unsigned tk = ((unsigned)ik << sh) + r;
            kr[i] = *(const u32x4*)((const unsigned char*)kn + (tk * (unsigned)(DQ * 2) + kcol));
            vr[i] = *(const u32x4*)((const unsigned char*)z + (tk * (unsigned)(ZP * 2) + vcol));
        }
        __builtin_amdgcn_sched_barrier(0);
        LAS unsigned char* kw = Ks + key0 * 128 + ((ch ^ (key0 & 7)) << 4);
        LAS unsigned char* vw = (LAS unsigned char*)Vs + key0 * (VSP * 2) + ch * 16;
#pragma unroll
        for (int i = 0; i < 6; ++i) { *(LAS u32x4*)(kw + i * 8192) = kr[i]; *(LAS u32x4*)(vw + i * (64 * VSP * 2)) = vr[i]; }
    }
    f32x16 o0, o1;
#pragma unroll
    for (int i = 0; i < 16; ++i) { o0[i] = 0.f; o1[i] = 0.f; }
    float lrun = 0.f;
    const int i0 = 32 * ib - 128;
    const LAS float* tb = tab + h * 132;
    __syncthreads();
#pragma unroll 1
    for (int kt = 0; kt < 5; ++kt) {
        const int ib0 = i0 + 32 * kt;
        const int lk = 32 * (wave + kt);
        bf16x8 kf[4];
#pragma unroll
        for (int s = 0; s < 4; ++s) kf[s] = *(const LAS bf16x8*)(Ks + (lk + c) * 128 + (((2 * s + hh) ^ (c & 7)) << 4));
        const bool need_mask = (kt == 0) || (kt == 4) || (ib < 4);
        f32x16 sa;
        if (need_mask) {
#pragma unroll
            for (int reg = 0; reg < 16; ++reg) { const int kr = (reg & 3) + 8 * (reg >> 2) + 4 * hh; const int j = c + 128 - 32 * kt - kr; const int jj = j < 0 ? 0 : (j > 128 ? 128 : j); sa[reg] = tb[jj]; }
        } else {
            const LAS float* tbl = tb + (c + 128 - 27 - 32 * kt - 4 * hh);
#pragma unroll
            for (int reg = 0; reg < 16; ++reg) sa[reg] = tbl[27 - ((reg & 3) + 8 * (reg >> 2))];
        }
#pragma unroll
        for (int s = 0; s < 4; ++s) sa = __builtin_amdgcn_mfma_f32_32x32x16_bf16(kf[s], qf[s], sa, 0, 0, 0);
        if (need_mask) {
#pragma unroll
            for (int reg = 0; reg < 16; ++reg) {
                const int kr = (reg & 3) + 8 * (reg >> 2) + 4 * hh;
                const int j = c + 128 - 32 * kt - kr;
                const bool valid = (j >= 0) && (j <= 128) && (ib0 + kr >= 0);
                sa[reg] = valid ? sa[reg] : -1.0e30f;
            }
        }
        float lsum = 0.f;
#pragma unroll
        for (int reg = 0; reg < 16; ++reg) { const float p = __builtin_amdgcn_exp2f(sa[reg]); sa[reg] = p; lsum += p; }
        lrun += lsum;
#pragma unroll
        for (int s = 0; s < 2; ++s) {
            u32x4 pw; pw.x = cvt_pk_bf16(sa[8 * s + 0], sa[8 * s + 1]); pw.y = cvt_pk_bf16(sa[8 * s + 2], sa[8 * s + 3]); pw.z = cvt_pk_bf16(sa[8 * s + 4], sa[8 * s + 5]); pw.w = cvt_pk_bf16(sa[8 * s + 6], sa[8 * s + 7]);
            const bf16x8 pf = __builtin_bit_cast(bf16x8, pw);
            const LAS bf16_t* vq = Vs + (lk + 16 * s + 4 * hh + ((lane & 15) >> 2)) * VSP + 16 * ((lane >> 4) & 1) + 4 * (lane & 3);
            {   const v4i16_t lo = __builtin_amdgcn_ds_read_tr16_b64_v4i16((LAS v4i16_t*)vq), hi = __builtin_amdgcn_ds_read_tr16_b64_v4i16((LAS v4i16_t*)(vq + 8 * VSP));
                const bf16x8 af = {lo[0], lo[1], lo[2], lo[3], hi[0], hi[1], hi[2], hi[3]};
                o0 = __builtin_amdgcn_mfma_f32_32x32x16_bf16(af, pf, o0, 0, 0, 0); }
            {   const v4i16_t lo = __builtin_amdgcn_ds_read_tr16_b64_v4i16((LAS v4i16_t*)(vq + 32)), hi = __builtin_amdgcn_ds_read_tr16_b64_v4i16((LAS v4i16_t*)(vq + 8 * VSP + 32));
                const bf16x8 af = {lo[0], lo[1], lo[2], lo[3], hi[0], hi[1], hi[2], hi[3]};
                o1 = __builtin_amdgcn_mfma_f32_32x32x16_bf16(af, pf, o1, 0, 0, 0); }
        }
    }
    const float ltot = lrun + __shfl_xor(lrun, 32);
    const float inv = 1.0f / ltot;
    bf16_t* op = (bf16_t*)(ws + WS_OPART) + (size_t)tq * DQ + h * 64 + 4 * hh;
#pragma unroll
    for (int q4 = 0; q4 < 4; ++q4) {
        u32x2 w0; w0.x = cvt_pk_bf16(o0[4 * q4 + 0] * inv, o0[4 * q4 + 1] * inv); w0.y = cvt_pk_bf16(o0[4 * q4 + 2] * inv, o0[4 * q4 + 3] * inv);
        u32x2 w1; w1.x = cvt_pk_bf16(o1[4 * q4 + 0] * inv, o1[4 * q4 + 1] * inv); w1.y = cvt_pk_bf16(o1[4 * q4 + 2] * inv, o1[4 * q4 + 3] * inv);
        *(u32x2*)(op + 8 * q4) = w0; *(u32x2*)(op + 32 + 8 * q4) = w1;
    }
    if (hh == 0) ((float*)(ws + WS_LSE))[(size_t)tq * 12 + h] = (__builtin_amdgcn_logf(ltot) + ATT_C2) * LN2;
}

struct CbRow { float l0, l1, l2; u32x2 w0, w1, w2; };
__device__ __forceinline__ CbRow combine_load(ArgsP a, int m, int lane) {
    unsigned char* ws = a->ws;
    const int hs = lane >> 4, d4 = 4 * (lane & 15);
    const float* ls = (const float*)(ws + WS_LSE) + (size_t)m * 12 + hs;
    const bf16_t* op = (const bf16_t*)(ws + WS_OPART) + (size_t)m * DQ + hs * 64 + d4;
    CbRow R; R.l0 = ls[0]; R.l1 = ls[4]; R.l2 = ls[8]; R.w0 = *(const u32x2*)op; R.w1 = *(const u32x2*)(op + 256); R.w2 = *(const u32x2*)(op + 512);
    return R;
}
__device__ __forceinline__ void combine_row(ArgsP a, int m, int lane, const CbRow& R) {
    unsigned char* ws = a->ws;
    const int hs = lane >> 4, d4 = 4 * (lane & 15);
    const float l0 = R.l0, l1 = R.l1, l2 = R.l2;
    const float mx = fmaxf(l0, fmaxf(l1, l2));
    float e0 = __expf(l0 - mx), e1 = __expf(l1 - mx), e2 = __expf(l2 - mx);
    const float inv = 1.0f / (e0 + e1 + e2); e0 *= inv; e1 *= inv; e2 *= inv;
    const u32x2 w0 = R.w0, w1 = R.w1, w2 = R.w2;
    const float r0 = e0 * bf_lo(w0.x) + e1 * bf_lo(w1.x) + e2 * bf_lo(w2.x), r1 = e0 * bf_hi(w0.x) + e1 * bf_hi(w1.x) + e2 * bf_hi(w2.x);
    const float r2 = e0 * bf_lo(w0.y) + e1 * bf_lo(w1.y) + e2 * bf_lo(w2.y), r3 = e0 * bf_hi(w0.y) + e1 * bf_hi(w1.y) + e2 * bf_hi(w2.y);
    u32x2 o; o.x = cvt_pk_bf16(r0, r1); o.y = cvt_pk_bf16(r2, r3);
    *(u32x2*)((bf16_t*)(ws + WS_ACTB) + (size_t)m * 256 + hs * 64 + d4) = o;
}

constexpr int CT = 32;
template <bool EDGE>
__device__ __forceinline__ void convpool_unit(ArgsP a, LAS unsigned char* lds, int l, int mbase, int s, int t0, int nt, int tid, int lane, int wave) {
    unsigned char* ws = a->ws;
    LAS bf16_t* Gs = (LAS bf16_t*)lds;
    LAS float* CV = (LAS float*)lds;
    LAS bf16_t* Zs = (LAS bf16_t*)(lds + 49152);
    const bf16_t* glub = (const bf16_t*)(ws + WS_GLU) + (size_t)mbase * 384;
    const bf16_t* zd = (const bf16_t*)(ws + WS_Z) + (size_t)mbase * ZP + ZD;
    float w[31]; float cb = 0.f;
    if (tid < 384) {
        const float* cw = a->in[IN_CONVW] + (size_t)l * 31 * 384 + tid;
#pragma unroll
        for (int k = 0; k < 31; ++k) w[k] = cw[k * 384];
        cb = a->in[IN_CONVB][l * 384 + tid];
    }
    __builtin_amdgcn_sched_barrier(0);
    if constexpr (!EDGE) {
        constexpr int NCH = (62 + 47) * 48, NIT = (NCH + 511) / 512;
        u32x4 v[NIT];
#pragma unroll
        for (int k = 0; k < NIT; ++k) {
            int i = tid + 512 * k; i = i < NCH ? i : NCH - 1;
            const bool isg = i < 62 * 48; const int kk = isg ? i : i - 62 * 48; const int r = kk / 48, c8 = kk - r * 48;
            v[k] = isg ? *(const u32x4*)(glub + (size_t)(t0 - 30 + r) * 384 + 8 * c8) : *(const u32x4*)(zd + (size_t)(t0 - 15 + r) * ZP + 8 * c8);
        }
#pragma unroll
        for (int k = 0; k < NIT; ++k) {
            const int i = tid + 512 * k;
            if (i < NCH) { const bool isg = i < 62 * 48; const int kk = isg ? i : i - 62 * 48; const int r = kk / 48, c8 = kk - r * 48; *(LAS u32x4*)((isg ? Gs : Zs) + r * 384 + 8 * c8) = v[k]; }
        }
    } else {
        for (int i = tid; i < (62 + 47) * 48; i += 512) {
            const bool isg = i < 62 * 48; const int k = isg ? i : i - 62 * 48; const int r = k / 48, c8 = k - r * 48;
            const int tt = isg ? t0 - 30 + r : t0 - 15 + r;
            u32x4 v = {0u, 0u, 0u, 0u};
            if (tt >= 0) { if (tt < t0 + nt) v = isg ? *(const u32x4*)(glub + (size_t)tt * 384 + 8 * c8) : *(const u32x4*)(zd + (size_t)tt * ZP + 8 * c8); }
            else if (s >= 0) {
                const float* p = isg ? a->in[IN_SCONV] + ((size_t)(l * 32 + s) * 30 + 30 + tt) * 384 + 8 * c8 : a->in[IN_SPOOL] + ((size_t)(l * 32 + s) * 15 + 15 + tt) * 384 + 8 * c8;
                const f32x4 x0 = *(const f32x4*)p, x1 = *(const f32x4*)(p + 4);
                v.x = cvt_pk_bf16(x0[0], x0[1]); v.y = cvt_pk_bf16(x0[2], x0[3]); v.z = cvt_pk_bf16(x1[0], x1[1]); v.w = cvt_pk_bf16(x1[2], x1[3]);
            }
            *(LAS u32x4*)((isg ? Gs : Zs) + r * 384 + 8 * c8) = v;
        }
    }
    __syncthreads();
    if (tid < 384) {
        const int c = tid;
        float x[CT + 30];
#pragma unroll
        for (int r = 0; r < CT + 30; ++r) x[r] = bf1(Gs[r * 384 + c]);
        asm volatile("s_waitcnt lgkmcnt(0)" ::: "memory");
        __syncthreads();
#pragma unroll
        for (int q = 0; q < CT; ++q) {
            float acc = cb;
#pragma unroll
            for (int k = 0; k < 31; ++k) acc += w[k] * x[q + k];
            CV[q * 384 + c] = acc;
        }
    } else {
        __syncthreads();
        const int c0 = tid - 384;
#pragma unroll 1
        for (int q3 = 0; q3 < 3; ++q3) {
            const int c = c0 + 128 * q3, wg = c / 96;
            float x[CT + 15];
#pragma unroll
            for (int r = 0; r < CT + 15; ++r) x[r] = bf1(Zs[r * 384 + c]);
            float lv[CT + 15], res[CT];
#pragma unroll
            for (int i = 0; i < CT + 15; ++i) lv[i] = x[i];
#pragma unroll
            for (int i = CT + 14; i >= 1; --i) lv[i] += lv[i - 1];
#pragma unroll
            for (int q = 0; q < CT; ++q) res[q] = lv[15 + q];
#pragma unroll
            for (int i = CT + 14; i >= 2; --i) lv[i] += lv[i - 2];
#pragma unroll
            for (int q = 0; q < CT; ++q) res[q] = wg >= 1 ? lv[15 + q] : res[q];
#pragma unroll
            for (int i = CT + 14; i >= 4; --i) lv[i] += lv[i - 4];
#pragma unroll
            for (int q = 0; q < CT; ++q) res[q] = wg >= 2 ? lv[15 + q] : res[q];
#pragma unroll
            for (int i = CT + 14; i >= 8; --i) lv[i] += lv[i - 8];
#pragma unroll
            for (int q = 0; q < CT; ++q) res[q] = wg >= 3 ? lv[15 + q] : res[q];
            const int wlen = 2 << wg;
            bf16_t* op = (bf16_t*)(ws + WS_ACTD) + (size_t)(mbase + t0) * 384 + c;
#pragma unroll
            for (int q = 0; q < CT; ++q) {
                float inv = 1.0f / (float)wlen;
                if constexpr (EDGE) { const int cnt = (s < 0) ? min(wlen, t0 + q + 1) : wlen; inv = 1.0f / (float)cnt; }
                const float pv = res[q] * inv - x[15 + q];
                if (q < nt) op[(size_t)q * 384] = (bf16_t)(cvt_pk_bf16(pv, 0.f) & 0xffffu);
            }
        }
    }
    float lg[6], lb[6];
    { const float* gp = a->in[IN_CLNG] + l * 384 + lane; const float* bp = a->in[IN_CLNB] + l * 384 + lane;
#pragma unroll
      for (int i = 0; i < 6; ++i) { lg[i] = gp[64 * i]; lb[i] = bp[64 * i]; } }
    __syncthreads();
    for (int tt = wave; tt < nt; tt += 8) {
        float x[6]; float sm = 0.f;
#pragma unroll
        for (int i = 0; i < 6; ++i) { x[i] = CV[tt * 384 + lane + 64 * i]; sm += x[i]; }
        const float mean = wave_sum(sm) * (1.0f / 384.0f);
        float sv = 0.f;
#pragma unroll
        for (int i = 0; i < 6; ++i) { x[i] -= mean; sv += x[i] * x[i]; }
        const float rstd = rsqrtf(wave_sum(sv) * (1.0f / 384.0f) + LN_EPS);
        bf16_t* o = (bf16_t*)(ws + WS_ACTA) + (size_t)(mbase + t0 + tt) * 384;
#pragma unroll
        for (int i = 0; i < 6; ++i) { const int c = lane + 64 * i; const float y = x[i] * rstd * lg[i] + lb[i]; o[c] = (bf16_t)(cvt_pk_bf16(y * sigmoidf_(y), 0.f) & 0xffffu); }
    }
    __syncthreads();
}

__device__ __forceinline__ void sgu_unit(ArgsP a, LAS unsigned char* lds, int l, int m0, int L, int g, int tid) {
    unsigned char* ws = a->ws;
    LAS float* V = (LAS float*)lds;
    LAS float* Wt = (LAS float*)(lds + 128 * 96 * 4);
    const bf16_t* vln = (const bf16_t*)(ws + WS_VLN); const bf16_t* z = (const bf16_t*)(ws + WS_Z);
    for (int i = tid; i < L * 12; i += 512) {
        const int j = i / 12, c8 = i - j * 12; float v[8]; unpack8(*(const u32x4*)(vln + (size_t)(m0 + j) * 384 + g * 96 + 8 * c8), v);
        *(LAS f32x4*)(V + j * 96 + 8 * c8) = (f32x4){v[0], v[1], v[2], v[3]}; *(LAS f32x4*)(V + j * 96 + 8 * c8 + 4) = (f32x4){v[4], v[5], v[6], v[7]};
    }
    const float* sw = a->in[IN_SGUW] + ((size_t)(l * 4 + g) * 128) * 128;
    const int L4 = L / 4;
    for (int i = tid; i < L * L4; i += 512) { const int r = i / L4, j4 = i - r * L4; *(LAS f32x4*)(Wt + r * 128 + 4 * j4) = *(const f32x4*)(sw + (size_t)r * 128 + 4 * j4); }
    __syncthreads();
    if (tid < 384) {
        const int c = tid % 96, iq = tid / 96;
        for (int i = iq; i < L; i += 4) {
            float acc = a->in[IN_SGUB][(l * 4 + g) * 128 + i];
            for (int j = 0; j <= i; ++j) acc += Wt[i * 128 + j] * V[j * 96 + c];
            const float u = bf1(z[(size_t)(m0 + i) * ZP + ZU + g * 96 + c]);
            ((bf16_t*)(ws + WS_ACTC))[(size_t)(m0 + i) * 384 + g * 96 + c] = (bf16_t)(cvt_pk_bf16(u * acc, 0.f) & 0xffffu);
        }
    }
    __syncthreads();
}

template <int IT>
__device__ __forceinline__ void sgu_mfma_tile(ArgsP a, int l, int m0, int g, int ct, int lane) {
    unsigned char* ws = a->ws;
    const int c = lane & 31, hh = lane >> 5;
    const bf16_t* wsb = (const bf16_t*)(ws + WS_SGUW) + ((size_t)(l * 4 + g) * 128 + 32 * IT + c) * 128 + 8 * hh;
    const bf16_t* vp = (const bf16_t*)(ws + WS_VLN) + ((size_t)(m0 >> 7) * 384 + g * 96 + 32 * ct + c) * 128 + 8 * hh;
    f32x16 acc;
#pragma unroll
    for (int i = 0; i < 16; ++i) acc[i] = 0.f;
    constexpr int NST = 2 * (IT + 1);
    bf16x8 afr[NST], bfr[NST];
#pragma unroll
    for (int st = 0; st < NST; ++st) { bfr[st] = *(const bf16x8*)(wsb + 16 * st); afr[st] = *(const bf16x8*)(vp + 16 * st); }
#pragma unroll
    for (int st = 0; st < NST; ++st) acc = __builtin_amdgcn_mfma_f32_32x32x16_bf16(afr[st], bfr[st], acc, 0, 0, 0);
    const int tok = m0 + 32 * IT + c;
    const float bias = a->in[IN_SGUB][(l * 4 + g) * 128 + 32 * IT + c];
    const bf16_t* up = (const bf16_t*)(ws + WS_Z) + (size_t)tok * ZP + ZU + g * 96 + 32 * ct + 4 * hh;
    bf16_t* op = (bf16_t*)(ws + WS_ACTC) + (size_t)tok * 384 + g * 96 + 32 * ct + 4 * hh;
#pragma unroll
    for (int q4 = 0; q4 < 4; ++q4) {
        const u32x2 uw = *(const u32x2*)(up + 8 * q4);
        u32x2 o; o.x = cvt_pk_bf16(bf_lo(uw.x) * (acc[4 * q4 + 0] + bias), bf_hi(uw.x) * (acc[4 * q4 + 1] + bias)); o.y = cvt_pk_bf16(bf_lo(uw.y) * (acc[4 * q4 + 2] + bias), bf_hi(uw.y) * (acc[4 * q4 + 3] + bias));
        *(u32x2*)(op + 8 * q4) = o;
    }
}
__device__ __forceinline__ void sgu_mfma_unit(ArgsP a, int l, int m0, int g, int lane, int wave) {
    if (wave < 3) sgu_mfma_tile<3>(a, l, m0, g, wave, lane);
    else if (wave < 6) { sgu_mfma_tile<2>(a, l, m0, g, wave - 3, lane); sgu_mfma_tile<0>(a, l, m0, g, wave - 3, lane); }
    else if (wave == 6) { sgu_mfma_tile<1>(a, l, m0, g, 0, lane); sgu_mfma_tile<1>(a, l, m0, g, 1, lane); }
    else sgu_mfma_tile<1>(a, l, m0, g, 2, lane);
}

constexpr int NU_ATTP = NT_ATTP / 8;
constexpr int NU_ATTS = MS * 12 / 8;
constexpr int NU_ATT = NU_ATTP + NU_ATTS;
constexpr int NU_SGU = 128 * 4 + 32 * 4;
constexpr int NU_CONV = MP / CT + 32;
constexpr int NU_MIX = NU_ATT + NU_SGU + NU_CONV;
#ifndef MIX_EXTRA_LO
#define MIX_EXTRA_LO 0
#define MIX_EXTRA_HI 0
#endif

__device__ __forceinline__ void p3_mixer(ArgsP a, LAS unsigned char* lds, int l, int tid, int lane, int wave, int G, int bid) {
    LAS float* tab = (LAS float*)(lds + TAB_OFF);
    for (int i = tid; i < 12 * 132; i += 512) { const int h = i / 132, j = i - h * 132; tab[i] = (j <= 128) ? a->in[IN_RELB][(int)T5_BUCKET[h >> 2][j] * 12 + h] * LOG2E - ATT_C2 : 0.f; }
    __syncthreads();
    const int vcu = (G % 8 == 0) ? (bid % 8) * (G / 8) + bid / 8 : bid;
    const int nmine = (NU_MIX + (MIX_EXTRA_HI - MIX_EXTRA_LO) - vcu + G - 1) / G;
    const bool rev = (G % 8 == 0) && (bid & 1);
    for (int k = 0; k < nmine; ++k) {
        const int u = vcu + (rev ? nmine - 1 - k : k) * G;
        int r = u < NU_MIX ? u : MIX_EXTRA_LO + (u - NU_MIX);
        if (r < NU_ATTP) { __syncthreads(); attn_mfma_unit(a, lds, l, r, tid, lane, wave, tab); __syncthreads(); continue; } r -= NU_ATTP;
        if (r < NU_ATTS) { const int task = r * 8 + wave; attn_sample_task(a, l, MP + task / 12, task % 12, lane, tab); continue; } r -= NU_ATTS;
        if (r < NU_SGU) { if (r < 512) sgu_mfma_unit(a, l, (r >> 2) * 128, r & 3, lane, wave); else { r -= 512; sgu_unit(a, lds, l, MP + (r >> 2) * 8, 8, r & 3, tid); } continue; } r -= NU_SGU;
        if (r == 0) convpool_unit<true>(a, lds, l, 0, -1, 0, CT, tid, lane, wave); else if (r < MP / CT) convpool_unit<false>(a, lds, l, 0, -1, r * CT, CT, tid, lane, wave); else { r -= MP / CT; convpool_unit<true>(a, lds, l, MP + r * 8, r, 0, 8, tid, lane, wave); }
    }
}


__device__ __forceinline__ void small_gemm_tile(LAS unsigned char* lds, const pg8::Gemm& g, const pg8::Epi& e, const pg8::Gemm& gp, const bool g2, int mt, int nt, int tid, int lane, int wave) {
    const int K = g.K, kw = K >> 3, nsteps = kw >> 4;
    const int c = lane & 31, hh = lane >> 5;
    const bool resid = (e.mode == pg8::EP_RES || e.mode == pg8::EP_PLE);
    const int erow = MP + 32 * mt + (tid & 31), ecol = 32 * nt + 8 * ((tid >> 5) & 3);
    u32x4 xpb = {0u, 0u, 0u, 0u}; f32x4 xpf0 = {0.f, 0.f, 0.f, 0.f}, xpf1 = {0.f, 0.f, 0.f, 0.f}; float rsq = 1.0f;
    if (tid < 128 && resid) {
        if (e.rin_b) xpb = *(const u32x4*)(e.rin_b + (size_t)erow * 1024 + ecol);
        else { const float* rp = e.res_base(erow) + (size_t)erow * 1024 + ecol; xpf0 = *(const f32x4*)rp; xpf1 = *(const f32x4*)(rp + 4); }
        if (e.needs_rstd()) rsq = e.rowss[erow];
    }
    bf16x8 a2[2], b2[2];
    {   const bf16x8 zz = {0, 0, 0, 0, 0, 0, 0, 0}; a2[0] = zz; a2[1] = zz; b2[0] = zz; b2[1] = zz; }
    if (g2) {
        const bf16_t* ap2 = gp.A + (size_t)(MP + 32 * mt + c) * DPLE + wave * 32 + 8 * hh; const bf16_t* bp2 = gp.Bt + (size_t)(32 * nt + c) * DPLE + wave * 32 + 8 * hh;
        a2[0] = *(const bf16x8*)ap2; a2[1] = *(const bf16x8*)(ap2 + 16); b2[0] = *(const bf16x8*)bp2; b2[1] = *(const bf16x8*)(bp2 + 16);
    }
    __builtin_amdgcn_sched_barrier(0);
    const bf16_t* ap = g.A + (size_t)(MP + 32 * mt + c) * K + wave * kw + 8 * hh;
    const bf16_t* bp = g.Bt + (size_t)(32 * nt + c) * K + wave * kw + 8 * hh;
    f32x16 acc;
#pragma unroll
    for (int i = 0; i < 16; ++i) acc[i] = 0.f;
    for (int s0 = 0; s0 < nsteps; s0 += 8) {
        bf16x8 af[8], bf[8];
#pragma unroll
        for (int i = 0; i < 8; ++i) { const int st = (s0 + i < nsteps) ? s0 + i : nsteps - 1; af[i] = *(const bf16x8*)(ap + 16 * st); bf[i] = *(const bf16x8*)(bp + 16 * st); }
#pragma unroll
        for (int i = 0; i < 8; ++i) { const bf16x8 zz = {0, 0, 0, 0, 0, 0, 0, 0}; const bf16x8 aa = (s0 + i < nsteps) ? af[i] : zz; acc = __builtin_amdgcn_mfma_f32_32x32x16_bf16(bf[i], aa, acc, 0, 0, 0); }
    }
    LAS float* P = (LAS float*)lds;
    LAS float* P2 = P + 8 * 16 * 64;
#pragma unroll
    for (int i = 0; i < 16; ++i) P[(wave * 16 + i) * 64 + lane] = acc[i];
    if (g2) {
        f32x16 acc2;
#pragma unroll
        for (int i = 0; i < 16; ++i) acc2[i] = 0.f;
        acc2 = __builtin_amdgcn_mfma_f32_32x32x16_bf16(b2[0], a2[0], acc2, 0, 0, 0); acc2 = __builtin_amdgcn_mfma_f32_32x32x16_bf16(b2[1], a2[1], acc2, 0, 0, 0);
#pragma unroll
        for (int i = 0; i < 16; ++i) P2[(wave * 16 + i) * 64 + lane] = acc2[i];
    }
    __syncthreads();
    if (tid < 128) {
        const int m = tid & 31, q4 = tid >> 5;
        float pv[8];
#pragma unroll
        for (int j = 0; j < 8; ++j) pv[j] = 0.f;
        if (g2) {
#pragma unroll
            for (int w = 0; w < 8; ++w)
#pragma unroll
                for (int j = 0; j < 4; ++j) { pv[j] += P2[(w * 16 + 4 * q4 + j) * 64 + m]; pv[4 + j] += P2[(w * 16 + 4 * q4 + j) * 64 + 32 + m]; }
        }
        f32x4 v0 = {0.f, 0.f, 0.f, 0.f}, v1 = {0.f, 0.f, 0.f, 0.f};
#pragma unroll
        for (int w = 0; w < 8; ++w)
#pragma unroll
            for (int j = 0; j < 4; ++j) { v0[j] += P[(w * 16 + 4 * q4 + j) * 64 + m]; v1[j] += P[(w * 16 + 4 * q4 + j) * 64 + 32 + m]; }
        const int row = MP + 32 * mt + m, col = 32 * nt + 8 * q4;
        float ss;
        if (resid) {
            pg8::EpiPre pre; pre.hp = g2; pre.hx = true;
            pre.p0 = (f32x4){pv[0], pv[1], pv[2], pv[3]}; pre.p1 = (f32x4){pv[4], pv[5], pv[6], pv[7]};
            if (e.rin_b) { pre.x0 = (f32x4){bf_lo(xpb.x), bf_hi(xpb.x), bf_lo(xpb.y), bf_hi(xpb.y)}; pre.x1 = (f32x4){bf_lo(xpb.z), bf_hi(xpb.z), bf_lo(xpb.w), bf_hi(xpb.w)}; }
            else { pre.x0 = xpf0; pre.x1 = xpf1; }
            const float r = e.needs_rstd() ? rsqrtf(rsq * (1.0f / 1024.0f) + EPS) : 1.0f;
            ss = e.epi8(row, col, v0, v1, r, nullptr, pre);
        } else {
            const float r = e.needs_rstd() ? e.row_rstd(row) : 1.0f;
            ss = e.epi8(row, col, v0, v1, r, e.res_base(row));
        }
        if ((e.mode == pg8::EP_RES || e.mode == pg8::EP_PLE) && e.rs_out) unsafeAtomicAdd(e.rs_out + row, ss);
    }
    __syncthreads();
}

__device__ __forceinline__ void small_br_tile(LAS unsigned char* lds, ArgsP a, int l, int mt, int nt, int tid, int lane, int wave) {
    unsigned char* ws = a->ws; const unsigned char* wl = ws + WS_W + (size_t)l * WL;
    const int c = lane & 31, hh = lane >> 5;
    const int row = MP + 32 * mt + c;
    bf16x8 af[11], bf[11]; unsigned gq[4][4];
    const unsigned char* gz = ws + WS_ZG8 + (size_t)row * 4096 + 32 * nt + 4 * hh;
#pragma unroll
    for (int sg = 0; sg < 4; ++sg) {
        const int K = (sg == 1) ? 256 : 384, kw = K >> 3, nsteps = kw >> 4, base = (sg == 0) ? 0 : (sg == 1 ? 3 : (sg == 2 ? 5 : 8));
        const size_t ao = sg == 0 ? WS_ACTA : (sg == 1 ? WS_ACTB : (sg == 2 ? WS_ACTC : WS_ACTD));
        const size_t bo = sg == 0 ? W_A : (sg == 1 ? W_B : (sg == 2 ? W_C : W_D));
        const bf16_t* ap = (const bf16_t*)(ws + ao) + (size_t)row * K + wave * kw + 8 * hh;
        const bf16_t* bp = (const bf16_t*)(wl + bo) + (size_t)(32 * nt + c) * K + wave * kw + 8 * hh;
#pragma unroll
        for (int i = 0; i < 3; ++i) if (i < nsteps) { af[base + i] = *(const bf16x8*)(ap + 16 * i); bf[base + i] = *(const bf16x8*)(bp + 16 * i); }
#pragma unroll
        for (int q = 0; q < 4; ++q) gq[sg][q] = *(const unsigned*)(gz + sg * 1024 + 8 * q);
    }
    __builtin_amdgcn_sched_barrier(0);
    f32x16 tot;
#pragma unroll
    for (int i = 0; i < 16; ++i) tot[i] = 0.f;
#pragma unroll
    for (int sg = 0; sg < 4; ++sg) {
        const int nsteps = (sg == 1) ? 2 : 3, base = (sg == 0) ? 0 : (sg == 1 ? 3 : (sg == 2 ? 5 : 8));
        f32x16 acc;
#pragma unroll
        for (int i = 0; i < 16; ++i) acc[i] = 0.f;
#pragma unroll
        for (int i = 0; i < 3; ++i) if (i < nsteps) acc = __builtin_amdgcn_mfma_f32_32x32x16_bf16(bf[base + i], af[base + i], acc, 0, 0, 0);
#pragma unroll
        for (int q = 0; q < 4; ++q)
#pragma unroll
            for (int j = 0; j < 4; ++j) tot[4 * q + j] += acc[4 * q + j] * ((float)((gq[sg][q] >> (8 * j)) & 0xffu) + 0.5f);
    }
    LAS float* P = (LAS float*)lds;
#pragma unroll
    for (int i = 0; i < 16; ++i) P[(wave * 16 + i) * 64 + lane] = tot[i];
    __syncthreads();
    if (tid < 128) {
        const int m = tid & 31, q4 = tid >> 5;
        float v[8];
#pragma unroll
        for (int j = 0; j < 8; ++j) v[j] = 0.f;
#pragma unroll
        for (int w = 0; w < 8; ++w)
#pragma unroll
            for (int j = 0; j < 4; ++j) { v[j] += P[(w * 16 + 4 * q4 + j) * 64 + m]; v[4 + j] += P[(w * 16 + 4 * q4 + j) * 64 + 32 + m]; }
#pragma unroll
        for (int j = 0; j < 8; ++j) v[j] *= (1.0f / 256.0f);
        *(u32x4*)((bf16_t*)(ws + WS_MGB) + (size_t)(MP + 32 * mt + m) * D + 32 * nt + 8 * q4) = pack8(v);
    }
    __syncthreads();
}

enum { SUB_Z = 0, SUB_POSTZ = 1, SUB_MIX = 2, SUB_COMB = 3, SUB_BR = 4, SUB_WO = 5, SUB_GU = 6, SUB_DN = 7, SUB_PLE = 8, NSUB = 9 };
constexpr int N_PHASES = 1 + 2 * NSUB;
__device__ __forceinline__ int n_passes(int sub) { return sub == SUB_BR ? 4 : 1; }
__device__ __forceinline__ void make_pass(ArgsP a, int l, int sub, int p, pg8::Gemm& g, pg8::Epi& e) {
    unsigned char* ws = a->ws; unsigned char* wl = ws + WS_W + (size_t)l * WL;
    float* rs = (float*)(ws + WS_CTL);
    bf16_t* xb = (bf16_t*)(ws + WS_XB); bf16_t* xb2 = (bf16_t*)(ws + WS_XB2); float* xres = (float*)(ws + WS_XRES); bf16_t* z = (bf16_t*)(ws + WS_Z);
    e.mode = 0; e.rowss = nullptr; e.ob = nullptr; e.ob2 = nullptr; e.ldb = 0; e.of = nullptr; e.rin_p = nullptr; e.rin_s = nullptr; e.rin_b = nullptr; e.rs_out = nullptr; e.gate8 = nullptr; e.pl = nullptr; e.mg = nullptr;
    g.M = (sub == SUB_Z || sub == SUB_GU) ? M : MP;
    if (sub == SUB_Z) {
        g.A = xb; g.Bt = (const bf16_t*)(wl + W_IN); g.N = NZ; g.K = D;
        e.mode = pg8::EP_Z; e.rowss = rs + (l == 0 ? RS_MIX0 : RS_MIX1) * RS_STRIDE; e.ob = z; e.ldb = ZP; e.gate8 = ws + WS_ZG8;
    } else if (sub == SUB_BR) {
        g.N = D;
        if (p == 0) { g.A = (const bf16_t*)(ws + WS_ACTA); g.Bt = (const bf16_t*)(wl + W_A); g.K = 384; e.mode = pg8::EP_BR_FIRST; }
        else if (p == 1) { g.A = (const bf16_t*)(ws + WS_ACTB); g.Bt = (const bf16_t*)(wl + W_B); g.K = 256; e.mode = pg8::EP_BR_MID; }
        else if (p == 2) { g.A = (const bf16_t*)(ws + WS_ACTC); g.Bt = (const bf16_t*)(wl + W_C); g.K = 384; e.mode = pg8::EP_BR_MID; }
        else { g.A = (const bf16_t*)(ws + WS_ACTD); g.Bt = (const bf16_t*)(wl + W_D); g.K = 384; e.mode = pg8::EP_BR_LAST; }
        e.gate8 = ws + WS_ZG8 + p * 1024; e.mg = (float*)(ws + WS_MG); e.ob = (bf16_t*)(ws + WS_MGB); e.ldb = D;
    } else if (sub == SUB_WO) {
        g.A = (const bf16_t*)(ws + WS_MGB); g.Bt = (const bf16_t*)(wl + W_O); g.N = D; g.K = D;
        e.mode = pg8::EP_RES; e.ob = xb2; e.ldb = D; e.rs_out = rs + (l == 0 ? RS_FFN0 : RS_FFN1) * RS_STRIDE;
        if (l == 0) { e.rin_p = a->in[IN_XP]; e.rin_s = a->in[IN_XS]; } else e.rin_b = xb;
    } else if (sub == SUB_GU) {
        g.A = xb2; g.Bt = (const bf16_t*)(wl + W_GU); g.N = 2 * DFF; g.K = D;
        e.mode = pg8::EP_GLU; e.rowss = rs + (l == 0 ? RS_FFN0 : RS_FFN1) * RS_STRIDE; e.ob = (bf16_t*)(ws + WS_HFF); e.ldb = DFF;
    } else if (sub == SUB_DN) {
        g.A = (const bf16_t*)(ws + WS_HFF); g.Bt = (const bf16_t*)(wl + W_DN); g.N = D; g.K = DFF;
        e.mode = pg8::EP_RES; e.ob = xb2; e.ldb = D; e.rs_out = rs + (l == 0 ? RS_PLE0 : RS_PLE1) * RS_STRIDE;
        e.rin_b = xb2;
    } else {
        g.N = D;
        if (p == 0) { g.A = (const bf16_t*)(ws + WS_PEB) + (size_t)l * M * DPLE; g.Bt = (const bf16_t*)(wl + W_PLE); g.K = DPLE; e.mode = pg8::EP_PL; e.ob = (bf16_t*)(ws + WS_PL); e.ldb = D; }
        else {
            g.A = xb2; g.Bt = (const bf16_t*)(wl + W_PG); g.K = D;
            e.mode = pg8::EP_PLE; e.rowss = rs + (l == 0 ? RS_PLE0 : RS_PLE1) * RS_STRIDE; e.pl = (const bf16_t*)(ws + WS_PL);
            e.rin_b = xb2;
            if (l == 0) { e.ob = xb; e.ldb = D; e.rs_out = rs + RS_MIX1 * RS_STRIDE; }
            else { e.of = a->out + O_YP; e.ob = nullptr; e.ldb = D; e.rs_out = nullptr; }
        }
    }
}


#ifndef MK_XCD_BARRIER
#define MK_XCD_BARRIER 1
#endif
constexpr int CW_BAR = 131072;
constexpr int LDS_BARST_OFF = LDS_BYTES - 64;
static_assert((CW_BAR + 3456) * 4 <= (int)CTL_ZERO_BYTES, "barrier words inside the memset region");
#define XB_TMO      128
#define XB_XCNT(j)  (256  + 64 * (j))
#define XB_XSUB(j)  (1280 + 64 * (j))
#define XB_XGEN(j)  (2304 + 64 * (j))
#define XB_TOP      3328
#define XB_TOPGEN   3392
#define XCD_BAR_WORDS 3456
#define XB_SPIN_CAP (1u << 18)

__device__ __forceinline__ unsigned xb_ld(unsigned* p)              { return __hip_atomic_load(p, __ATOMIC_RELAXED, __HIP_MEMORY_SCOPE_AGENT); }
__device__ __forceinline__ unsigned xb_add(unsigned* p, unsigned v) { return __hip_atomic_fetch_add(p, v, __ATOMIC_RELAXED, __HIP_MEMORY_SCOPE_AGENT); }
__device__ __forceinline__ unsigned xb_xcc_id() { return (unsigned)__builtin_amdgcn_s_getreg((3 << 11) | 20) & 0xFu; }
#define XB_SPIN(cond, bar) do { unsigned _sp = 0; while (cond) { __builtin_amdgcn_s_sleep(1); \
    if ((++_sp & 255u) == 0u) { if (xb_ld(&(bar)[XB_TMO])) break; if (_sp > XB_SPIN_CAP) { atomicAdd(&(bar)[XB_TMO], 1u); break; } } } } while (0)

struct XcdBarrier {
    unsigned* bar; unsigned x;
    volatile LAS unsigned* st;
};

__device__ __forceinline__ XcdBarrier xcd_barrier_post(unsigned* bar, volatile LAS unsigned* st) {
    XcdBarrier b; b.bar = bar; b.x = xb_xcc_id(); b.st = st;
    if (threadIdx.x == 0) (void)xb_add(&bar[XB_XCNT(b.x)], 1u);
    return b;
}
__device__ __forceinline__ void xcd_barrier_complete(unsigned* bar, unsigned x, unsigned& nloc, unsigned& nx) {
    const unsigned G = gridDim.x * gridDim.y * gridDim.z;
    unsigned sum, cnt, mine, sp = 0u;
    for (;;) {
        sum = 0u; cnt = 0u; mine = 0u;
#pragma unroll
        for (unsigned j = 0; j < 16; ++j) { const unsigned c = xb_ld(&bar[XB_XCNT(j)]); sum += c; cnt += (c > 0u) ? 1u : 0u; mine = (j == x) ? c : mine; }
        if (sum == G) break;
        __builtin_amdgcn_s_sleep(1);
        if ((++sp & 255u) == 0u) { if (xb_ld(&bar[XB_TMO])) break; if (sp > XB_SPIN_CAP) { atomicAdd(&bar[XB_TMO], 1u); break; } }
    }
    nloc = mine > 0u ? mine : 1u; nx = cnt > 0u ? cnt : 1u;
}

__device__ __forceinline__ void xcd_barrier(const XcdBarrier& b) {
    asm volatile("s_waitcnt vmcnt(0)" ::: "memory");
    __syncthreads();
    if (threadIdx.x == 0) {
        unsigned* bar = b.bar;
        __builtin_amdgcn_s_waitcnt(0);
        unsigned nloc = b.st[0], nx = b.st[1];
        if (nloc == 0u) { xcd_barrier_complete(bar, b.x, nloc, nx); b.st[0] = nloc; b.st[1] = nx; }
        const unsigned old = xb_add(&bar[XB_XSUB(b.x)], 1u);
        const unsigned gen = old / nloc;
        if (old + 1u == (gen + 1u) * nloc) {
            __builtin_amdgcn_fence(__ATOMIC_RELEASE, "agent");
            asm volatile("s_waitcnt vmcnt(0)" ::: "memory");
            const unsigned og = xb_add(&bar[XB_TOP], 1u);
            const unsigned tg = og / nx;
            if (og + 1u == (tg + 1u) * nx) xb_add(&bar[XB_TOPGEN], 1u);
            else XB_SPIN(xb_ld(&bar[XB_TOPGEN]) == tg, bar);
            __builtin_amdgcn_fence(__ATOMIC_ACQUIRE, "agent");
            xb_add(&bar[XB_XGEN(b.x)], 1u);
            asm volatile("s_waitcnt vmcnt(0)" ::: "memory");
        } else {
            XB_SPIN(xb_ld(&bar[XB_XGEN(b.x)]) == gen, bar);
            __builtin_amdgcn_fence(__ATOMIC_ACQUIRE, "agent");
            asm volatile("s_waitcnt vmcnt(0)" ::: "memory");
        }
    }
    __syncthreads();
}


constexpr int Z0_SPLIT_ROUNDS = 7;
#ifndef WGM_WIDE
#define WGM_WIDE 4
#define WGM_NARROW 8
#endif
__device__ __forceinline__ int phase_reps(int ph, int sub) {
    return ph == 0 ? REP_P0 : sub == SUB_Z ? REP_Z : sub == SUB_POSTZ ? REP_POSTZ : sub == SUB_MIX ? REP_MIX : sub == SUB_COMB ? REP_COMB : sub == SUB_BR ? REP_BR : sub == SUB_GU ? REP_GU : 1;
}
__global__ void __launch_bounds__(512, 2) mega_fwd(Args a) {
    extern __shared__ __attribute__((aligned(16))) unsigned char lds_raw[];
    LAS unsigned char* lds = (LAS unsigned char*)lds_raw;
    const int G = gridDim.x, bid = blockIdx.x;
    const int ph_lo = a.ph_lo, ph_hi = a.ph_hi;
#if MK_XCD_BARRIER
    if (threadIdx.x < 2) ((volatile LAS unsigned*)(lds + LDS_BARST_OFF))[threadIdx.x] = 0u;
    __syncthreads();
    (void)xcd_barrier_post((unsigned*)(((ArgsP)__builtin_amdgcn_kernarg_segment_ptr())->ws + WS_CTL) + CW_BAR, (volatile LAS unsigned*)(lds + LDS_BARST_OFF));
#else
    cg::grid_group grid = cg::this_grid();
#endif
    for (int ph = ph_lo; ph < ph_hi; ++ph) {
#if MK_XCD_BARRIER
        if (ph > ph_lo) {
            XcdBarrier xb; xb.bar = (unsigned*)(((ArgsP)__builtin_amdgcn_kernarg_segment_ptr())->ws + WS_CTL) + CW_BAR; xb.x = xb_xcc_id(); xb.st = (volatile LAS unsigned*)(lds + LDS_BARST_OFF);
            xcd_barrier(xb);
        }
#else
        if (ph > ph_lo) grid.sync();
#endif
        ArgsP ap = (ArgsP)__builtin_amdgcn_kernarg_segment_ptr(); asm volatile("" : "+s"(ap));
        int tid = threadIdx.x; asm volatile("" : "+v"(tid));
        const int lane = tid & 63, wave = __builtin_amdgcn_readfirstlane(tid >> 6);
        if (ph == 0 || (ph == 1 && G == 256 && bid >= 128)) {
            p0_prologue(ap, lds, tid, lane, wave, ph == 0 ? G : 128, ph == 0 ? bid : bid - 128, ph == 0 ? (G == 256 ? 0 : 2) : 1, ph == 1);
            if (ph == 0) continue;
            __syncthreads();
        }
        const int l = (ph - 1) / NSUB, sub = (ph - 1) - l * NSUB;
        if (sub == SUB_POSTZ) {
            for (int rep = 0; rep < REP_POSTZ; ++rep) {
                for (int t8 = bid * 8 + wave; t8 < MP / 8; t8 += G * 8) postz_rows8(ap, l, t8 * 8, lane);
                for (int m = MP + bid * 8 + wave; m < M; m += G * 8) { const PzRow R = postz_load(ap, m, lane); __builtin_amdgcn_sched_barrier(0); (void)postz_row(ap, l, m, lane, R); }
            }
            continue;
        }
        if (sub == SUB_MIX) { p3_mixer(ap, lds, l, tid, lane, wave, G, bid); __syncthreads(); continue; }
        if (sub == SUB_COMB) { for (int rep = 0; rep < REP_COMB; ++rep) {
                int m = bid * 8 + wave; if (m >= M) continue;
                CbRow cur = combine_load(ap, m, lane);
                for (; m < M; m += G * 8) { const int mn = m + G * 8; CbRow nxt = cur; if (mn < M) nxt = combine_load(ap, mn, lane); __builtin_amdgcn_sched_barrier(0); combine_row(ap, m, lane, cur); cur = nxt; }
            } continue; }
        const int np = n_passes(sub);
        const int nrep = phase_reps(ph, sub) + ((DRY_SUB >= 0 && sub == DRY_SUB) ? 1 : 0);
        const int nmain = (sub == SUB_BR ? 1 : np) * nrep;
        for (int pp = 0; pp < nmain; ++pp) {
            const int p = (sub == SUB_BR) ? 0 : (sub == SUB_PLE ? 1 : pp % np);
            pg8::Gemm g; pg8::Epi e; pg8::SegSched S;
            make_pass(ap, l, sub, p, g, e);
            pg8::Gemm g2 = g; pg8::Epi e2 = e;
            if (sub == SUB_PLE) make_pass(ap, l, SUB_PLE, 0, g2, e2);
#if DRY_SUB >= 0
            if (sub == DRY_SUB && pp < np) {
                if (e.ob) e.ob = (bf16_t*)(ap->ws + WS_XRES); if (e.of) e.of = (float*)(ap->ws + WS_MG); if (e.rs_out) e.rs_out = (float*)(ap->ws + WS_CTL) + 6 * RS_STRIDE;
            }
#endif
            S.nseg = 1; S.A0 = g.A; S.B0 = g.Bt; S.K0 = g.K; S.ws = ap->ws; S.wl = ap->ws + WS_W + (size_t)l * WL;
            S.A1 = g2.A; S.B1 = g2.Bt; S.K1 = g2.K;
            if (sub == SUB_BR) { S.nseg = 4; e.mode = pg8::EP_BRC; }
            if (sub == SUB_PLE) { S.nseg = 2; e.ob2 = e2.ob; }
            S.so.init(g.M, g.N, G, bid, (g.N > D) ? WGM_WIDE : WGM_NARROW);
            S.split_rounds = 0;
            if (G == 256 && sub == SUB_Z && l == 0 && pp == 0) {
                S.split_rounds = Z0_SPLIT_ROUNDS;
            }
            if (G == 256 && (sub == SUB_Z || sub == SUB_GU) && pp == 0 && !(sub == SUB_Z && l == 0)) {
                const int nwg = (g.M / 256) * (g.N / 256), rem = nwg - (nwg / G) * G;
                if (bid >= rem) {
                    const int k = bid - rem, Q = (sub == SUB_Z) ? STAG_Q_Z : STAG_Q_GU;
                    const int base = ((sub == SUB_GU) ? STAG_TOT_Z : 0) + l * (STAG_TOT_Z + STAG_TOT_GU);
                    const int lo = base + Q * (k * (k - 1) / 2);
                    cache_copy_range(ap, lo, lo + Q * k, tid, 512);
                }
            }
            const bool has_small = (sub != SUB_BR && g.M == MP);
            const bool small_first = has_small && ((bid >> 3) & 1);
#pragma unroll 1
            for (int step = 0; step < 2; ++step) {
                if ((step == 0) != small_first) pg8::gemm_phase<pg8::Epi, pg8::SegSched, true>(lds, S, e, tid);
                else if (has_small) {
                    for (int tile = bid; tile < 256; tile += G) small_gemm_tile(lds, g, e, g2, sub == SUB_PLE, tile >> 5, tile & 31, tid, lane, wave);
                }
            }
        }
        if (sub == SUB_BR) {
            for (int pp = 0; pp < nrep; ++pp)
                for (int tile = bid; tile < 256; tile += G) small_br_tile(lds, ap, l, tile >> 5, tile & 31, tid, lane, wave);
        }
    }
}

extern "C" void kernel_launch(void* const* d_in, const int* in_sizes, int n_in, void* d_out, int out_size, void* d_ws, size_t ws_size, hipStream_t stream) {
    static int grid = 0;
    if (grid == 0) {
        if (n_in != 36 || (size_t)out_size != O_END || ws_size < WS_END) { fprintf(stderr, "kernel_launch: unexpected shapes: n_in %d out %d ws %zu (need %zu)\n", n_in, out_size, ws_size, (size_t)WS_END); grid = -1; return; }
        int dev = 0, cus = 0, per_cu = 0;
        if (hipGetDevice(&dev) != hipSuccess || hipDeviceGetAttribute(&cus, hipDeviceAttributeMultiprocessorCount, dev) != hipSuccess) { grid = -1; return; }
        if (hipFuncSetAttribute((const void*)mega_fwd, hipFuncAttributeMaxDynamicSharedMemorySize, LDS_BYTES) != hipSuccess) { fprintf(stderr, "kernel_launch: hipFuncSetAttribute failed\n"); grid = -1; return; }
        if (hipOccupancyMaxActiveBlocksPerMultiprocessor(&per_cu, (const void*)mega_fwd, 512, LDS_BYTES) != hipSuccess || per_cu < 1) { fprintf(stderr, "kernel_launch: occupancy query says %d blocks per CU\n", per_cu); per_cu = 1; }
        (void)hipGetLastError();
        grid = cus;
    }
    if (grid < 0) return;
    (void)hipMemsetAsync((char*)d_ws + WS_CTL, 0, CTL_ZERO_BYTES, stream);
    Args a{};
    for (int i = 0; i < 36; ++i) a.in[i] = (const float*)d_in[i];
    a.out = (float*)d_out; a.ws = (unsigned char*)d_ws;
#if MK_ONE_LAUNCH
    a.ph_lo = 0; a.ph_hi = N_PHASES;
    void* args[] = {&a};
    hipError_t e = hipLaunchCooperativeKernel((const void*)mega_fwd, dim3(grid), dim3(512), args, LDS_BYTES, stream);
    if (e != hipSuccess) fprintf(stderr, "cooperative launch failed: %s (grid %d)\n", hipGetErrorString(e), grid);
#else
    for (int ph = 0; ph < N_PHASES; ++ph) {
        a.ph_lo = ph; a.ph_hi = ph + 1;
        hipLaunchKernelGGL(mega_fwd, dim3(grid), dim3(512), LDS_BYTES, stream, a);
    }
#endif
}
```
